# Optimizing an MI355X kernel written in HIP

```python
import math
import jax, jax.numpy as jnp
from jax import lax
import numpy as np

D_MODEL = 2048
BATCH = 4
SEQ = 4096
DEPTH = 2
DEC_BATCH = 2
DEC_SEQ = 8192
PAST_LEN = 128

N_META = 16
POOL_WIDTH = D_MODEL // 2
POOL_WINDOWS = (2, 4, 8, 16)
N_POOL_GROUPS = len(POOL_WINDOWS)
POOL_GROUP = POOL_WIDTH // N_POOL_GROUPS
HYENA_WIDTH = D_MODEL - POOL_WIDTH
HYENA_ORDER = 2
N_HYENA_PROJ = HYENA_ORDER + 1
SHORT_CONV = 3
FILTER_EMB = 33
FILTER_BANDS = (FILTER_EMB - 1) // 2
FILTER_WIDTH = 64
N_DIRS = 2
DECAY_TARGET = 1e-2
FAST_DECAY_PCT = 0.3
SLOW_DECAY_PCT = 1.5
IN_WIDTH = POOL_WIDTH + N_HYENA_PROJ * HYENA_WIDTH
FILTER_OUT = HYENA_ORDER * N_DIRS * HYENA_WIDTH
D_FF = -(-8 * D_MODEL // (3 * 256)) * 256
EPS = 1e-6

kernel_name = 'hybrid_pool_hyena_encoder'


def rmsnorm(x, g):
    x32 = x.astype(jnp.float32)
    y = x32 * lax.rsqrt(jnp.mean(x32 * x32, axis=-1, keepdims=True) + EPS)
    return (y * g.astype(jnp.float32)).astype(x.dtype)


def pool_mixer(u, pool_w, pool_scale):
    B, L, C = u.shape
    u32 = u.astype(jnp.float32)
    cs = jnp.concatenate([jnp.zeros((B, 1, C), jnp.float32), jnp.cumsum(u32, axis=1)], axis=1)
    pos = jnp.arange(L)
    outs = []
    for g, w in enumerate(POOL_WINDOWS):
        lo = jnp.clip(pos - w // 2, 0, L)
        hi = jnp.clip(pos + w // 2, 0, L)
        csg = cs[..., g * POOL_GROUP:(g + 1) * POOL_GROUP]
        cnt = (hi - lo).astype(jnp.float32)[None, :, None]
        mean = (jnp.take(csg, hi, axis=1) - jnp.take(csg, lo, axis=1)) / cnt
        outs.append(mean - u32[..., g * POOL_GROUP:(g + 1) * POOL_GROUP])
    d = jnp.stack(outs, axis=2)
    y = jnp.einsum('blgc,gcd->blgd', d, pool_w.astype(jnp.float32)).reshape(B, L, C)
    return (y * pool_scale.astype(jnp.float32)).astype(u.dtype)


def short_conv(u, w, b):
    up = jnp.pad(u, ((0, 0), (1, 1), (0, 0)))
    return up[:, :-2] * w[0] + up[:, 1:-1] * w[1] + up[:, 2:] * w[2] + b


def hyena_filters(L, w1, b1, w2, b2, w3, b3, freq, w4):
    f32 = jnp.float32
    n = jnp.arange(L, dtype=f32)
    t = n / (L - 1)
    ang = (2.0 * math.pi / L) * n[:, None] * jnp.linspace(1e-4, FILTER_BANDS - 1, FILTER_BANDS, dtype=f32)[None, :]
    z = jnp.concatenate([t[:, None], jnp.cos(ang), -jnp.sin(ang)], axis=-1)
    fr = freq.astype(f32)
    h = jnp.sin(fr * (z @ w1.astype(f32) + b1.astype(f32)))
    h = jnp.sin(fr * (h @ w2.astype(f32) + b2.astype(f32)))
    h = jnp.sin(fr * (h @ w3.astype(f32) + b3.astype(f32)))
    k = (h @ w4.astype(f32)).reshape(L, HYENA_ORDER, N_DIRS, HYENA_WIDTH)
    deltas = jnp.linspace(math.log(DECAY_TARGET) / SLOW_DECAY_PCT,
                          math.log(DECAY_TARGET) / FAST_DECAY_PCT, HYENA_WIDTH, dtype=f32)
    decay = jnp.exp(-t[:, None] * jnp.abs(deltas)[None, :])
    return k * decay[:, None, None, :]


def long_conv(u, kf, kb, skip):
    B, L, C = u.shape
    u32 = u.astype(jnp.float32)
    kfull = jnp.concatenate([kf, jnp.zeros((1, C), jnp.float32), kb[:0:-1]], axis=0)
    U = jnp.fft.rfft(u32, n=2 * L, axis=1)
    K = jnp.fft.rfft(kfull, n=2 * L, axis=0)
    y = jnp.fft.irfft(U * K[None], n=2 * L, axis=1)[:, :L]
    return (y + u32 * skip.astype(jnp.float32)).astype(u.dtype)


def hyena_mixer(u, conv_w, conv_b, w1, b1, w2, b2, w3, b3, freq, w4, skip):
    L = u.shape[1]
    uc = short_conv(u, conv_w, conv_b)
    v, x1, x2 = jnp.split(uc, N_HYENA_PROJ, axis=-1)
    k = hyena_filters(L, w1, b1, w2, b2, w3, b3, freq, w4)
    z = x1 * long_conv(v, k[:, 0, 0], k[:, 0, 1], skip[0])
    return x2 * long_conv(z, k[:, 1, 0], k[:, 1, 1], skip[1])


def trunk(x, meta_tokens, norm1_g, in_proj, pool_w, pool_scale, hy_conv_w, hy_conv_b,
          flt_w1, flt_b1, flt_w2, flt_b2, flt_w3, flt_b3, flt_freq, flt_w4, hy_skip,
          out_proj, norm2_g, w_gate, w_up, w_down, final_g):
    B = x.shape[0]
    meta = jnp.broadcast_to(meta_tokens[None].astype(x.dtype), (B, N_META, D_MODEL))
    h = jnp.concatenate([meta, x], axis=1)
    for l in range(DEPTH):
        hn = rmsnorm(h, norm1_g[l])
        proj = hn @ in_proj[l]
        a = pool_mixer(proj[..., :POOL_WIDTH], pool_w[l], pool_scale[l])
        b = hyena_mixer(proj[..., POOL_WIDTH:], hy_conv_w[l], hy_conv_b[l],
                        flt_w1[l], flt_b1[l], flt_w2[l], flt_b2[l], flt_w3[l], flt_b3[l],
                        flt_freq[l], flt_w4[l], hy_skip[l])
        h = h + jnp.concatenate([a, b], axis=-1) @ out_proj[l]
        hn = rmsnorm(h, norm2_g[l])
        h = h + (jax.nn.silu(hn @ w_gate[l]) * (hn @ w_up[l])) @ w_down[l]
    return rmsnorm(h, final_g)[:, N_META:]


def setup_inputs(seed: int = 0) -> dict:
    key = jax.random.key(seed)
    ks = jax.random.split(key, 32)
    f32 = jnp.float32
    nrm = lambda k, shape, s: jax.random.normal(k, shape, f32) * s
    return {
        'x_prompt': nrm(ks[0], (BATCH, SEQ, D_MODEL), 1.0),
        'x_sample': nrm(ks[1], (DEC_BATCH, DEC_SEQ, D_MODEL), 1.0),
        'meta_tokens': nrm(ks[2], (N_META, D_MODEL), 1.0),
        'norm1_g': 1.0 + nrm(ks[3], (DEPTH, D_MODEL), 0.02),
        'in_proj': nrm(ks[4], (DEPTH, D_MODEL, IN_WIDTH), D_MODEL ** -0.5),
        'pool_w': nrm(ks[5], (DEPTH, N_POOL_GROUPS, POOL_GROUP, POOL_GROUP), POOL_GROUP ** -0.5),
        'pool_scale': 1.0 + nrm(ks[6], (DEPTH, POOL_WIDTH), 0.02),
        'hy_conv_w': nrm(ks[7], (DEPTH, SHORT_CONV, N_HYENA_PROJ * HYENA_WIDTH), SHORT_CONV ** -0.5),
        'hy_conv_b': nrm(ks[8], (DEPTH, N_HYENA_PROJ * HYENA_WIDTH), 0.02),
        'flt_w1': nrm(ks[9], (DEPTH, FILTER_EMB, FILTER_WIDTH), FILTER_EMB ** -0.5),
        'flt_b1': nrm(ks[10], (DEPTH, FILTER_WIDTH), 0.02),
        'flt_w2': nrm(ks[11], (DEPTH, FILTER_WIDTH, FILTER_WIDTH), FILTER_WIDTH ** -0.5),
        'flt_b2': nrm(ks[12], (DEPTH, FILTER_WIDTH), 0.02),
        'flt_w3': nrm(ks[13], (DEPTH, FILTER_WIDTH, FILTER_WIDTH), FILTER_WIDTH ** -0.5),
        'flt_b3': nrm(ks[14], (DEPTH, FILTER_WIDTH), 0.02),
        'flt_freq': 1.0 + nrm(ks[15], (DEPTH, FILTER_WIDTH), 0.02),
        'flt_w4': nrm(ks[16], (DEPTH, FILTER_WIDTH, FILTER_OUT), 0.05 * FILTER_WIDTH ** -0.5),
        'hy_skip': nrm(ks[17], (DEPTH, HYENA_ORDER, HYENA_WIDTH), 0.1),
        'out_proj': nrm(ks[18], (DEPTH, D_MODEL, D_MODEL), D_MODEL ** -0.5),
        'norm2_g': 1.0 + nrm(ks[19], (DEPTH, D_MODEL), 0.02),
        'w_gate': nrm(ks[20], (DEPTH, D_MODEL, D_FF), D_MODEL ** -0.5),
        'w_up': nrm(ks[21], (DEPTH, D_MODEL, D_FF), D_MODEL ** -0.5),
        'w_down': nrm(ks[22], (DEPTH, D_FF, D_MODEL), D_FF ** -0.5),
        'final_g': 1.0 + nrm(ks[23], (D_MODEL,), 0.02),
    }


def reference(x_prompt, x_sample, meta_tokens, norm1_g, in_proj, pool_w, pool_scale,
              hy_conv_w, hy_conv_b, flt_w1, flt_b1, flt_w2, flt_b2, flt_w3, flt_b3,
              flt_freq, flt_w4, hy_skip, out_proj, norm2_g, w_gate, w_up, w_down, final_g):
    y_prompt = trunk(x_prompt, meta_tokens, norm1_g, in_proj, pool_w, pool_scale, hy_conv_w, hy_conv_b,
                     flt_w1, flt_b1, flt_w2, flt_b2, flt_w3, flt_b3, flt_freq, flt_w4, hy_skip,
                     out_proj, norm2_g, w_gate, w_up, w_down, final_g)
    y_sample = trunk(x_sample, meta_tokens, norm1_g, in_proj, pool_w, pool_scale, hy_conv_w, hy_conv_b,
                     flt_w1, flt_b1, flt_w2, flt_b2, flt_w3, flt_b3, flt_freq, flt_w4, hy_skip,
                     out_proj, norm2_g, w_gate, w_up, w_down, final_g)
    return (y_prompt, y_sample)
```

```cpp
#include <hip/hip_runtime.h>
#include <hip/hip_cooperative_groups.h>
#include <cstdio>
namespace cg = cooperative_groups;

#ifndef PHMASK
#define PHMASK 255
#endif
#ifndef SUB
#define SUB 7
#endif
#ifndef MEGA
#define MEGA 1
#endif

#define LAS __attribute__((address_space(3)))
typedef unsigned short bf16_t;
typedef short bf16x8 __attribute__((ext_vector_type(8)));
typedef float f32x4 __attribute__((ext_vector_type(4)));
typedef float f32x16 __attribute__((ext_vector_type(16)));
typedef unsigned u32x4 __attribute__((ext_vector_type(4)));
typedef unsigned u32x2 __attribute__((ext_vector_type(2)));

constexpr int DM = 2048, TREAL = 32768, TTOK = 32864, TP = 33024, DFF = 5632;
constexpr int NTHREADS = 512;
constexpr int LDS_BYTES = 147456;
constexpr float EPSN = 1e-6f;

constexpr size_t WS_TAIL = 0;
constexpr size_t WS_XA   = WS_TAIL + (size_t)256 * DM * 4;
constexpr size_t WS_WIN  = WS_XA + (size_t)TP * DM * 2;
constexpr size_t WS_WOUT = WS_WIN + (size_t)4096 * DM * 2;
constexpr size_t WS_WGU  = WS_WOUT + (size_t)DM * DM * 2;
constexpr size_t WS_WDN  = WS_WGU + (size_t)2 * DFF * DM * 2;
constexpr size_t WS_H3   = WS_WDN + (size_t)DM * DFF * 2;
constexpr size_t WS_W4T  = WS_H3 + (size_t)(8208 + 4112) * 64 * 4;
constexpr size_t WS_BIG  = WS_W4T + (size_t)4096 * 64 * 4;
constexpr size_t WS_P    = WS_BIG;
constexpr size_t WS_UT   = WS_P + (size_t)TP * 1024 * 2;
constexpr size_t WS_GFS  = WS_UT + (size_t)3072 * TP * 2;
constexpr size_t WS_GFP  = WS_GFS + (size_t)2048 * 16416 * 2;
constexpr size_t WS_HID  = WS_BIG;
constexpr size_t WS_END  = WS_BIG + (size_t)TP * DFF * 2;
static_assert(WS_GFP + (size_t)2048 * 8224 * 2 <= WS_END, "big region");

struct Params {
    const float* in[24];
    float* out;
    unsigned char* ws;
};
typedef const __attribute__((address_space(4))) unsigned long long* kseg_t;
struct DP {
    kseg_t ks; int tid, bid, nb;
    __device__ __forceinline__ const float* in_(int k) const { return (const float*)ks[k]; }
    __device__ __forceinline__ float* out_() const { return (float*)ks[24]; }
    __device__ __forceinline__ unsigned char* ws_() const { return (unsigned char*)ks[25]; }
};

__device__ __forceinline__ unsigned cvt_pk_bf16(float lo, float hi) { unsigned r; asm volatile("v_cvt_pk_bf16_f32 %0, %1, %2" : "=v"(r) : "v"(lo), "v"(hi)); return r; }
__device__ __forceinline__ bf16_t f2bf(float f) { return (bf16_t)(cvt_pk_bf16(f, 0.f) & 0xffffu); }
__device__ __forceinline__ float bf2f(unsigned v) { return __uint_as_float(v << 16); }
__device__ __forceinline__ float bflo(unsigned w) { return __uint_as_float(w << 16); }
__device__ __forceinline__ float bfhi(unsigned w) { return __uint_as_float(w & 0xffff0000u); }
__device__ __forceinline__ float wave_sum(float v) {
#pragma unroll
    for (int o = 32; o >= 1; o >>= 1) v += __shfl_xor(v, o);
    return v;
}
__device__ __forceinline__ int seq_rbase(int sq) { return sq < 4 ? sq * 4096 : 16384 + (sq - 4) * 8192; }
__device__ __forceinline__ int seq_row(int sq, int p) { return p < 16 ? TREAL + 16 * sq + p : seq_rbase(sq) + p - 16; }

namespace pg8 {
constexpr int BM = 256, BK = 64, HALF = 128, HTB = HALF * BK * 2, STAGE_BYTES = 8 * HTB, NXCD = 8, WGM = 8;
__device__ __forceinline__ int lds_byte(int r, int c) { const int st = (r >> 4) * 2 + (c >> 5), rr = r & 15, cc = c & 31, ob = rr * 64 + cc * 2; return st * 1024 + (ob ^ (((ob >> 9) & 1) << 5)); }
__device__ __forceinline__ void stage_rc(int b, int& R, int& C) { const int st = b / 1024, sb = b % 1024, swz = sb ^ (((sb >> 9) & 1) << 5); R = (st >> 1) * 16 + swz / 64; C = (st & 1) * 32 + (swz % 64) / 2; }
__device__ __forceinline__ int perm32(int rho) { const int n = rho >> 4, i = rho & 15; return 8 * (i >> 2) + 4 * n + (i & 3); }

struct Unit { const char* a; const char* b; int pm, pn, prob; };
struct Prob { const bf16_t* A; const bf16_t* Bt; int nM, nN; };
struct Sched2 {
    const bf16_t* A0; const bf16_t* B0; const bf16_t* A1; const bf16_t* B1; int nM0, nN0, nM1, nN1, nwg0, nwg1; int K, G, c;
    __device__ __forceinline__ void init(const Prob& p0, const Prob& p1, int K_, int G_, int c_) { A0 = p0.A; B0 = p0.Bt; A1 = p1.A; B1 = p1.Bt; nM0 = p0.nM; nN0 = p0.nN; nM1 = p1.nM; nN1 = p1.nN;
        nwg0 = nM0 * nN0; nwg1 = nM1 * nN1; K = K_; G = G_; c = c_; }
    __device__ __forceinline__ bool next(int i, Unit& u) const {
        long L = (long)i * G + c; int q = 0;
        if (L >= nwg0) { L -= nwg0; q = 1; if (L >= nwg1) return false; }
        const int nM = q ? nM1 : nM0, nN = q ? nN1 : nN0, nw = q ? nwg1 : nwg0;
        int wgid = (int)L; { const int qq = nw / NXCD, r = nw % NXCD, xcd = wgid % NXCD, off = wgid / NXCD; wgid = (xcd < r ? xcd * (qq + 1) : r * (qq + 1) + (xcd - r) * qq) + off; }
        const int nig = WGM * nN, gid = wgid / nig, fm = gid * WGM, gsz = (nM - fm) < WGM ? (nM - fm) : WGM;
        u.pm = fm + ((wgid % nig) % gsz); u.pn = (wgid % nig) / gsz; u.prob = q;
        const size_t tstep = (size_t)BM * K * 2;
        u.a = (const char*)(q ? A1 : A0) + (size_t)u.pm * tstep; u.b = (const char*)(q ? B1 : B0) + (size_t)u.pn * tstep;
        return true;
    }
};

struct EpiStore {
    static constexpr bool PERM = true;
    bf16_t* O[2]; int ldc[2];
    __device__ __forceinline__ void operator()(const f32x4 (&acc)[2][2][4][2], const Unit& u, int wr, int wc, int fr, int fq) const {
        bf16_t* base = u.prob ? O[1] : O[0]; const int ld = u.prob ? ldc[1] : ldc[0];
        const int row0 = u.pm * BM + wr * 64 + fr, col0 = u.pn * BM + wc * 32 + 8 * fq;
#pragma unroll
        for (int ai = 0; ai < 2; ++ai)
#pragma unroll
            for (int m = 0; m < 4; ++m) { bf16_t* rowp = base + (size_t)(row0 + ai * HALF + m * 16) * ld + col0;
#pragma unroll
                for (int bj = 0; bj < 2; ++bj) { const f32x4 v0 = acc[ai][bj][m][0], v1 = acc[ai][bj][m][1];
                    u32x4 w; w.x = cvt_pk_bf16(v0[0], v0[1]); w.y = cvt_pk_bf16(v0[2], v0[3]); w.z = cvt_pk_bf16(v1[0], v1[1]); w.w = cvt_pk_bf16(v1[2], v1[3]);
                    *(u32x4*)(rowp + bj * HALF) = w; } }
    }
};
struct EpiResid {
    static constexpr bool PERM = false;
    float* hmain; float* htail;
    __device__ __forceinline__ void operator()(const f32x4 (&acc)[2][2][4][2], const Unit& u, int wr, int wc, int fr, int fq) const {
        float* base = (u.pm < TREAL / BM) ? hmain + (size_t)u.pm * BM * DM : htail;
        const int row0 = wr * 64 + fr, col0 = u.pn * BM + wc * 32 + 4 * fq;
#pragma unroll
        for (int ai = 0; ai < 2; ++ai)
#pragma unroll
            for (int m = 0; m < 4; ++m) { float* rowp = base + (size_t)(row0 + ai * HALF + m * 16) * DM + col0;
#pragma unroll
                for (int bj = 0; bj < 2; ++bj)
#pragma unroll
                    for (int n = 0; n < 2; ++n) { f32x4* p = (f32x4*)(rowp + bj * HALF + n * 16); *p = *p + acc[ai][bj][m][n]; } }
    }
};
struct EpiSwiGLU {
    static constexpr bool PERM = true;
    bf16_t* O;
    __device__ __forceinline__ void operator()(const f32x4 (&acc)[2][2][4][2], const Unit& u, int wr, int wc, int fr, int fq) const {
        const int row0 = u.pm * BM + wr * 64 + fr, col0 = u.pn * HALF + wc * 32 + 8 * fq;
#pragma unroll
        for (int ai = 0; ai < 2; ++ai)
#pragma unroll
            for (int m = 0; m < 4; ++m) { bf16_t* rowp = O + (size_t)(row0 + ai * HALF + m * 16) * DFF + col0;
                float r[8];
#pragma unroll
                for (int n = 0; n < 2; ++n)
#pragma unroll
                    for (int e = 0; e < 4; ++e) { const float g = acc[ai][0][m][n][e], up = acc[ai][1][m][n][e];
                        r[n * 4 + e] = g * __builtin_amdgcn_rcpf(1.0f + __expf(-g)) * up; }
                u32x4 w; w.x = cvt_pk_bf16(r[0], r[1]); w.y = cvt_pk_bf16(r[2], r[3]); w.z = cvt_pk_bf16(r[4], r[5]); w.w = cvt_pk_bf16(r[6], r[7]);
                *(u32x4*)rowp = w; }
    }
};

template <class Epi, class Sched>
__device__ __forceinline__ void gemm_phase(const DP& p, LAS unsigned char* lds, const Sched& S, const Epi& E) {
    const int tid = p.tid, wid = __builtin_amdgcn_readfirstlane(tid >> 6), lane = tid & 63, wr = wid >> 2, wc = wid & 3, fr = lane & 15, fq = lane >> 4;
    const int K = S.K, nt = K / BK;
    unsigned voffA[2], voffB[2];
#pragma unroll
    for (int i = 0; i < 2; ++i) { int R, C; stage_rc(tid * 16 + i * 8192, R, C); const int Rb = Epi::PERM ? ((R & ~31) + perm32(R & 31)) : R;
        voffA[i] = (unsigned)(R * K + C) * 2u; voffB[i] = (unsigned)(Rb * K + C) * 2u; }
    const size_t kstep = (size_t)(BK * 2);
    const size_t hstep = (size_t)HALF * K * 2;
    const unsigned ldsw = (unsigned)wid * 1024u;
    const int aoff = lds_byte(wr * 64 + fr, fq * 8), boff = lds_byte(wc * 32 + fr, fq * 8);
#define PG8_SA(b, h) (((b) * 2 + (h)) * HTB)
#define PG8_SB(b, h) ((4 + (b) * 2 + (h)) * HTB)
#define PG8_STAGE(bufoff, gbase, voff) do { _Pragma("unroll") for (int _i = 0; _i < 2; ++_i) \
        __builtin_amdgcn_global_load_lds((const unsigned*)((const char*)(gbase) + (voff)[_i]), (LAS unsigned*)(lds + (bufoff) + ldsw + _i * 8192), 16, 0, 0); } while (0)
#define PG8_LDA(dst, b, h) do { _Pragma("unroll") for (int m = 0; m < 4; ++m) _Pragma("unroll") for (int k = 0; k < 2; ++k) dst[m][k] = *(const LAS bf16x8*)(lds + PG8_SA(b, h) + aoff + m * 2048 + k * 1024); } while (0)
#define PG8_LDB(dst, b, h) do { _Pragma("unroll") for (int n = 0; n < 2; ++n) _Pragma("unroll") for (int k = 0; k < 2; ++k) dst[n][k] = *(const LAS bf16x8*)(lds + PG8_SB(b, h) + boff + n * 2048 + k * 1024); } while (0)
#define PG8_MMA(ai, bj, At, Bt) do { __builtin_amdgcn_s_setprio(1); _Pragma("unroll") for (int m = 0; m < 4; ++m) _Pragma("unroll") for (int n = 0; n < 2; ++n) _Pragma("unroll") for (int k = 0; k < 2; ++k) \
        acc[ai][bj][m][n] = __builtin_amdgcn_mfma_f32_16x16x32_bf16(Bt[n][k], At[m][k], acc[ai][bj][m][n], 0, 0, 0); __builtin_amdgcn_s_setprio(0); } while (0)
#define PG8_WAIT_V(n) asm volatile("s_waitcnt vmcnt(" #n ")" ::: "memory")
#define PG8_WAIT_L(n) asm volatile("s_waitcnt lgkmcnt(" #n ")" ::: "memory")
#define PG8_BAR __builtin_amdgcn_s_barrier()
#define PG8_SCHED __builtin_amdgcn_sched_barrier(0)
    Unit cur, nxt; int ui = 0;
    if (!S.next(0, cur)) return;
    f32x4 acc[2][2][4][2];
#pragma unroll
    for (int a = 0; a < 2; ++a)
#pragma unroll
        for (int b = 0; b < 2; ++b)
#pragma unroll
            for (int m = 0; m < 4; ++m)
#pragma unroll
                for (int n = 0; n < 2; ++n) acc[a][b][m][n] = (f32x4){0.f, 0.f, 0.f, 0.f};
    bf16x8 At[4][2], B0[2][2], B1[2][2];
    const char* cA = cur.a; const char* cB = cur.b;
    PG8_STAGE(PG8_SB(0, 0), cB, voffB); PG8_STAGE(PG8_SA(0, 0), cA, voffA); PG8_STAGE(PG8_SB(0, 1), cB + hstep, voffB); PG8_STAGE(PG8_SA(0, 1), cA + hstep, voffA);
    if (wr == 1) PG8_BAR;
    PG8_WAIT_V(4); PG8_BAR;
    PG8_STAGE(PG8_SB(1, 0), cB + kstep, voffB); PG8_STAGE(PG8_SA(1, 0), cA + kstep, voffA); PG8_STAGE(PG8_SB(1, 1), cB + hstep + kstep, voffB);
    PG8_WAIT_V(6); PG8_BAR;
    for (;;) {
        const bool has_next = S.next(ui + 1, nxt);
        const char* nA = has_next ? nxt.a : cA; const char* nB = has_next ? nxt.b : cB;
        for (int t = 0; t < nt; t += 2) {
            const bool last = (t == nt - 2);
            const char* a1 = cA + (size_t)(t + 1) * kstep;
            const char* a2 = last ? nA : cA + (size_t)(t + 2) * kstep; const char* b2 = last ? nB : cB + (size_t)(t + 2) * kstep;
            const char* a3 = a2 + kstep; const char* b3 = b2 + kstep;
            PG8_LDB(B0, 0, 0); PG8_SCHED; PG8_LDA(At, 0, 0); PG8_STAGE(PG8_SA(1, 1), a1 + hstep, voffA);
            PG8_WAIT_L(8); PG8_BAR; PG8_WAIT_L(0); PG8_MMA(0, 0, At, B0); PG8_BAR; PG8_SCHED;
            PG8_LDB(B1, 0, 1); PG8_STAGE(PG8_SB(0, 0), b2, voffB);
            PG8_BAR; PG8_WAIT_L(0); PG8_MMA(0, 1, At, B1); PG8_BAR;
            PG8_LDA(At, 0, 1); PG8_STAGE(PG8_SA(0, 0), a2, voffA);
            PG8_BAR; PG8_WAIT_L(0); PG8_MMA(1, 0, At, B0); PG8_BAR; PG8_SCHED;
            PG8_STAGE(PG8_SB(0, 1), b2 + hstep, voffB);
            PG8_WAIT_V(6); PG8_BAR; PG8_MMA(1, 1, At, B1); PG8_BAR;
            PG8_LDB(B0, 1, 0); PG8_SCHED; PG8_LDA(At, 1, 0); PG8_STAGE(PG8_SA(0, 1), a2 + hstep, voffA);
            PG8_WAIT_L(8); PG8_BAR; PG8_WAIT_L(0); PG8_MMA(0, 0, At, B0); PG8_BAR; PG8_SCHED;
            PG8_LDB(B1, 1, 1); PG8_STAGE(PG8_SB(1, 0), b3, voffB);
            PG8_BAR; PG8_WAIT_L(0); PG8_MMA(0, 1, At, B1); PG8_BAR;
            PG8_LDA(At, 1, 1); PG8_STAGE(PG8_SA(1, 0), a3, voffA);
            PG8_BAR; PG8_WAIT_L(0); PG8_MMA(1, 0, At, B0); PG8_BAR; PG8_SCHED;
            PG8_STAGE(PG8_SB(1, 1), b3 + hstep, voffB);
            PG8_WAIT_V(6); PG8_BAR; PG8_MMA(1, 1, At, B1); PG8_BAR;
        }
        E(acc, cur, wr, wc, fr, fq);
        if (!has_next) break;
#pragma unroll
        for (int a = 0; a < 2; ++a)
#pragma unroll
            for (int b = 0; b < 2; ++b)
#pragma unroll
                for (int m = 0; m < 4; ++m)
#pragma unroll
                    for (int n = 0; n < 2; ++n) acc[a][b][m][n] = (f32x4){0.f, 0.f, 0.f, 0.f};
        cur = nxt; cA = nA; cB = nB; ++ui;
    }
    PG8_WAIT_V(0);
    if (wr == 0) PG8_BAR;
    PG8_BAR;
#undef PG8_SA
#undef PG8_SB
#undef PG8_STAGE
#undef PG8_LDA
#undef PG8_LDB
#undef PG8_MMA
#undef PG8_WAIT_V
#undef PG8_WAIT_L
#undef PG8_BAR
#undef PG8_SCHED
}
}

__device__ __forceinline__ void norm_rows(const DP& p, int mode, const float* gain) {
    const int lane = p.tid & 63, gw = p.bid * 8 + (p.tid >> 6), nw = p.nb * 8;
    float* tail = (float*)(p.ws_() + WS_TAIL); bf16_t* hn = (bf16_t*)(p.ws_() + WS_XA);
    const int nrows = (mode == 2) ? TREAL : TP;
    f32x4 g[8];
#pragma unroll
    for (int j = 0; j < 8; ++j) g[j] = *(const f32x4*)(gain + 4 * (lane + 64 * j));
    for (int r = gw; r < nrows; r += nw) {
        if (r >= TTOK) {
#pragma unroll
            for (int j = 0; j < 8; ++j) { *(u32x2*)(hn + (size_t)r * DM + 4 * (lane + 64 * j)) = (u32x2){0u, 0u};
                if (mode == 0) *(f32x4*)(tail + (size_t)(r - TREAL) * DM + 4 * (lane + 64 * j)) = (f32x4){0.f, 0.f, 0.f, 0.f}; }
            continue;
        }
        float* hrow = (r < TREAL) ? p.out_() + (size_t)r * DM : tail + (size_t)(r - TREAL) * DM;
        const float* src = hrow;
        if (mode == 0) src = (r < 16384) ? p.in_(0) + (size_t)r * DM : (r < TREAL) ? p.in_(1) + (size_t)(r - 16384) * DM : p.in_(2) + (size_t)((r - TREAL) & 15) * DM;
        f32x4 v[8]; float ss = 0.f;
#pragma unroll
        for (int j = 0; j < 8; ++j) { v[j] = *(const f32x4*)(src + 4 * (lane + 64 * j)); ss += v[j][0] * v[j][0] + v[j][1] * v[j][1] + v[j][2] * v[j][2] + v[j][3] * v[j][3]; }
        ss = wave_sum(ss);
        const float rstd = 1.0f / sqrtf(ss * (1.0f / DM) + EPSN);
#pragma unroll
        for (int j = 0; j < 8; ++j) {
            const f32x4 o = v[j] * rstd * g[j];
            if (mode == 0) *(f32x4*)(hrow + 4 * (lane + 64 * j)) = v[j];
            if (mode == 2) *(f32x4*)(hrow + 4 * (lane + 64 * j)) = o;
            else { u32x2 w; w.x = cvt_pk_bf16(o[0], o[1]); w.y = cvt_pk_bf16(o[2], o[3]); *(u32x2*)(hn + (size_t)r * DM + 4 * (lane + 64 * j)) = w; }
        }
    }
}

__device__ __forceinline__ void transpose_cvt(const DP& p, LAS unsigned char* lds, const float* src, int K, int N, bf16_t* dst, int ldd, int koff, int mode) {
    LAS float* tile = (LAS float*)lds;
    const int tid = p.tid, nkt = K / 64, nnt = N / 64;
    for (int t = p.bid; t < nkt * nnt; t += p.nb) {
        const int k0 = (t / nnt) * 64, n0 = (t % nnt) * 64;
#pragma unroll
        for (int it = 0; it < 2; ++it) { const int e = tid + it * 512, kk = e >> 4, n4 = e & 15;
            const f32x4 v = *(const f32x4*)(src + (size_t)(k0 + kk) * N + n0 + 4 * n4);
            tile[kk * 65 + 4 * n4 + 0] = v[0]; tile[kk * 65 + 4 * n4 + 1] = v[1]; tile[kk * 65 + 4 * n4 + 2] = v[2]; tile[kk * 65 + 4 * n4 + 3] = v[3]; }
        __syncthreads();
        { const int nn = tid >> 3, k8 = tid & 7; float f[8];
#pragma unroll
          for (int j = 0; j < 8; ++j) f[j] = tile[(8 * k8 + j) * 65 + nn];
          const int n = n0 + nn; const int drow = (mode == 0) ? n : ((n >> 7) * 256 + (n & 127) + (mode == 2 ? 128 : 0));
          u32x4 w; w.x = cvt_pk_bf16(f[0], f[1]); w.y = cvt_pk_bf16(f[2], f[3]); w.z = cvt_pk_bf16(f[4], f[5]); w.w = cvt_pk_bf16(f[6], f[7]);
          *(u32x4*)(dst + (size_t)drow * ldd + koff + k0 + 8 * k8) = w; }
        __syncthreads();
    }
}
__device__ __forceinline__ void fold_pool(const DP& p, const float* pw, const float* sc, const float* wo, bf16_t* dst) {
    const int tid = p.tid;
    for (int it = p.bid; it < 512; it += p.nb) {
        const int g = it >> 7, c8 = (it >> 2) & 31, n = (it & 3) * 512 + tid;
        float acc[8];
#pragma unroll
        for (int e = 0; e < 8; ++e) acc[e] = 0.f;
        const float* pwr = pw + (size_t)(g * 256 + c8 * 8) * 256;
        for (int d = 0; d < 256; ++d) {
            const float wv = wo[(size_t)(g * 256 + d) * DM + n] * sc[g * 256 + d];
#pragma unroll
            for (int e = 0; e < 8; ++e) acc[e] += pwr[e * 256 + d] * wv;
        }
        u32x4 w; w.x = cvt_pk_bf16(acc[0], acc[1]); w.y = cvt_pk_bf16(acc[2], acc[3]); w.z = cvt_pk_bf16(acc[4], acc[5]); w.w = cvt_pk_bf16(acc[6], acc[7]);
        *(u32x4*)(dst + (size_t)n * DM + g * 256 + c8 * 8) = w;
    }
}
__device__ __forceinline__ void prep_weights(const DP& p, LAS unsigned char* lds, int l) {
    transpose_cvt(p, lds, p.in_(4) + (size_t)l * DM * 4096, DM, 4096, (bf16_t*)(p.ws_() + WS_WIN), DM, 0, 0);
    transpose_cvt(p, lds, p.in_(18) + (size_t)l * DM * DM + (size_t)1024 * DM, 1024, DM, (bf16_t*)(p.ws_() + WS_WOUT), DM, 1024, 0);
    transpose_cvt(p, lds, p.in_(20) + (size_t)l * DM * DFF, DM, DFF, (bf16_t*)(p.ws_() + WS_WGU), DM, 0, 1);
    transpose_cvt(p, lds, p.in_(21) + (size_t)l * DM * DFF, DM, DFF, (bf16_t*)(p.ws_() + WS_WGU), DM, 0, 2);
    transpose_cvt(p, lds, p.in_(22) + (size_t)l * DFF * DM, DFF, DM, (bf16_t*)(p.ws_() + WS_WDN), DFF, 0, 0);
    fold_pool(p, p.in_(5) + (size_t)l * 4 * 256 * 256, p.in_(6) + (size_t)l * 1024, p.in_(18) + (size_t)l * DM * DM, (bf16_t*)(p.ws_() + WS_WOUT));
    { const float* w4 = p.in_(16) + (size_t)l * 64 * 4096; float* w4t = (float*)(p.ws_() + WS_W4T);
      for (int i = p.bid * NTHREADS + p.tid; i < 4096 * 64; i += p.nb * NTHREADS) w4t[i] = w4[(size_t)(i & 63) * 4096 + (i >> 6)]; }
}

__device__ __forceinline__ void mlp_layer(LAS float* hl, int lane, int nin, const float* w, const float* b, const float* fr) {
    float acc[64];
#pragma unroll
    for (int j = 0; j < 64; ++j) acc[j] = b[j];
#pragma unroll 1
    for (int i = 0; i < nin; ++i) {
        const float hv = hl[i * 64 + lane];
#pragma unroll
        for (int j = 0; j < 64; ++j) acc[j] += hv * w[i * 64 + j];
    }
#pragma unroll
    for (int j = 0; j < 64; ++j) hl[j * 64 + lane] = __sinf(fr[j] * acc[j]);
}
__device__ __forceinline__ void filter_h3(const DP& p, LAS unsigned char* lds, int l) {
    const int lane = p.tid & 63, wv = __builtin_amdgcn_readfirstlane(p.tid >> 6), gw = __builtin_amdgcn_readfirstlane(p.bid * 8 + (p.tid >> 6)), nw = p.nb * 8;
    const float* w1 = p.in_(9) + (size_t)l * 33 * 64; const float* b1 = p.in_(10) + l * 64;
    const float* w2 = p.in_(11) + (size_t)l * 64 * 64; const float* b2 = p.in_(12) + l * 64;
    const float* w3 = p.in_(13) + (size_t)l * 64 * 64; const float* b3 = p.in_(14) + l * 64;
    const float* fr = p.in_(15) + l * 64;
    float* h3 = (float*)(p.ws_() + WS_H3);
    LAS float* hl = (LAS float*)lds + wv * 4096;
    for (int item = gw; item < 129 + 65; item += nw) {
        const int tr = item < 129 ? 1 : 0, tile = tr ? item : item - 129, L = tr ? 8208 : 4112;
        const int n = tile * 64 + lane; const bool valid = n < L;
        const float nf = (float)n, t = nf / (float)(L - 1);
        hl[lane] = t;
#pragma unroll
        for (int b = 0; b < 16; ++b) { const float band = 1e-4f + (float)b * ((15.0f - 1e-4f) / 15.0f);
            const float ang = (6.283185307179586f / (float)L) * nf * band; hl[(1 + b) * 64 + lane] = __cosf(ang); hl[(17 + b) * 64 + lane] = -__sinf(ang); }
        mlp_layer(hl, lane, 33, w1, b1, fr);
        mlp_layer(hl, lane, 64, w2, b2, fr);
        mlp_layer(hl, lane, 64, w3, b3, fr);
        if (valid) { float* o = h3 + (size_t)((tr ? 0 : 8208) + n) * 64;
#pragma unroll
            for (int j = 0; j < 16; ++j) *(f32x4*)(o + 4 * j) = (f32x4){hl[(4 * j) * 64 + lane], hl[(4 * j + 1) * 64 + lane], hl[(4 * j + 2) * 64 + lane], hl[(4 * j + 3) * 64 + lane]}; }
    }
}
__device__ __forceinline__ void filter_gen(const DP& p, int l) {
    const int lane = p.tid & 63, gw = __builtin_amdgcn_readfirstlane(p.bid * 8 + (p.tid >> 6)), nw = p.nb * 8;
    const float* w4t = (const float*)(p.ws_() + WS_W4T); const float* h3 = (const float*)(p.ws_() + WS_H3);
    const float* skip = p.in_(17) + (size_t)l * 2 * 1024;
    const int NS = 129 * 32, NPI = 65 * 32;
    for (int item = gw; item < NS + NPI; item += nw) {
        const int tr = item < NS ? 1 : 0, it2 = tr ? item : item - NS;
        const int L = tr ? 8208 : 4112, GL = 2 * L;
        const int tile = it2 >> 5, o = (it2 >> 4) & 1, chunk = it2 & 15;
        const int n = tile * 64 + lane; const bool valid = n < L; const int nc = valid ? n : L - 1;
        const float t = (float)nc / (float)(L - 1);
        float h[64];
        { const float* hr = h3 + (size_t)((tr ? 0 : 8208) + nc) * 64;
#pragma unroll
          for (int j = 0; j < 16; ++j) { const f32x4 v = *(const f32x4*)(hr + 4 * j); h[4 * j] = v[0]; h[4 * j + 1] = v[1]; h[4 * j + 2] = v[2]; h[4 * j + 3] = v[3]; } }
        bf16_t* gbase = (bf16_t*)(p.ws_() + (tr ? WS_GFS : WS_GFP)) + (size_t)o * 1024 * GL;
        for (int cc = 0; cc < 64; ++cc) {
            const int c = chunk * 64 + cc;
            const float* wa = w4t + (size_t)(o * 2048 + c) * 64; const float* wb = wa + (size_t)1024 * 64;
            float v0 = 0.f, v1 = 0.f;
#pragma unroll
            for (int j = 0; j < 64; ++j) { v0 += h[j] * wa[j]; v1 += h[j] * wb[j]; }
            const float d0 = -3.0701134573253946f, d1 = -15.350567286626973f;
            const float adel = fabsf(d0 + (float)c * ((d1 - d0) / 1023.0f));
            const float dec = expf(-t * adel);
            float kf = v0 * dec; const float kb = v1 * dec;
            if (n == 0) kf += skip[o * 1024 + c];
            bf16_t* row = gbase + (size_t)c * GL;
            if (valid) { row[L - 1 - n] = f2bf(kf); if (n >= 1) row[L - 1 + n] = f2bf(kb); else row[GL - 1] = 0; }
        }
    }
}

__device__ __forceinline__ void pool_window(const DP& p) {
    const bf16_t* P = (const bf16_t*)(p.ws_() + WS_P); bf16_t* mix = (bf16_t*)(p.ws_() + WS_XA);
    const int total = TTOK * 128;
    for (int idx = p.bid * NTHREADS + p.tid; idx < total; idx += p.nb * NTHREADS) {
        const int tok = idx >> 7, c8 = idx & 127;
        int sq, pp, L;
        if (tok < 4 * 4112) { sq = tok / 4112; pp = tok - sq * 4112; L = 4112; } else { const int t2 = tok - 4 * 4112; sq = 4 + t2 / 8208; pp = t2 - (sq - 4) * 8208; L = 8208; }
        const int hw = 1 << (c8 >> 5);
        const int lo = pp - hw < 0 ? 0 : pp - hw, hi = pp + hw > L ? L : pp + hw;
        float s[8];
#pragma unroll
        for (int e = 0; e < 8; ++e) s[e] = 0.f;
        for (int q = lo; q < hi; ++q) {
            const u32x4 v = *(const u32x4*)(P + (size_t)seq_row(sq, q) * 1024 + 8 * c8);
            s[0] += bflo(v.x); s[1] += bfhi(v.x); s[2] += bflo(v.y); s[3] += bfhi(v.y); s[4] += bflo(v.z); s[5] += bfhi(v.z); s[6] += bflo(v.w); s[7] += bfhi(v.w);
        }
        const float inv = 1.0f / (float)(hi - lo);
        const int row = seq_row(sq, pp);
        const u32x4 v = *(const u32x4*)(P + (size_t)row * 1024 + 8 * c8);
        u32x4 w;
        w.x = cvt_pk_bf16(s[0] * inv - bflo(v.x), s[1] * inv - bfhi(v.x)); w.y = cvt_pk_bf16(s[2] * inv - bflo(v.y), s[3] * inv - bfhi(v.y));
        w.z = cvt_pk_bf16(s[4] * inv - bflo(v.z), s[5] * inv - bfhi(v.z)); w.w = cvt_pk_bf16(s[6] * inv - bflo(v.w), s[7] * inv - bfhi(v.w));
        *(u32x4*)(mix + (size_t)row * DM + 8 * c8) = w;
    }
}

constexpr int HY_U = 0, HY_X1 = 41216, HY_X2 = HY_X1 + 32896, HY_FB = HY_X2 + 32896, HY_RED = HY_FB + 33024, HY_END = HY_RED + 2048;
static_assert(HY_END <= LDS_BYTES, "hyena LDS");
constexpr int FPAD = 48, UPAD = 512;

struct HyGeo { int L, B, NBLK, NIN, nbt, URS; };

__device__ __forceinline__ void hy_conv(LAS unsigned char* lds, const HyGeo& G, int wave, int lane, f32x16& acc0, f32x16& acc1) {
    const LAS bf16_t* U = (const LAS bf16_t*)(lds + HY_U); const LAS bf16_t* FB = (const LAS bf16_t*)(lds + HY_FB);
    const int r = lane & 31, h = lane >> 5;
    const int beta = r % G.B, bo = r / G.B;
    const int t0 = 2 * wave, t1 = 2 * wave + 1;
    const int ub0 = beta * G.URS + UPAD + 32 * (t0 * G.nbt + bo) + 8 * h;
    const int ub1 = ub0 + 32 * G.nbt;
    const int ab = FPAD + (G.L - 1) - r + 8 * h;
    const int dlo = 32 * (t0 * G.nbt) - 16 * (G.NIN - 1), dhi = 32 * (t1 * G.nbt + G.nbt - 1);
    const int d0hi = 32 * (t0 * G.nbt + G.nbt - 1), d1lo = 32 * (t1 * G.nbt) - 16 * (G.NIN - 1);
#pragma unroll
    for (int i = 0; i < 16; ++i) { acc0[i] = 0.f; acc1[i] = 0.f; }
#pragma unroll 2
    for (int d = dlo; d <= dhi; d += 16) {
        bf16x8 a;
        const LAS bf16_t* ap = FB + (ab - d);
#pragma unroll
        for (int j = 0; j < 8; ++j) a[j] = (short)ap[j];
        if (d <= d0hi) { const bf16x8 b = *(const LAS bf16x8*)(U + (ub0 - d)); acc0 = __builtin_amdgcn_mfma_f32_32x32x16_bf16(a, b, acc0, 0, 0, 0); }
        if (d >= d1lo) { const bf16x8 b = *(const LAS bf16x8*)(U + (ub1 - d)); acc1 = __builtin_amdgcn_mfma_f32_32x32x16_bf16(a, b, acc1, 0, 0, 0); }
    }
    {
        f32x16 at;
#pragma unroll
        for (int i = 0; i < 16; ++i) at[i] = 0.f;
        const int MS = (G.NIN + 7) / 8, m0 = wave * MS, m1 = (m0 + MS < G.NIN) ? m0 + MS : G.NIN;
        const int blkT = G.NBLK - 1;
        const bool colv = r < G.B;
        const int ubt = (colv ? r : 0) * G.URS + UPAD + 8 * h;
        for (int m = m0; m < m1; ++m) {
            const int d = 32 * blkT - 16 * m;
            bf16x8 a;
            const LAS bf16_t* ap = FB + (ab - d);
#pragma unroll
            for (int j = 0; j < 8; ++j) a[j] = (short)ap[j];
            bf16x8 b = *(const LAS bf16x8*)(U + (ubt + 16 * m));
            if (!colv) b = (bf16x8){0, 0, 0, 0, 0, 0, 0, 0};
            at = __builtin_amdgcn_mfma_f32_32x32x16_bf16(a, b, at, 0, 0, 0);
        }
        LAS float* RED = (LAS float*)(lds + HY_RED);
        if (colv) {
#pragma unroll
            for (int i = 0; i < 8; ++i) { const int arow = (i & 3) + 8 * (i >> 2) + 4 * h; RED[(wave * 16 + arow) * 4 + r] = at[i]; }
        }
    }
}

__device__ __forceinline__ void hyena_phase(const DP& p, LAS unsigned char* lds, int l) {
    const int tid = p.tid, lane = tid & 63, wave = __builtin_amdgcn_readfirstlane(tid >> 6);
    const int Gd = p.nb, bx = p.bid;
    const int vcu = (Gd % 8 == 0) ? (bx % 8) * (Gd / 8) + bx / 8 : bx;
    const bf16_t* UT = (const bf16_t*)(p.ws_() + WS_UT); bf16_t* mix = (bf16_t*)(p.ws_() + WS_XA);
    const float* cw = p.in_(7) + (size_t)l * 3 * 3072; const float* cb = p.in_(8) + (size_t)l * 3072;
    LAS bf16_t* U = (LAS bf16_t*)(lds + HY_U); LAS bf16_t* X1 = (LAS bf16_t*)(lds + HY_X1); LAS bf16_t* X2 = (LAS bf16_t*)(lds + HY_X2);
    LAS bf16_t* FB = (LAS bf16_t*)(lds + HY_FB); LAS float* RED = (LAS float*)(lds + HY_RED);
    for (int item = vcu; item < 2048; item += Gd) {
        const int tr = item < 1024 ? 1 : 0, c = item & 1023;
        HyGeo G; if (tr) G = HyGeo{8208, 2, 257, 513, 16, 9232}; else G = HyGeo{4112, 4, 129, 257, 8, 5136};
        const int L = G.L, GL = 2 * L, sq0 = tr ? 4 : 0;
        const bf16_t* gf = (const bf16_t*)(p.ws_() + (tr ? WS_GFS : WS_GFP)) + (size_t)c * GL;
        if (tid < G.B * 128) { const int b = tid >> 7, q = tid & 127; const int off = b * G.URS + (q < 64 ? 8 * q : UPAD + L + 8 * (q - 64));
            *(LAS u32x4*)(U + off) = (u32x4){0u, 0u, 0u, 0u}; }
        if (tid < FPAD / 8) *(LAS u32x4*)(FB + 8 * tid) = (u32x4){0u, 0u, 0u, 0u};
        const int nch = L / 8;
#pragma unroll 1
        for (int k = 0; k < 3; ++k) {
            const int ch = k * 1024 + c;
            const float w0 = cw[ch], w1 = cw[3072 + ch], w2 = cw[2 * 3072 + ch], bb = cb[ch];
            const bf16_t* src = UT + (size_t)ch * TP;
            for (int idx = tid; idx < G.B * nch; idx += NTHREADS) {
                const int b = idx / nch, q = idx - b * nch, p0 = 8 * q, sq = sq0 + b;
                const int moff = TREAL + 16 * sq, roff = seq_rbase(sq);
                const int off = p0 < 16 ? moff + p0 : roff + p0 - 16;
                const u32x4 v = *(const u32x4*)(src + off);
                float x[10];
                x[0] = (p0 == 0) ? 0.f : bf2f(p0 == 16 ? src[moff + 15] : src[off - 1]);
                x[9] = (p0 + 8 >= L) ? 0.f : bf2f(p0 + 8 == 16 ? src[roff] : src[off + 8]);
                x[1] = bflo(v.x); x[2] = bfhi(v.x); x[3] = bflo(v.y); x[4] = bfhi(v.y); x[5] = bflo(v.z); x[6] = bfhi(v.z); x[7] = bflo(v.w); x[8] = bfhi(v.w);
                float y[8];
#pragma unroll
                for (int j = 0; j < 8; ++j) y[j] = w0 * x[j] + w1 * x[j + 1] + w2 * x[j + 2] + bb;
                u32x4 w; w.x = cvt_pk_bf16(y[0], y[1]); w.y = cvt_pk_bf16(y[2], y[3]); w.z = cvt_pk_bf16(y[4], y[5]); w.w = cvt_pk_bf16(y[6], y[7]);
                LAS bf16_t* dst = (k == 0) ? U + b * G.URS + UPAD + p0 : (k == 1) ? X1 + b * L + p0 : X2 + b * L + p0;
                *(LAS u32x4*)dst = w;
            }
        }
        for (int idx = tid; idx < GL / 8; idx += NTHREADS) *(LAS u32x4*)(FB + FPAD + 8 * idx) = *(const u32x4*)(gf + 8 * idx);
        __syncthreads();
        const int r = lane & 31, hh = lane >> 5, beta = r % G.B, bo = r / G.B;
        f32x16 acc0, acc1;
        hy_conv(lds, G, wave, lane, acc0, acc1);
        __syncthreads();
        for (int idx = tid; idx < GL / 8; idx += NTHREADS) *(LAS u32x4*)(FB + FPAD + 8 * idx) = *(const u32x4*)(gf + (size_t)1024 * GL + 8 * idx);
#pragma unroll
        for (int tt = 0; tt < 2; ++tt) {
            const int blk = (2 * wave + tt) * G.nbt + bo;
#pragma unroll
            for (int qd = 0; qd < 4; ++qd) {
                const int tpos = 32 * blk + 8 * qd + 4 * hh;
                const u32x2 xv = *(const LAS u32x2*)(X1 + beta * L + tpos);
                float y[4];
#pragma unroll
                for (int e = 0; e < 4; ++e) y[e] = tt ? acc1[4 * qd + e] : acc0[4 * qd + e];
                u32x2 w; w.x = cvt_pk_bf16(bflo(xv.x) * y[0], bfhi(xv.x) * y[1]); w.y = cvt_pk_bf16(bflo(xv.y) * y[2], bfhi(xv.y) * y[3]);
                *(LAS u32x2*)(U + beta * G.URS + UPAD + tpos) = w;
            }
        }
        if (tid < 16 * G.B) { const int a = tid & 15, b = tid >> 4; float y = 0.f;
#pragma unroll
            for (int w = 0; w < 8; ++w) y += RED[(w * 16 + a) * 4 + b];
            const int tpos = 32 * (G.NBLK - 1) + a;
            U[b * G.URS + UPAD + tpos] = f2bf(bf2f(X1[b * L + tpos]) * y); }
        __syncthreads();
        hy_conv(lds, G, wave, lane, acc0, acc1);
        __syncthreads();
#pragma unroll
        for (int tt = 0; tt < 2; ++tt) {
            const int blk = (2 * wave + tt) * G.nbt + bo; const int sq = sq0 + beta;
#pragma unroll
            for (int qd = 0; qd < 4; ++qd) {
                const int tpos = 32 * blk + 8 * qd + 4 * hh;
                const u32x2 xv = *(const LAS u32x2*)(X2 + beta * L + tpos);
                const float x2v[4] = {bflo(xv.x), bfhi(xv.x), bflo(xv.y), bfhi(xv.y)};
#pragma unroll
                for (int e = 0; e < 4; ++e) { const float y = tt ? acc1[4 * qd + e] : acc0[4 * qd + e];
                    mix[(size_t)seq_row(sq, tpos + e) * DM + 1024 + c] = f2bf(x2v[e] * y); }
            }
        }
        if (tid < 16 * G.B) { const int a = tid & 15, b = tid >> 4; float y = 0.f;
#pragma unroll
            for (int w = 0; w < 8; ++w) y += RED[(w * 16 + a) * 4 + b];
            const int tpos = 32 * (G.NBLK - 1) + a;
            mix[(size_t)seq_row(sq0 + b, tpos) * DM + 1024 + c] = f2bf(bf2f(X2[b * L + tpos]) * y); }
        __syncthreads();
    }
}

constexpr int NPHASES = 15;
__device__ __forceinline__ void run_phase(const DP& p, LAS unsigned char* lds, int ph) {
    const int l = (ph == 0) ? 0 : (ph - 1) / 7, k = (ph == 0) ? 0 : 1 + (ph - 1) % 7;
    const int G = p.nb, cbx = p.bid;
    bf16_t* XA = (bf16_t*)(p.ws_() + WS_XA);
    switch (k) {
#if (PHMASK >> 0) & 1
    case 0: {
#if SUB & 1
        norm_rows(p, 0, p.in_(3));
#endif
#if SUB & 2
        prep_weights(p, lds, 0);
#endif
#if SUB & 4
        __syncthreads(); filter_h3(p, lds, 0);
#endif
    } break;
#endif
#if (PHMASK >> 1) & 1
    case 1: {
        pg8::Prob p0{XA, (const bf16_t*)(p.ws_() + WS_WIN), TP / 256, 4};
        pg8::Prob p1{(const bf16_t*)(p.ws_() + WS_WIN) + (size_t)1024 * DM, XA, 12, TP / 256};
        pg8::Sched2 S; S.init(p0, p1, DM, G, cbx);
        pg8::EpiStore E{{(bf16_t*)(p.ws_() + WS_P), (bf16_t*)(p.ws_() + WS_UT)}, {1024, TP}};
        pg8::gemm_phase<pg8::EpiStore, pg8::Sched2>(p, lds, S, E);
        filter_gen(p, l);
    } break;
#endif
#if (PHMASK >> 2) & 1
    case 2: {
        hyena_phase(p, lds, l);
        pool_window(p);
    } break;
#endif
#if (PHMASK >> 3) & 1
    case 3: {
        pg8::Prob p0{XA, (const bf16_t*)(p.ws_() + WS_WOUT), l == 0 ? TP / 256 : TREAL / 256, DM / 256};
        pg8::Prob p1{XA, XA, 0, 0};
        pg8::Sched2 S; S.init(p0, p1, DM, G, cbx);
        pg8::EpiResid E{p.out_(), (float*)(p.ws_() + WS_TAIL)};
        pg8::gemm_phase<pg8::EpiResid, pg8::Sched2>(p, lds, S, E);
    } break;
#endif
#if (PHMASK >> 4) & 1
    case 4: norm_rows(p, 1, p.in_(19) + (size_t)l * DM); break;
#endif
#if (PHMASK >> 5) & 1
    case 5: {
        pg8::Prob p0{XA, (const bf16_t*)(p.ws_() + WS_WGU), l == 0 ? TP / 256 : TREAL / 256, 2 * DFF / 256};
        pg8::Prob p1{XA, XA, 0, 0};
        pg8::Sched2 S; S.init(p0, p1, DM, G, cbx);
        pg8::EpiSwiGLU E{(bf16_t*)(p.ws_() + WS_HID)};
        pg8::gemm_phase<pg8::EpiSwiGLU, pg8::Sched2>(p, lds, S, E);
    } break;
#endif
#if (PHMASK >> 6) & 1
    case 6: {
        pg8::Prob p0{(const bf16_t*)(p.ws_() + WS_HID), (const bf16_t*)(p.ws_() + WS_WDN), l == 0 ? TP / 256 : TREAL / 256, DM / 256};
        pg8::Prob p1{XA, XA, 0, 0};
        pg8::Sched2 S; S.init(p0, p1, DFF, G, cbx);
        pg8::EpiResid E{p.out_(), (float*)(p.ws_() + WS_TAIL)};
        pg8::gemm_phase<pg8::EpiResid, pg8::Sched2>(p, lds, S, E);
    } break;
#endif
#if (PHMASK >> 7) & 1
    case 7: {
        if (l == 0) { norm_rows(p, 1, p.in_(3) + DM); prep_weights(p, lds, 1); __syncthreads(); filter_h3(p, lds, 1); }
        else norm_rows(p, 2, p.in_(23));
    } break;
#endif
    }
}

__global__ void __launch_bounds__(NTHREADS, 2) mega_fwd(Params pk, int ph_lo, int ph_hi) {
    DP p;
    extern __shared__ __attribute__((aligned(16))) unsigned char lds_raw[];
    LAS unsigned char* lds = (LAS unsigned char*)lds_raw;
    cg::grid_group grid = cg::this_grid();
    for (int ph = ph_lo; ph < ph_hi; ++ph) {
        { kseg_t ks = (kseg_t)__builtin_amdgcn_kernarg_segment_ptr(); int t = threadIdx.x, b = blockIdx.x, n = gridDim.x;
          asm volatile("" : "+s"(ks), "+v"(t), "+s"(b), "+s"(n));
          p.ks = ks; p.tid = t; p.bid = b; p.nb = n; }
        run_phase(p, lds, ph);
        if (ph + 1 < ph_hi) grid.sync();
    }
}

extern "C" void kernel_launch(void* const* d_in, const int* in_sizes, int n_in, void* d_out, int out_size, void* d_ws, size_t ws_size, hipStream_t stream) {
    static int grid = 0;
    if (grid == 0) {
        if (n_in != 24 || ws_size < WS_END) { fprintf(stderr, "kernel_launch: need 24 inputs and %zu bytes of workspace (got %d, %zu)\n", (size_t)WS_END, n_in, ws_size); grid = -1; return; }
        int dev = 0, cus = 0, per_cu = 0;
        hipGetDevice(&dev);
        hipDeviceGetAttribute(&cus, hipDeviceAttributeMultiprocessorCount, dev);
        if (hipFuncSetAttribute((const void*)mega_fwd, hipFuncAttributeMaxDynamicSharedMemorySize, LDS_BYTES) != hipSuccess) { fprintf(stderr, "hipFuncSetAttribute failed\n"); grid = -1; return; }
        hipOccupancyMaxActiveBlocksPerMultiprocessor(&per_cu, (const void*)mega_fwd, NTHREADS, LDS_BYTES);
        if (per_cu < 1) per_cu = 1;
        (void)hipGetLastError();
        grid = cus;
    }
    if (grid < 0) return;
    Params p{};
    for (int i = 0; i < 24; ++i) p.in[i] = (const float*)d_in[i];
    p.out = (float*)d_out; p.ws = (unsigned char*)d_ws;
#if MEGA
    int lo = 0, hi = NPHASES;
    void* args[] = {&p, &lo, &hi};
    hipError_t e = hipLaunchCooperativeKernel((const void*)mega_fwd, dim3(grid), dim3(NTHREADS), args, LDS_BYTES, stream);
    if (e != hipSuccess) fprintf(stderr, "cooperative launch failed: %s (grid %d)\n", hipGetErrorString(e), grid);
#else
    for (int ph = 0; ph < NPHASES; ++ph) hipLaunchKernelGGL(mega_fwd, dim3(grid), dim3(NTHREADS), LDS_BYTES, stream, p, ph, ph + 1);
#endif
}
```

```cpp
#include <hip/hip_runtime.h>
#include <hip/hip_cooperative_groups.h>
#include <cstdio>
namespace cg = cooperative_groups;

#ifndef PHMASK
#define PHMASK 511
#endif
#ifndef SUB
#define SUB 7
#endif
#ifndef REPMASK
#define REPMASK 0
#endif
#ifndef MEGA
#define MEGA 1
#endif

#define LAS __attribute__((address_space(3)))
typedef unsigned short bf16_t;
typedef short bf16x8 __attribute__((ext_vector_type(8)));
typedef float f32x4 __attribute__((ext_vector_type(4)));
typedef float f32x16 __attribute__((ext_vector_type(16)));
typedef unsigned u32x4 __attribute__((ext_vector_type(4)));
typedef unsigned u32x2 __attribute__((ext_vector_type(2)));

constexpr int DM = 2048, TREAL = 32768, TTOK = 32864, TP = 33024, DFF = 5632;
constexpr int NTHREADS = 512;
constexpr int LDS_BYTES = 147456;
constexpr float EPSN = 1e-6f;

constexpr size_t WS_TAIL = 0;
constexpr size_t WS_XA   = WS_TAIL + (size_t)256 * DM * 4;
constexpr size_t WS_WIN  = WS_XA + (size_t)TP * DM * 2;
constexpr size_t WS_WOUT = WS_WIN + (size_t)4096 * DM * 2;
constexpr size_t WS_WGU  = WS_WOUT + (size_t)DM * DM * 2;
constexpr size_t WS_WDN  = WS_WGU + (size_t)2 * DFF * DM * 2;
constexpr size_t WS_H3   = WS_WDN + (size_t)DM * DFF * 2;
constexpr size_t WS_W4T  = WS_H3 + (size_t)(8208 + 4112) * 64 * 4;
constexpr size_t WS_BIG  = WS_W4T + (size_t)4096 * 64 * 4;
constexpr size_t WS_P    = WS_BIG;
constexpr size_t WS_UT   = WS_P + (size_t)TP * 1024 * 2;
constexpr size_t WS_GFS  = WS_UT + (size_t)3072 * TP * 2;
constexpr size_t WS_GFP  = WS_GFS + (size_t)2048 * 16416 * 2;
constexpr size_t WS_HID  = WS_BIG;
constexpr size_t WS_END  = WS_BIG + (size_t)TP * DFF * 2;
static_assert(WS_GFP + (size_t)2048 * 8224 * 2 <= WS_END, "big region");

struct Params {
    const float* in[24];
    float* out;
    unsigned char* ws;
};
typedef const __attribute__((address_space(4))) unsigned long long* kseg_t;
struct DP {
    kseg_t ks; int tid, bid, nb;
    __device__ __forceinline__ const float* in_(int k) const { return (const float*)ks[k]; }
    __device__ __forceinline__ float* out_() const { return (float*)ks[24]; }
    __device__ __forceinline__ unsigned char* ws_() const { return (unsigned char*)ks[25]; }
};

__device__ __forceinline__ unsigned cvt_pk_bf16(float lo, float hi) { unsigned r; asm volatile("v_cvt_pk_bf16_f32 %0, %1, %2" : "=v"(r) : "v"(lo), "v"(hi)); return r; }
__device__ __forceinline__ bf16_t f2bf(float f) { return (bf16_t)(cvt_pk_bf16(f, 0.f) & 0xffffu); }
__device__ __forceinline__ float bf2f(unsigned v) { return __uint_as_float(v << 16); }
__device__ __forceinline__ float bflo(unsigned w) { return __uint_as_float(w << 16); }
__device__ __forceinline__ float bfhi(unsigned w) { return __uint_as_float(w & 0xffff0000u); }
__device__ __forceinline__ float wave_sum(float v) {
#pragma unroll
    for (int o = 32; o >= 1; o >>= 1) v += __shfl_xor(v, o);
    return v;
}
__device__ __forceinline__ int seq_rbase(int sq) { return sq < 4 ? sq * 4096 : 16384 + (sq - 4) * 8192; }
__device__ __forceinline__ int seq_row(int sq, int p) { return p < 16 ? TREAL + 16 * sq + p : seq_rbase(sq) + p - 16; }

namespace pg8 {
constexpr int BM = 256, BK = 64, HALF = 128, HTB = HALF * BK * 2, STAGE_BYTES = 8 * HTB, NXCD = 8, WGM = 8;
__device__ __forceinline__ int lds_byte(int r, int c) { const int st = (r >> 4) * 2 + (c >> 5), rr = r & 15, cc = c & 31, ob = rr * 64 + cc * 2; return st * 1024 + (ob ^ (((ob >> 9) & 1) << 5)); }
__device__ __forceinline__ void stage_rc(int b, int& R, int& C) { const int st = b / 1024, sb = b % 1024, swz = sb ^ (((sb >> 9) & 1) << 5); R = (st >> 1) * 16 + swz / 64; C = (st & 1) * 32 + (swz % 64) / 2; }
__device__ __forceinline__ int perm32(int rho) { const int n = rho >> 4, i = rho & 15; return 8 * (i >> 2) + 4 * n + (i & 3); }

struct Unit { const char* a; const char* b; int pm, pn, prob; };
struct Prob { const bf16_t* A; const bf16_t* Bt; int nM, nN; };
struct Sched2 {
    const bf16_t* A0; const bf16_t* B0; const bf16_t* A1; const bf16_t* B1; int nM0, nN0, nM1, nN1, nwg0, nwg1; int K, G, c;
    __device__ __forceinline__ void init(const Prob& p0, const Prob& p1, int K_, int G_, int c_) { A0 = p0.A; B0 = p0.Bt; A1 = p1.A; B1 = p1.Bt; nM0 = p0.nM; nN0 = p0.nN; nM1 = p1.nM; nN1 = p1.nN;
        nwg0 = nM0 * nN0; nwg1 = nM1 * nN1; K = K_; G = G_; c = c_; }
    __device__ __forceinline__ bool next(int i, Unit& u) const {
        long L = (long)i * G + c; int q = 0;
        if (L >= nwg0) { L -= nwg0; q = 1; if (L >= nwg1) return false; }
        const int nM = q ? nM1 : nM0, nN = q ? nN1 : nN0, nw = q ? nwg1 : nwg0;
        int wgid = (int)L; { const int qq = nw / NXCD, r = nw % NXCD, xcd = wgid % NXCD, off = wgid / NXCD; wgid = (xcd < r ? xcd * (qq + 1) : r * (qq + 1) + (xcd - r) * qq) + off; }
        const int nig = WGM * nN, gid = wgid / nig, fm = gid * WGM, gsz = (nM - fm) < WGM ? (nM - fm) : WGM;
        u.pm = fm + ((wgid % nig) % gsz); u.pn = (wgid % nig) / gsz; u.prob = q;
        const size_t tstep = (size_t)BM * K * 2;
        u.a = (const char*)(q ? A1 : A0) + (size_t)u.pm * tstep; u.b = (const char*)(q ? B1 : B0) + (size_t)u.pn * tstep;
        return true;
    }
};

struct EpiStore {
    static constexpr bool PERM = true;
    bf16_t* O[2]; int ldc[2];
    __device__ __forceinline__ void operator()(const f32x4 (&acc)[2][2][4][2], const Unit& u, int wr, int wc, int fr, int fq) const {
        bf16_t* base = u.prob ? O[1] : O[0]; const int ld = u.prob ? ldc[1] : ldc[0];
        const int row0 = u.pm * BM + wr * 64 + fr, col0 = u.pn * BM + wc * 32 + 8 * fq;
#pragma unroll
        for (int ai = 0; ai < 2; ++ai)
#pragma unroll
            for (int m = 0; m < 4; ++m) { bf16_t* rowp = base + (size_t)(row0 + ai * HALF + m * 16) * ld + col0;
#pragma unroll
                for (int bj = 0; bj < 2; ++bj) { const f32x4 v0 = acc[ai][bj][m][0], v1 = acc[ai][bj][m][1];
                    u32x4 w; w.x = cvt_pk_bf16(v0[0], v0[1]); w.y = cvt_pk_bf16(v0[2], v0[3]); w.z = cvt_pk_bf16(v1[0], v1[1]); w.w = cvt_pk_bf16(v1[2], v1[3]);
                    *(u32x4*)(rowp + bj * HALF) = w; } }
    }
};
struct EpiResid {
    static constexpr bool PERM = false;
    float* hmain; float* htail;
    __device__ __forceinline__ void operator()(const f32x4 (&acc)[2][2][4][2], const Unit& u, int wr, int wc, int fr, int fq) const {
        float* base = (u.pm < TREAL / BM) ? hmain + (size_t)u.pm * BM * DM : htail;
        const int row0 = wr * 64 + fr, col0 = u.pn * BM + wc * 32 + 4 * fq;
#pragma unroll
        for (int ai = 0; ai < 2; ++ai)
#pragma unroll
            for (int m = 0; m < 4; ++m) { float* rowp = base + (size_t)(row0 + ai * HALF + m * 16) * DM + col0;
#pragma unroll
                for (int bj = 0; bj < 2; ++bj)
#pragma unroll
                    for (int n = 0; n < 2; ++n) { f32x4* p = (f32x4*)(rowp + bj * HALF + n * 16); *p = *p + acc[ai][bj][m][n]; } }
    }
};
struct EpiSwiGLU {
    static constexpr bool PERM = true;
    bf16_t* O;
    __device__ __forceinline__ void operator()(const f32x4 (&acc)[2][2][4][2], const Unit& u, int wr, int wc, int fr, int fq) const {
        const int row0 = u.pm * BM + wr * 64 + fr, col0 = u.pn * HALF + wc * 32 + 8 * fq;
#pragma unroll
        for (int ai = 0; ai < 2; ++ai)
#pragma unroll
            for (int m = 0; m < 4; ++m) { bf16_t* rowp = O + (size_t)(row0 + ai * HALF + m * 16) * DFF + col0;
                float r[8];
#pragma unroll
                for (int n = 0; n < 2; ++n)
#pragma unroll
                    for (int e = 0; e < 4; ++e) { const float g = acc[ai][0][m][n][e], up = acc[ai][1][m][n][e];
                        r[n * 4 + e] = g * __builtin_amdgcn_rcpf(1.0f + __expf(-g)) * up; }
                u32x4 w; w.x = cvt_pk_bf16(r[0], r[1]); w.y = cvt_pk_bf16(r[2], r[3]); w.z = cvt_pk_bf16(r[4], r[5]); w.w = cvt_pk_bf16(r[6], r[7]);
                *(u32x4*)rowp = w; }
    }
};

template <class Epi, class Sched>
__device__ __forceinline__ void gemm_phase(const DP& p, LAS unsigned char* lds, const Sched& S, const Epi& E) {
    const int tid = p.tid, wid = __builtin_amdgcn_readfirstlane(tid >> 6), lane = tid & 63, wr = wid >> 2, wc = wid & 3, fr = lane & 15, fq = lane >> 4;
    const int K = S.K, nt = K / BK;
    unsigned voffA[2], voffB[2];
#pragma unroll
    for (int i = 0; i < 2; ++i) { int R, C; stage_rc(tid * 16 + i * 8192, R, C); const int Rb = Epi::PERM ? ((R & ~31) + perm32(R & 31)) : R;
        voffA[i] = (unsigned)(R * K + C) * 2u; voffB[i] = (unsigned)(Rb * K + C) * 2u; }
    const size_t kstep = (size_t)(BK * 2);
    const size_t hstep = (size_t)HALF * K * 2;
    const unsigned ldsw = (unsigned)wid * 1024u;
    const int aoff = lds_byte(wr * 64 + fr, fq * 8), boff = lds_byte(wc * 32 + fr, fq * 8);
#define PG8_SA(b, h) (((b) * 2 + (h)) * HTB)
#define PG8_SB(b, h) ((4 + (b) * 2 + (h)) * HTB)
#define PG8_STAGE(bufoff, gbase, voff) do { _Pragma("unroll") for (int _i = 0; _i < 2; ++_i) \
        __builtin_amdgcn_global_load_lds((const unsigned*)((const char*)(gbase) + (voff)[_i]), (LAS unsigned*)(lds + (bufoff) + ldsw + _i * 8192), 16, 0, 0); } while (0)
#define PG8_LDA(dst, b, h) do { _Pragma("unroll") for (int m = 0; m < 4; ++m) _Pragma("unroll") for (int k = 0; k < 2; ++k) dst[m][k] = *(const LAS bf16x8*)(lds + PG8_SA(b, h) + aoff + m * 2048 + k * 1024); } while (0)
#define PG8_LDB(dst, b, h) do { _Pragma("unroll") for (int n = 0; n < 2; ++n) _Pragma("unroll") for (int k = 0; k < 2; ++k) dst[n][k] = *(const LAS bf16x8*)(lds + PG8_SB(b, h) + boff + n * 2048 + k * 1024); } while (0)
#define PG8_MMA(ai, bj, At, Bt) do { __builtin_amdgcn_s_setprio(1); _Pragma("unroll") for (int m = 0; m < 4; ++m) _Pragma("unroll") for (int n = 0; n < 2; ++n) _Pragma("unroll") for (int k = 0; k < 2; ++k) \
        acc[ai][bj][m][n] = __builtin_amdgcn_mfma_f32_16x16x32_bf16(Bt[n][k], At[m][k], acc[ai][bj][m][n], 0, 0, 0); __builtin_amdgcn_s_setprio(0); } while (0)
#define PG8_WAIT_V(n) asm volatile("s_waitcnt vmcnt(" #n ")" ::: "memory")
#define PG8_WAIT_L(n) asm volatile("s_waitcnt lgkmcnt(" #n ")" ::: "memory")
#define PG8_BAR __builtin_amdgcn_s_barrier()
#define PG8_SCHED __builtin_amdgcn_sched_barrier(0)
    Unit cur, nxt; int ui = 0;
    if (!S.next(0, cur)) return;
    f32x4 acc[2][2][4][2];
#pragma unroll
    for (int a = 0; a < 2; ++a)
#pragma unroll
        for (int b = 0; b < 2; ++b)
#pragma unroll
            for (int m = 0; m < 4; ++m)
#pragma unroll
                for (int n = 0; n < 2; ++n) acc[a][b][m][n] = (f32x4){0.f, 0.f, 0.f, 0.f};
    bf16x8 At[4][2], B0[2][2], B1[2][2];
    const char* cA = cur.a; const char* cB = cur.b;
    PG8_STAGE(PG8_SB(0, 0), cB, voffB); PG8_STAGE(PG8_SA(0, 0), cA, voffA); PG8_STAGE(PG8_SB(0, 1), cB + hstep, voffB); PG8_STAGE(PG8_SA(0, 1), cA + hstep, voffA);
    if (wr == 1) PG8_BAR;
    PG8_WAIT_V(4); PG8_BAR;
    PG8_STAGE(PG8_SB(1, 0), cB + kstep, voffB); PG8_STAGE(PG8_SA(1, 0), cA + kstep, voffA); PG8_STAGE(PG8_SB(1, 1), cB + hstep + kstep, voffB);
    PG8_WAIT_V(6); PG8_BAR;
    for (;;) {
        const bool has_next = S.next(ui + 1, nxt);
        const char* nA = has_next ? nxt.a : cA; const char* nB = has_next ? nxt.b : cB;
        for (int t = 0; t < nt; t += 2) {
            const bool last = (t == nt - 2);
            const char* a1 = cA + (size_t)(t + 1) * kstep;
            const char* a2 = last ? nA : cA + (size_t)(t + 2) * kstep; const char* b2 = last ? nB : cB + (size_t)(t + 2) * kstep;
            const char* a3 = a2 + kstep; const char* b3 = b2 + kstep;
            PG8_LDB(B0, 0, 0); PG8_SCHED; PG8_LDA(At, 0, 0); PG8_STAGE(PG8_SA(1, 1), a1 + hstep, voffA);
            PG8_WAIT_L(8); PG8_BAR; PG8_WAIT_L(0); PG8_MMA(0, 0, At, B0); PG8_BAR; PG8_SCHED;
            PG8_LDB(B1, 0, 1); PG8_STAGE(PG8_SB(0, 0), b2, voffB);
            PG8_BAR; PG8_WAIT_L(0); PG8_MMA(0, 1, At, B1); PG8_BAR;
            PG8_LDA(At, 0, 1); PG8_STAGE(PG8_SA(0, 0), a2, voffA);
            PG8_BAR; PG8_WAIT_L(0); PG8_MMA(1, 0, At, B0); PG8_BAR; PG8_SCHED;
            PG8_STAGE(PG8_SB(0, 1), b2 + hstep, voffB);
            PG8_WAIT_V(6); PG8_BAR; PG8_MMA(1, 1, At, B1); PG8_BAR;
            PG8_LDB(B0, 1, 0); PG8_SCHED; PG8_LDA(At, 1, 0); PG8_STAGE(PG8_SA(0, 1), a2 + hstep, voffA);
            PG8_WAIT_L(8); PG8_BAR; PG8_WAIT_L(0); PG8_MMA(0, 0, At, B0); PG8_BAR; PG8_SCHED;
            PG8_LDB(B1, 1, 1); PG8_STAGE(PG8_SB(1, 0), b3, voffB);
            PG8_BAR; PG8_WAIT_L(0); PG8_MMA(0, 1, At, B1); PG8_BAR;
            PG8_LDA(At, 1, 1); PG8_STAGE(PG8_SA(1, 0), a3, voffA);
            PG8_BAR; PG8_WAIT_L(0); PG8_MMA(1, 0, At, B0); PG8_BAR; PG8_SCHED;
            PG8_STAGE(PG8_SB(1, 1), b3 + hstep, voffB);
            PG8_WAIT_V(6); PG8_BAR; PG8_MMA(1, 1, At, B1); PG8_BAR;
        }
        E(acc, cur, wr, wc, fr, fq);
        if (!has_next) break;
#pragma unroll
        for (int a = 0; a < 2; ++a)
#pragma unroll
            for (int b = 0; b < 2; ++b)
#pragma unroll
                for (int m = 0; m < 4; ++m)
#pragma unroll
                    for (int n = 0; n < 2; ++n) acc[a][b][m][n] = (f32x4){0.f, 0.f, 0.f, 0.f};
        cur = nxt; cA = nA; cB = nB; ++ui;
    }
    PG8_WAIT_V(0);
    if (wr == 0) PG8_BAR;
    PG8_BAR;
#undef PG8_SA
#undef PG8_SB
#undef PG8_STAGE
#undef PG8_LDA
#undef PG8_LDB
#undef PG8_MMA
#undef PG8_WAIT_V
#undef PG8_WAIT_L
#undef PG8_BAR
#undef PG8_SCHED
}
}

__device__ __forceinline__ void norm_rows(const DP& p, int mode, const float* gain) {
    const int lane = p.tid & 63, gw = p.bid * 8 + (p.tid >> 6), nw = p.nb * 8;
    float* tail = (float*)(p.ws_() + WS_TAIL); bf16_t* hn = (bf16_t*)(p.ws_() + WS_XA);
    const int nrows = (mode == 2) ? TREAL : TP;
    f32x4 g[8];
#pragma unroll
    for (int j = 0; j < 8; ++j) g[j] = *(const f32x4*)(gain + 4 * (lane + 64 * j));
    for (int r = gw; r < nrows; r += nw) {
        if (r >= TTOK) {
#pragma unroll
            for (int j = 0; j < 8; ++j) { *(u32x2*)(hn + (size_t)r * DM + 4 * (lane + 64 * j)) = (u32x2){0u, 0u};
                if (mode == 0) *(f32x4*)(tail + (size_t)(r - TREAL) * DM + 4 * (lane + 64 * j)) = (f32x4){0.f, 0.f, 0.f, 0.f}; }
            continue;
        }
        float* hrow = (r < TREAL) ? p.out_() + (size_t)r * DM : tail + (size_t)(r - TREAL) * DM;
        const float* src = hrow;
        if (mode == 0) src = (r < 16384) ? p.in_(0) + (size_t)r * DM : (r < TREAL) ? p.in_(1) + (size_t)(r - 16384) * DM : p.in_(2) + (size_t)((r - TREAL) & 15) * DM;
        f32x4 v[8]; float ss = 0.f;
#pragma unroll
        for (int j = 0; j < 8; ++j) { v[j] = *(const f32x4*)(src + 4 * (lane + 64 * j)); ss += v[j][0] * v[j][0] + v[j][1] * v[j][1] + v[j][2] * v[j][2] + v[j][3] * v[j][3]; }
        ss = wave_sum(ss);
        const float rstd = 1.0f / sqrtf(ss * (1.0f / DM) + EPSN);
#pragma unroll
        for (int j = 0; j < 8; ++j) {
            const f32x4 o = v[j] * rstd * g[j];
            if (mode == 0) *(f32x4*)(hrow + 4 * (lane + 64 * j)) = v[j];
            if (mode == 2) *(f32x4*)(hrow + 4 * (lane + 64 * j)) = o;
            else { u32x2 w; w.x = cvt_pk_bf16(o[0], o[1]); w.y = cvt_pk_bf16(o[2], o[3]); *(u32x2*)(hn + (size_t)r * DM + 4 * (lane + 64 * j)) = w; }
        }
    }
}

__device__ __forceinline__ void transpose_cvt(const DP& p, LAS unsigned char* lds, const float* src, int K, int N, bf16_t* dst, int ldd, int koff, int mode) {
    LAS float* tile = (LAS float*)lds;
    const int tid = p.tid, nkt = K / 64, nnt = N / 64;
    for (int t = p.bid; t < nkt * nnt; t += p.nb) {
        const int k0 = (t / nnt) * 64, n0 = (t % nnt) * 64;
#pragma unroll
        for (int it = 0; it < 2; ++it) { const int e = tid + it * 512, kk = e >> 4, n4 = e & 15;
            const f32x4 v = *(const f32x4*)(src + (size_t)(k0 + kk) * N + n0 + 4 * n4);
            tile[kk * 65 + 4 * n4 + 0] = v[0]; tile[kk * 65 + 4 * n4 + 1] = v[1]; tile[kk * 65 + 4 * n4 + 2] = v[2]; tile[kk * 65 + 4 * n4 + 3] = v[3]; }
        __syncthreads();
        { const int nn = tid >> 3, k8 = tid & 7; float f[8];
#pragma unroll
          for (int j = 0; j < 8; ++j) f[j] = tile[(8 * k8 + j) * 65 + nn];
          const int n = n0 + nn; const int drow = (mode == 0) ? n : ((n >> 7) * 256 + (n & 127) + (mode == 2 ? 128 : 0));
          u32x4 w; w.x = cvt_pk_bf16(f[0], f[1]); w.y = cvt_pk_bf16(f[2], f[3]); w.z = cvt_pk_bf16(f[4], f[5]); w.w = cvt_pk_bf16(f[6], f[7]);
          *(u32x4*)(dst + (size_t)drow * ldd + koff + k0 + 8 * k8) = w; }
        __syncthreads();
    }
}
__device__ __forceinline__ void fold_pool(const DP& p, const float* pw, const float* sc, const float* wo, bf16_t* dst) {
    const int tid = p.tid;
    for (int it = p.bid; it < 512; it += p.nb) {
        const int g = it >> 7, c8 = (it >> 2) & 31, n = (it & 3) * 512 + tid;
        float acc[8];
#pragma unroll
        for (int e = 0; e < 8; ++e) acc[e] = 0.f;
        const float* pwr = pw + (size_t)(g * 256 + c8 * 8) * 256;
        for (int d = 0; d < 256; ++d) {
            const float wv = wo[(size_t)(g * 256 + d) * DM + n] * sc[g * 256 + d];
#pragma unroll
            for (int e = 0; e < 8; ++e) acc[e] += pwr[e * 256 + d] * wv;
        }
        u32x4 w; w.x = cvt_pk_bf16(acc[0], acc[1]); w.y = cvt_pk_bf16(acc[2], acc[3]); w.z = cvt_pk_bf16(acc[4], acc[5]); w.w = cvt_pk_bf16(acc[6], acc[7]);
        *(u32x4*)(dst + (size_t)n * DM + g * 256 + c8 * 8) = w;
    }
}
__device__ __forceinline__ void prep_weights(const DP& p, LAS unsigned char* lds, int l) {
    transpose_cvt(p, lds, p.in_(4) + (size_t)l * DM * 4096, DM, 4096, (bf16_t*)(p.ws_() + WS_WIN), DM, 0, 0);
    transpose_cvt(p, lds, p.in_(18) + (size_t)l * DM * DM + (size_t)1024 * DM, 1024, DM, (bf16_t*)(p.ws_() + WS_WOUT), DM, 1024, 0);
    transpose_cvt(p, lds, p.in_(20) + (size_t)l * DM * DFF, DM, DFF, (bf16_t*)(p.ws_() + WS_WGU), DM, 0, 1);
    transpose_cvt(p, lds, p.in_(21) + (size_t)l * DM * DFF, DM, DFF, (bf16_t*)(p.ws_() + WS_WGU), DM, 0, 2);
    transpose_cvt(p, lds, p.in_(22) + (size_t)l * DFF * DM, DFF, DM, (bf16_t*)(p.ws_() + WS_WDN), DFF, 0, 0);
    fold_pool(p, p.in_(5) + (size_t)l * 4 * 256 * 256, p.in_(6) + (size_t)l * 1024, p.in_(18) + (size_t)l * DM * DM, (bf16_t*)(p.ws_() + WS_WOUT));
    { const float* w4 = p.in_(16) + (size_t)l * 64 * 4096; float* w4t = (float*)(p.ws_() + WS_W4T);
      for (int i = p.bid * NTHREADS + p.tid; i < 4096 * 64; i += p.nb * NTHREADS) w4t[i] = w4[(size_t)(i & 63) * 4096 + (i >> 6)]; }
}

__device__ __forceinline__ void mlp_layer(LAS float* hl, int lane, int nin, const float* w, const float* b, const float* fr) {
    float acc[64];
#pragma unroll
    for (int j = 0; j < 64; ++j) acc[j] = b[j];
#pragma unroll 1
    for (int i = 0; i < nin; ++i) {
        const float hv = hl[i * 64 + lane];
#pragma unroll
        for (int j = 0; j < 64; ++j) acc[j] += hv * w[i * 64 + j];
    }
#pragma unroll
    for (int j = 0; j < 64; ++j) hl[j * 64 + lane] = __sinf(fr[j] * acc[j]);
}
__device__ __forceinline__ void filter_h3(const DP& p, LAS unsigned char* lds, int l) {
    const int lane = p.tid & 63, wv = __builtin_amdgcn_readfirstlane(p.tid >> 6), gw = __builtin_amdgcn_readfirstlane(p.bid * 8 + (p.tid >> 6)), nw = p.nb * 8;
    const float* w1 = p.in_(9) + (size_t)l * 33 * 64; const float* b1 = p.in_(10) + l * 64;
    const float* w2 = p.in_(11) + (size_t)l * 64 * 64; const float* b2 = p.in_(12) + l * 64;
    const float* w3 = p.in_(13) + (size_t)l * 64 * 64; const float* b3 = p.in_(14) + l * 64;
    const float* fr = p.in_(15) + l * 64;
    float* h3 = (float*)(p.ws_() + WS_H3);
    LAS float* hl = (LAS float*)lds + wv * 4096;
    for (int item = gw; item < 129 + 65; item += nw) {
        const int tr = item < 129 ? 1 : 0, tile = tr ? item : item - 129, L = tr ? 8208 : 4112;
        const int n = tile * 64 + lane; const bool valid = n < L;
        const float nf = (float)n, t = nf / (float)(L - 1);
        hl[lane] = t;
#pragma unroll
        for (int b = 0; b < 16; ++b) { const float band = 1e-4f + (float)b * ((15.0f - 1e-4f) / 15.0f);
            const float ang = (6.283185307179586f / (float)L) * nf * band; hl[(1 + b) * 64 + lane] = __cosf(ang); hl[(17 + b) * 64 + lane] = -__sinf(ang); }
        mlp_layer(hl, lane, 33, w1, b1, fr);
        mlp_layer(hl, lane, 64, w2, b2, fr);
        mlp_layer(hl, lane, 64, w3, b3, fr);
        if (valid) { float* o = h3 + (size_t)((tr ? 0 : 8208) + n) * 64;
#pragma unroll
            for (int j = 0; j < 16; ++j) *(f32x4*)(o + 4 * j) = (f32x4){hl[(4 * j) * 64 + lane], hl[(4 * j + 1) * 64 + lane], hl[(4 * j + 2) * 64 + lane], hl[(4 * j + 3) * 64 + lane]}; }
    }
}
__device__ __forceinline__ bf16x8 cvt8(const f32x4 a, const f32x4 b) { u32x4 o; o.x = cvt_pk_bf16(a[0], a[1]); o.y = cvt_pk_bf16(a[2], a[3]); o.z = cvt_pk_bf16(b[0], b[1]); o.w = cvt_pk_bf16(b[2], b[3]); return __builtin_bit_cast(bf16x8, o); }
__device__ __forceinline__ void filter_gen(const DP& p, LAS unsigned char* lds, int l) {
    const int lane = p.tid & 63, wv = __builtin_amdgcn_readfirstlane(p.tid >> 6), gw = __builtin_amdgcn_readfirstlane(p.bid * 8 + (p.tid >> 6)), nw = p.nb * 8;
    const float* w4t = (const float*)(p.ws_() + WS_W4T); const float* h3 = (const float*)(p.ws_() + WS_H3);
    const float* skip = p.in_(17) + (size_t)l * 2 * 1024;
    LAS bf16_t* S = (LAS bf16_t*)(lds + wv * 8448);
    const int col = lane & 31, hh = lane >> 5;
    constexpr int NS = 2 * 65 * 8, NPI = 2 * 33 * 8;
    for (int item = gw; item < NS + NPI; item += nw) {
        const int tr = item < NS ? 1 : 0, it2 = tr ? item : item - NS;
        const int L = tr ? 8208 : 4112, GL = 2 * L;
        const int part = it2 & 7, bd = it2 >> 3, dir = bd & 1, b = bd >> 1, o = part >> 2, ct0 = (part & 3) * 8;
        const int nbase = 128 * b + dir;
        const float invL1 = 1.0f / (float)(L - 1);
        bf16x8 A[4][4];
#pragma unroll
        for (int r = 0; r < 4; ++r) {
            int n = nbase + 32 * r + col; n = n < L ? n : L - 1;
            const float* hr = h3 + (size_t)((tr ? 0 : 8208) + n) * 64 + 8 * hh;
#pragma unroll
            for (int s4 = 0; s4 < 4; ++s4) A[r][s4] = cvt8(*(const f32x4*)(hr + 16 * s4), *(const f32x4*)(hr + 16 * s4 + 4));
        }
        bf16_t* gbase = (bf16_t*)(p.ws_() + (tr ? WS_GFS : WS_GFP)) + (size_t)o * 1024 * GL;
        const int ebase = dir ? L + 128 * b : L - 128 * b - 128;
#pragma unroll 1
        for (int ct = 0; ct < 8; ++ct) {
            const int c = (ct0 + ct) * 32 + col;
            const float* wr = w4t + (size_t)(o * 2048 + dir * 1024 + c) * 64 + 8 * hh;
            bf16x8 Bf[4];
#pragma unroll
            for (int s4 = 0; s4 < 4; ++s4) Bf[s4] = cvt8(*(const f32x4*)(wr + 16 * s4), *(const f32x4*)(wr + 16 * s4 + 4));
            const float d0 = -3.0701134573253946f, d1 = -15.350567286626973f;
            const float kc = -fabsf(d0 + (float)c * ((d1 - d0) / 1023.0f)) * 1.4426950408889634f;
            const float sk = skip[o * 1024 + c];
#pragma unroll
            for (int r = 0; r < 4; ++r) {
                f32x16 acc;
#pragma unroll
                for (int i = 0; i < 16; ++i) acc[i] = 0.f;
#pragma unroll
                for (int s4 = 0; s4 < 4; ++s4) acc = __builtin_amdgcn_mfma_f32_32x32x16_bf16(A[r][s4], Bf[s4], acc, 0, 0, 0);
#pragma unroll
                for (int q = 0; q < 4; ++q) {
                    const int nl0 = 32 * r + 8 * q + 4 * hh;
                    float v[4];
#pragma unroll
                    for (int e = 0; e < 4; ++e) { const int n = nbase + nl0 + e; const float t = (float)n * invL1;
                        float x = acc[4 * q + e] * __builtin_amdgcn_exp2f(t * kc);
                        if (dir == 0 && n == 0) x += sk;
                        v[e] = n < L ? x : 0.f; }
                    u32x2 w;
                    if (dir) { w.x = cvt_pk_bf16(v[0], v[1]); w.y = cvt_pk_bf16(v[2], v[3]); *(LAS u32x2*)(S + col * 132 + nl0) = w; }
                    else     { w.x = cvt_pk_bf16(v[3], v[2]); w.y = cvt_pk_bf16(v[1], v[0]); *(LAS u32x2*)(S + col * 132 + 124 - nl0) = w; }
                }
            }
#pragma unroll
            for (int u = 0; u < 8; ++u) {
                const int id = u * 64 + lane, colr = id >> 4, k = id & 15;
                const u32x2 lo = *(const LAS u32x2*)(S + colr * 132 + 8 * k), hi = *(const LAS u32x2*)(S + colr * 132 + 8 * k + 4);
                const int e0 = ebase + 8 * k;
                if (e0 >= 0 && e0 + 8 <= GL) *(u32x4*)(gbase + (size_t)((ct0 + ct) * 32 + colr) * GL + e0) = (u32x4){lo.x, lo.y, hi.x, hi.y};
            }
        }
    }
}

__device__ __forceinline__ void pool_acc(float (&s)[8], const u32x4 v, float sg) {
    s[0] += sg * bflo(v.x); s[1] += sg * bfhi(v.x); s[2] += sg * bflo(v.y); s[3] += sg * bfhi(v.y); s[4] += sg * bflo(v.z); s[5] += sg * bfhi(v.z); s[6] += sg * bflo(v.w); s[7] += sg * bfhi(v.w);
}
__device__ __forceinline__ void pool_window(const DP& p) {
    const bf16_t* P = (const bf16_t*)(p.ws_() + WS_P); bf16_t* mix = (bf16_t*)(p.ws_() + WS_XA);
    const int total = (4 * 257 + 2 * 513) * 128;
    for (int idx = p.bid * NTHREADS + p.tid; idx < total; idx += p.nb * NTHREADS) {
        const int run = idx >> 7, c8 = idx & 127;
        int sq, r, L;
        if (run < 4 * 257) { sq = run / 257; r = run - sq * 257; L = 4112; } else { const int r2 = run - 4 * 257; sq = 4 + r2 / 513; r = r2 - (sq - 4) * 513; L = 8208; }
        const int hw = 1 << (c8 >> 5), p0 = 16 * r;
        const bf16_t* Pc = P + 8 * c8;
        float s[8];
#pragma unroll
        for (int e = 0; e < 8; ++e) s[e] = 0.f;
        { const int lo = p0 - hw < 0 ? 0 : p0 - hw, hi = p0 + hw > L ? L : p0 + hw;
          for (int q = lo; q < hi; ++q) pool_acc(s, *(const u32x4*)(Pc + (size_t)seq_row(sq, q) * 1024), 1.0f); }
#pragma unroll 4
        for (int i = 0; i < 16; ++i) {
            const int pp = p0 + i;
            const int lo = pp - hw < 0 ? 0 : pp - hw, hi = pp + hw > L ? L : pp + hw;
            const float inv = 1.0f / (float)(hi - lo);
            const int row = seq_row(sq, pp);
            const u32x4 v = *(const u32x4*)(Pc + (size_t)row * 1024);
            u32x4 w;
            w.x = cvt_pk_bf16(s[0] * inv - bflo(v.x), s[1] * inv - bfhi(v.x)); w.y = cvt_pk_bf16(s[2] * inv - bflo(v.y), s[3] * inv - bfhi(v.y));
            w.z = cvt_pk_bf16(s[4] * inv - bflo(v.z), s[5] * inv - bfhi(v.z)); w.w = cvt_pk_bf16(s[6] * inv - bflo(v.w), s[7] * inv - bfhi(v.w));
            *(u32x4*)(mix + (size_t)row * DM + 8 * c8) = w;
            if (pp + hw < L) pool_acc(s, *(const u32x4*)(Pc + (size_t)seq_row(sq, pp + hw) * 1024), 1.0f);
            if (pp - hw >= 0) pool_acc(s, *(const u32x4*)(Pc + (size_t)seq_row(sq, pp - hw) * 1024), -1.0f);
        }
    }
}

constexpr int HYH_U = 0, HYH_FB = 35840, HYH_ZB = HYH_FB + 33280, HYH_RED = HYH_ZB + 512, HYH_SIZE = HYH_RED + 1024;
static_assert(2 * HYH_SIZE <= LDS_BYTES, "hyena LDS");
constexpr int FPAD = 176;
template <int TR> struct HG;
template <> struct HG<1> { static constexpr int L = 8208, B = 2, NSB = 16, BSE = 8720, NIN = 513, SQ0 = 4; };
template <> struct HG<0> { static constexpr int L = 4112, B = 4, NSB = 8,  BSE = 4416, NIN = 257, SQ0 = 0; };
__device__ __forceinline__ int uphys(int q) { return q + 8 * (q >> 7); }

struct ARaw { u32x2 w01, w23, w45; };
__device__ __forceinline__ ARaw hy_raw_a(const LAS unsigned char* p8) { ARaw r; r.w01 = *(const LAS u32x2*)p8; r.w23 = *(const LAS u32x2*)(p8 + 8); r.w45 = *(const LAS u32x2*)(p8 + 16); return r; }
__device__ __forceinline__ bf16x8 hy_fin_a(const ARaw& r, bool dsel, unsigned bsh) {
    const unsigned s0 = dsel ? r.w01.y : r.w01.x, s1 = dsel ? r.w23.x : r.w01.y, s2 = dsel ? r.w23.y : r.w23.x, s3 = dsel ? r.w45.x : r.w23.y, s4 = dsel ? r.w45.y : r.w45.x;
    u32x4 o; o.x = __builtin_amdgcn_alignbit(s1, s0, bsh); o.y = __builtin_amdgcn_alignbit(s2, s1, bsh); o.z = __builtin_amdgcn_alignbit(s3, s2, bsh); o.w = __builtin_amdgcn_alignbit(s4, s3, bsh);
    return __builtin_bit_cast(bf16x8, o);
}
template <int TR>
__device__ __forceinline__ void hy_conv(LAS unsigned char* hl, int wq, int lane, f32x16 (&acc)[4]) {
    typedef HG<TR> G;
    const LAS unsigned char* Ub = hl + HYH_U; const LAS unsigned char* FBb = hl + HYH_FB;
    const int n = lane & 31, h = lane >> 5;
    const int sbi = n % G::NSB, beta = n / G::NSB, sb0 = wq * G::NSB;
    const int abase = FPAD + (G::L - 1) - n + 8 * h;
    const int ab2 = 2 * abase, ab8 = ab2 & ~7; const bool dsel = (ab2 & 4) != 0; const unsigned bsh = (ab2 & 2) ? 16u : 0u;
    constexpr int KS = (G::L - 16) / 16 + 8 * (G::NSB - 1) + 1, NIT = (KS + 1) / 2, NOUT = (NIT + 3) / 4;
    const int dlo = 128 * sb0 - (G::L - 16);
    constexpr int MMAX = (G::L - 16) / 128;
#pragma unroll
    for (int r = 0; r < 4; ++r)
#pragma unroll
        for (int i = 0; i < 16; ++i) acc[r][i] = 0.f;
    bf16x8 qe[4], qo[4];
#pragma unroll
    for (int r = 0; r < 4; ++r) { qe[r] = hy_fin_a(hy_raw_a(FBb + (ab8 - 2 * (dlo + 32 * r))), dsel, bsh); qo[r] = hy_fin_a(hy_raw_a(FBb + (ab8 - 2 * (dlo + 16 + 32 * r))), dsel, bsh); }
    const int ub2 = 2 * (beta * G::BSE + 8 * h);
    int M = sbi + MMAX;
    const LAS unsigned char* zb = hl + HYH_ZB + 256;
#define HY_PB(MM, first) ({ const bool v_ = (first) ? ((unsigned)(MM) <= (unsigned)MMAX) : ((unsigned)((MM) - 1) < (unsigned)MMAX); v_ ? (Ub + ub2 + 272 * (MM)) : zb; })
    const LAS unsigned char* pb0 = HY_PB(M, true); const LAS unsigned char* pb1 = HY_PB(M, false);
    bf16x8 be = *(const LAS bf16x8*)pb0, bo = *(const LAS bf16x8*)(pb1 - 2 * (16 + 8));
    const LAS unsigned char* pa = FBb + (ab8 - 2 * (dlo + 128));
#pragma unroll 1
    for (int I = 0; I < NOUT; ++I) {
        const LAS unsigned char* pn0 = HY_PB(M - 1, true); const LAS unsigned char* pn1 = HY_PB(M - 1, false);
#pragma unroll
        for (int j = 0; j < 4; ++j) {
            const ARaw ra = hy_raw_a(pa - 2 * (32 * j)), rb = hy_raw_a(pa - 2 * (32 * j + 16));
            bf16x8 nbe, nbo;
            if (j < 3) { nbe = *(const LAS bf16x8*)(pb1 - 2 * (32 * (j + 1) + 8)); nbo = *(const LAS bf16x8*)(pb1 - 2 * (32 * (j + 1) + 16 + 8)); }
            else       { nbe = *(const LAS bf16x8*)pn0;                            nbo = *(const LAS bf16x8*)(pn1 - 2 * (16 + 8)); }
#pragma unroll
            for (int r = 0; r < 4; ++r) acc[r] = __builtin_amdgcn_mfma_f32_32x32x16_bf16(qe[(j + r) & 3], be, acc[r], 0, 0, 0);
#pragma unroll
            for (int r = 0; r < 4; ++r) acc[r] = __builtin_amdgcn_mfma_f32_32x32x16_bf16(qo[(j + r) & 3], bo, acc[r], 0, 0, 0);
            qe[j] = hy_fin_a(ra, dsel, bsh); qo[j] = hy_fin_a(rb, dsel, bsh);
            be = nbe; bo = nbo;
        }
        pa -= 256; pb0 = pn0; pb1 = pn1; --M;
    }
#undef HY_PB
    {
        f32x16 at;
#pragma unroll
        for (int i = 0; i < 16; ++i) at[i] = 0.f;
        constexpr int MS = (G::NIN + 3) / 4;
        const int m0 = wq * MS, m1 = (m0 + MS < G::NIN) ? m0 + MS : G::NIN;
        const bool colv = n < G::B;
        const int ut2 = 2 * ((colv ? n : 0) * G::BSE + 8 * h);
#pragma unroll 2
        for (int m = m0; m < m1; ++m) {
            const int d = (G::L - 16) - 16 * m;
            const bf16x8 a = hy_fin_a(hy_raw_a(FBb + (ab8 - 2 * d)), dsel, bsh);
            const bf16x8 b = *(const LAS bf16x8*)(colv ? Ub + ut2 + 2 * (16 * m + 8 * ((16 * m) >> 7)) : zb);
            at = __builtin_amdgcn_mfma_f32_32x32x16_bf16(a, b, at, 0, 0, 0);
        }
        LAS float* RED = (LAS float*)(hl + HYH_RED);
        if (colv) {
#pragma unroll
            for (int i = 0; i < 8; ++i) { const int arow = (i & 3) + 8 * (i >> 2) + 4 * h; RED[(wq * 16 + arow) * 4 + n] = at[i]; }
        }
    }
}
template <int TR>
__device__ __forceinline__ void hy_load_stream(const DP& p, LAS unsigned char* hl, int lt, int l, int k, int c, bool toU) {
    typedef HG<TR> G;
    const int ch = k * 1024 + c;
    const float* cw = p.in_(7) + (size_t)l * 3 * 3072; const float* cb = p.in_(8) + (size_t)l * 3072;
    const float w0 = cw[ch], w1 = cw[3072 + ch], w2 = cw[2 * 3072 + ch], bb = cb[ch];
    const bf16_t* src = (const bf16_t*)(p.ws_() + WS_UT) + (size_t)ch * TP;
    LAS bf16_t* U = (LAS bf16_t*)(hl + HYH_U); LAS bf16_t* X = (LAS bf16_t*)(hl + HYH_FB);
    constexpr int nch = G::L / 8;
    for (int idx = lt; idx < G::B * nch; idx += 256) {
        const int b = idx / nch, q = idx - b * nch, p0 = 8 * q, sq = G::SQ0 + b;
        const int moff = TREAL + 16 * sq, roff = seq_rbase(sq);
        const int off = p0 < 16 ? moff + p0 : roff + p0 - 16;
        const u32x4 v = *(const u32x4*)(src + off);
        float x[10];
        x[0] = (p0 == 0) ? 0.f : bf2f(p0 == 16 ? src[moff + 15] : src[off - 1]);
        x[9] = (p0 + 8 >= G::L) ? 0.f : bf2f(p0 + 8 == 16 ? src[roff] : src[off + 8]);
        x[1] = bflo(v.x); x[2] = bfhi(v.x); x[3] = bflo(v.y); x[4] = bfhi(v.y); x[5] = bflo(v.z); x[6] = bfhi(v.z); x[7] = bflo(v.w); x[8] = bfhi(v.w);
        float y[8];
#pragma unroll
        for (int j = 0; j < 8; ++j) y[j] = w0 * x[j] + w1 * x[j + 1] + w2 * x[j + 2] + bb;
        u32x4 w; w.x = cvt_pk_bf16(y[0], y[1]); w.y = cvt_pk_bf16(y[2], y[3]); w.z = cvt_pk_bf16(y[4], y[5]); w.w = cvt_pk_bf16(y[6], y[7]);
        LAS bf16_t* dst = toU ? U + b * G::BSE + uphys(p0) : X + b * G::L + p0;
        *(LAS u32x4*)dst = w;
    }
}
template <int TR>
__device__ __forceinline__ void hy_load_filter(const DP& p, LAS unsigned char* hl, int lt, int o, int c) {
    typedef HG<TR> G;
    constexpr int GL = 2 * G::L;
    const bf16_t* gf = (const bf16_t*)(p.ws_() + (TR ? WS_GFS : WS_GFP)) + ((size_t)o * 1024 + c) * GL;
    LAS bf16_t* FB = (LAS bf16_t*)(hl + HYH_FB);
    if (lt < FPAD / 8) *(LAS u32x4*)(FB + 8 * lt) = (u32x4){0u, 0u, 0u, 0u};
    for (int idx = lt; idx < GL / 8; idx += 256) *(LAS u32x4*)(FB + FPAD + 8 * idx) = *(const u32x4*)(gf + 8 * idx);
}
template <int TR>
__device__ __forceinline__ void hy_items(const DP& p, LAS unsigned char* lds, int l, int vcu) {
    typedef HG<TR> G;
    const int tid = p.tid, lane = tid & 63, wave = __builtin_amdgcn_readfirstlane(tid >> 6), hf = wave >> 2, wq = wave & 3, lt = tid & 255;
    LAS unsigned char* hl = lds + hf * HYH_SIZE;
    LAS bf16_t* U = (LAS bf16_t*)(hl + HYH_U); const LAS bf16_t* X = (const LAS bf16_t*)(hl + HYH_FB); const LAS float* RED = (const LAS float*)(hl + HYH_RED);
    bf16_t* UT = (bf16_t*)(p.ws_() + WS_UT);
    const int n = lane & 31, hh = lane >> 5, sbi = n % G::NSB, beta = n / G::NSB, sb = wq * G::NSB + sbi;
    for (int pit = vcu; pit < 512; pit += p.nb) {
        const int c = 2 * pit + hf;
        if (lt < 32) *(LAS u32x4*)(hl + HYH_ZB + 16 * lt) = (u32x4){0u, 0u, 0u, 0u};
        hy_load_stream<TR>(p, hl, lt, l, 0, c, true);
        hy_load_filter<TR>(p, hl, lt, 0, c);
        __syncthreads();
        f32x16 acc[4];
        hy_conv<TR>(hl, wq, lane, acc);
        __syncthreads();
        hy_load_stream<TR>(p, hl, lt, l, 1, c, false);
        __syncthreads();
#pragma unroll
        for (int r = 0; r < 4; ++r)
#pragma unroll
            for (int qd = 0; qd < 4; ++qd) {
                const int t0 = 128 * sb + 32 * r + 8 * qd + 4 * hh;
                const u32x2 xv = *(const LAS u32x2*)(X + beta * G::L + t0);
                u32x2 w; w.x = cvt_pk_bf16(bflo(xv.x) * acc[r][4 * qd], bfhi(xv.x) * acc[r][4 * qd + 1]); w.y = cvt_pk_bf16(bflo(xv.y) * acc[r][4 * qd + 2], bfhi(xv.y) * acc[r][4 * qd + 3]);
                *(LAS u32x2*)(U + beta * G::BSE + uphys(t0)) = w;
            }
        if (lt < 16 * G::B) { const int a = lt & 15, b = lt >> 4; float y = 0.f;
#pragma unroll
            for (int w = 0; w < 4; ++w) y += RED[(w * 16 + a) * 4 + b];
            const int t = (G::L - 16) + a;
            U[b * G::BSE + uphys(t)] = f2bf(bf2f(X[b * G::L + t]) * y); }
        __syncthreads();
        hy_load_filter<TR>(p, hl, lt, 1, c);
        __syncthreads();
        hy_conv<TR>(hl, wq, lane, acc);
        __syncthreads();
        hy_load_stream<TR>(p, hl, lt, l, 2, c, false);
        __syncthreads();
        bf16_t* orow = UT + (size_t)c * TP;
#pragma unroll
        for (int r = 0; r < 4; ++r)
#pragma unroll
            for (int qd = 0; qd < 4; ++qd) {
                const int t0 = 128 * sb + 32 * r + 8 * qd + 4 * hh;
                const u32x2 xv = *(const LAS u32x2*)(X + beta * G::L + t0);
                u32x2 w; w.x = cvt_pk_bf16(bflo(xv.x) * acc[r][4 * qd], bfhi(xv.x) * acc[r][4 * qd + 1]); w.y = cvt_pk_bf16(bflo(xv.y) * acc[r][4 * qd + 2], bfhi(xv.y) * acc[r][4 * qd + 3]);
                *(u32x2*)(orow + seq_row(G::SQ0 + beta, t0)) = w;
            }
        if (lt < 16 * G::B) { const int a = lt & 15, b = lt >> 4; float y = 0.f;
#pragma unroll
            for (int w = 0; w < 4; ++w) y += RED[(w * 16 + a) * 4 + b];
            const int t = (G::L - 16) + a;
            orow[seq_row(G::SQ0 + b, t)] = f2bf(bf2f(X[b * G::L + t]) * y); }
        __syncthreads();
    }
}
__device__ __forceinline__ void hyena_phase(const DP& p, LAS unsigned char* lds, int l) {
    const int Gd = p.nb, bx = p.bid;
    const int vcu = (Gd % 8 == 0) ? (bx % 8) * (Gd / 8) + bx / 8 : bx;
    hy_items<1>(p, lds, l, vcu);
    hy_items<0>(p, lds, l, vcu);
}
__device__ __forceinline__ void hyena_transpose(const DP& p, LAS unsigned char* lds) {
    const bf16_t* UT = (const bf16_t*)(p.ws_() + WS_UT); bf16_t* mix = (bf16_t*)(p.ws_() + WS_XA);
    LAS bf16_t* tile = (LAS bf16_t*)lds;
    const int tid = p.tid;
    for (int t = p.bid; t < 16 * (TP / 64); t += p.nb) {
        const int c0 = (t & 15) * 64, t0 = (t >> 4) * 64;
        { const int cc = tid >> 3, t8 = tid & 7;
          *(LAS u32x4*)(tile + cc * 72 + 8 * t8) = *(const u32x4*)(UT + (size_t)(c0 + cc) * TP + t0 + 8 * t8); }
        __syncthreads();
        { const int tt = tid >> 3, c8 = tid & 7; unsigned w[4];
#pragma unroll
          for (int j = 0; j < 4; ++j) w[j] = (unsigned)tile[(8 * c8 + 2 * j) * 72 + tt] | ((unsigned)tile[(8 * c8 + 2 * j + 1) * 72 + tt] << 16);
          *(u32x4*)(mix + (size_t)(t0 + tt) * DM + 1024 + c0 + 8 * c8) = (u32x4){w[0], w[1], w[2], w[3]}; }
        __syncthreads();
    }
}

constexpr int NPHASES = 17;
__device__ __forceinline__ void run_phase(const DP& p, LAS unsigned char* lds, int ph) {
    const int l = (ph == 0) ? 0 : (ph - 1) / 8, jj = (ph - 1) % 8, k = (ph == 0) ? 0 : (jj < 2 ? jj + 1 : (jj == 2 ? 8 : jj));
    const int G = p.nb, cbx = p.bid;
    bf16_t* XA = (bf16_t*)(p.ws_() + WS_XA);
    switch (k) {
#if (PHMASK >> 0) & 1
    case 0: {
#if SUB & 1
        norm_rows(p, 0, p.in_(3));
#endif
#if SUB & 2
        prep_weights(p, lds, 0);
#endif
#if SUB & 4
        __syncthreads(); filter_h3(p, lds, 0);
#endif
    } break;
#endif
#if (PHMASK >> 1) & 1
    case 1: {
        pg8::Prob p0{XA, (const bf16_t*)(p.ws_() + WS_WIN), TP / 256, 4};
        pg8::Prob p1{(const bf16_t*)(p.ws_() + WS_WIN) + (size_t)1024 * DM, XA, 12, TP / 256};
        pg8::Sched2 S; S.init(p0, p1, DM, G, cbx);
        pg8::EpiStore E{{(bf16_t*)(p.ws_() + WS_P), (bf16_t*)(p.ws_() + WS_UT)}, {1024, TP}};
        pg8::gemm_phase<pg8::EpiStore, pg8::Sched2>(p, lds, S, E);
        __syncthreads(); filter_gen(p, lds, l);
    } break;
#endif
#if (PHMASK >> 2) & 1
    case 2: {
        hyena_phase(p, lds, l);
        pool_window(p);
    } break;
#endif
#if (PHMASK >> 8) & 1
    case 8: hyena_transpose(p, lds); break;
#endif
#if (PHMASK >> 3) & 1
    case 3: {
        pg8::Prob p0{XA, (const bf16_t*)(p.ws_() + WS_WOUT), l == 0 ? TP / 256 : TREAL / 256, DM / 256};
        pg8::Prob p1{XA, XA, 0, 0};
        pg8::Sched2 S; S.init(p0, p1, DM, G, cbx);
        pg8::EpiResid E{p.out_(), (float*)(p.ws_() + WS_TAIL)};
        pg8::gemm_phase<pg8::EpiResid, pg8::Sched2>(p, lds, S, E);
    } break;
#endif
#if (PHMASK >> 4) & 1
    case 4: norm_rows(p, 1, p.in_(19) + (size_t)l * DM); break;
#endif
#if (PHMASK >> 5) & 1
    case 5: {
        pg8::Prob p0{XA, (const bf16_t*)(p.ws_() + WS_WGU), l == 0 ? TP / 256 : TREAL / 256, 2 * DFF / 256};
        pg8::Prob p1{XA, XA, 0, 0};
        pg8::Sched2 S; S.init(p0, p1, DM, G, cbx);
        pg8::EpiSwiGLU E{(bf16_t*)(p.ws_() + WS_HID)};
        pg8::gemm_phase<pg8::EpiSwiGLU, pg8::Sched2>(p, lds, S, E);
    } break;
#endif
#if (PHMASK >> 6) & 1
    case 6: {
        pg8::Prob p0{(const bf16_t*)(p.ws_() + WS_HID), (const bf16_t*)(p.ws_() + WS_WDN), l == 0 ? TP / 256 : TREAL / 256, DM / 256};
        pg8::Prob p1{XA, XA, 0, 0};
        pg8::Sched2 S; S.init(p0, p1, DFF, G, cbx);
        pg8::EpiResid E{p.out_(), (float*)(p.ws_() + WS_TAIL)};
        pg8::gemm_phase<pg8::EpiResid, pg8::Sched2>(p, lds, S, E);
    } break;
#endif
#if (PHMASK >> 7) & 1
    case 7: {
        if (l == 0) { norm_rows(p, 1, p.in_(3) + DM); prep_weights(p, lds, 1); __syncthreads(); filter_h3(p, lds, 1); }
        else norm_rows(p, 2, p.in_(23));
    } break;
#endif
    }
}

__global__ void __launch_bounds__(NTHREADS, 2) mega_fwd(Params pk, int ph_lo, int ph_hi) {
    DP p;
    extern __shared__ __attribute__((aligned(16))) unsigned char lds_raw[];
    LAS unsigned char* lds = (LAS unsigned char*)lds_raw;
    cg::grid_group grid = cg::this_grid();
    for (int ph = ph_lo; ph < ph_hi; ++ph) {
        { kseg_t ks = (kseg_t)__builtin_amdgcn_kernarg_segment_ptr(); int t = threadIdx.x, b = blockIdx.x, n = gridDim.x;
          asm volatile("" : "+s"(ks), "+v"(t), "+s"(b), "+s"(n));
          p.ks = ks; p.tid = t; p.bid = b; p.nb = n; }
        run_phase(p, lds, ph);
#if REPMASK
        { const int j2 = (ph - 1) % 8, kk = (ph == 0) ? 0 : (j2 < 2 ? j2 + 1 : (j2 == 2 ? 8 : j2));
          if (((REPMASK >> kk) & 1) && ph != 16) { grid.sync(); run_phase(p, lds, ph); } }
#endif
        if (ph + 1 < ph_hi) grid.sync();
    }
}

extern "C" void kernel_launch(void* const* d_in, const int* in_sizes, int n_in, void* d_out, int out_size, void* d_ws, size_t ws_size, hipStream_t stream) {
    static int grid = 0;
    if (grid == 0) {
        if (n_in != 24 || ws_size < WS_END) { fprintf(stderr, "kernel_launch: need 24 inputs and %zu bytes of workspace (got %d, %zu)\n", (size_t)WS_END, n_in, ws_size); grid = -1; return; }
        int dev = 0, cus = 0, per_cu = 0;
        hipGetDevice(&dev);
        hipDeviceGetAttribute(&cus, hipDeviceAttributeMultiprocessorCount, dev);
        if (hipFuncSetAttribute((const void*)mega_fwd, hipFuncAttributeMaxDynamicSharedMemorySize, LDS_BYTES) != hipSuccess) { fprintf(stderr, "hipFuncSetAttribute failed\n"); grid = -1; return; }
        hipOccupancyMaxActiveBlocksPerMultiprocessor(&per_cu, (const void*)mega_fwd, NTHREADS, LDS_BYTES);
        if (per_cu < 1) per_cu = 1;
        (void)hipGetLastError();
        grid = cus;
    }
    if (grid < 0) return;
    Params p{};
    for (int i = 0; i < 24; ++i) p.in[i] = (const float*)d_in[i];
    p.out = (float*)d_out; p.ws = (unsigned char*)d_ws;
#if MEGA
    int lo = 0, hi = NPHASES;
    void* args[] = {&p, &lo, &hi};
    hipError_t e = hipLaunchCooperativeKernel((const void*)mega_fwd, dim3(grid), dim3(NTHREADS), args, LDS_BYTES, stream);
    if (e != hipSuccess) fprintf(stderr, "cooperative launch failed: %s (grid %d)\n", hipGetErrorString(e), grid);
#else
    for (int ph = 0; ph < NPHASES; ++ph) hipLaunchKernelGGL(mega_fwd, dim3(grid), dim3(NTHREADS), LDS_BYTES, stream, p, ph, ph + 1);
#endif
}
```

```cpp
#include <hip/hip_runtime.h>
#include <hip/hip_cooperative_groups.h>
#include <cstdio>
namespace cg = cooperative_groups;

#ifndef PHMASK
#define PHMASK 511
#endif
#ifndef SUB
#define SUB 7
#endif
#ifndef REPMASK
#define REPMASK 0
#endif
#ifndef HYREP
#define HYREP 1
#endif
#ifndef MEGA
#define MEGA 1
#endif

#define LAS __attribute__((address_space(3)))
typedef unsigned short bf16_t;
typedef short bf16x8 __attribute__((ext_vector_type(8)));
typedef float f32x4 __attribute__((ext_vector_type(4)));
typedef float f32x16 __attribute__((ext_vector_type(16)));
typedef unsigned u32x4 __attribute__((ext_vector_type(4)));
typedef unsigned u32x2 __attribute__((ext_vector_type(2)));

constexpr int DM = 2048, TREAL = 32768, TTOK = 32864, TP = 33024, DFF = 5632;
constexpr int NTHREADS = 512;
constexpr int LDS_BYTES = 147456;
constexpr float EPSN = 1e-6f;

constexpr size_t WS_TAIL = 0;
constexpr size_t WS_XA   = WS_TAIL + (size_t)256 * DM * 4;
constexpr size_t WS_WIN  = WS_XA + (size_t)TP * DM * 2;
constexpr size_t WS_WOUT = WS_WIN + (size_t)4096 * DM * 2;
constexpr size_t WS_WGU  = WS_WOUT + (size_t)DM * DM * 2;
constexpr size_t WS_WDN  = WS_WGU + (size_t)2 * DFF * DM * 2;
constexpr size_t WS_H3   = WS_WDN + (size_t)DM * DFF * 2;
constexpr size_t WS_W4T  = WS_H3 + (size_t)(8208 + 4112) * 64 * 4;
constexpr size_t WS_BIG  = WS_W4T + (size_t)4096 * 64 * 4;
constexpr size_t WS_P    = WS_BIG;
constexpr size_t WS_UT   = WS_P + (size_t)TP * 1024 * 2;
constexpr size_t WS_GFS  = WS_UT + (size_t)3072 * TP * 2;
constexpr size_t WS_GFP  = WS_GFS + (size_t)2048 * 16416 * 2;
constexpr size_t WS_HID  = WS_BIG;
constexpr size_t WS_BAR  = WS_BIG + (size_t)TP * DFF * 2;
constexpr size_t WS_END  = WS_BAR + 16384;
static_assert(WS_GFP + (size_t)2048 * 8224 * 2 <= WS_BAR, "big region");

struct Params {
    const float* in[24];
    float* out;
    unsigned char* ws;
};
typedef const __attribute__((address_space(4))) unsigned long long* kseg_t;
struct DP {
    kseg_t ks; int tid, bid, nb;
    __device__ __forceinline__ const float* in_(int k) const { return (const float*)ks[k]; }
    __device__ __forceinline__ float* out_() const { return (float*)ks[24]; }
    __device__ __forceinline__ unsigned char* ws_() const { return (unsigned char*)ks[25]; }
};

__device__ __forceinline__ unsigned cvt_pk_bf16(float lo, float hi) { unsigned r; asm volatile("v_cvt_pk_bf16_f32 %0, %1, %2" : "=v"(r) : "v"(lo), "v"(hi)); return r; }
__device__ __forceinline__ bf16_t f2bf(float f) { return (bf16_t)(cvt_pk_bf16(f, 0.f) & 0xffffu); }
__device__ __forceinline__ float bf2f(unsigned v) { return __uint_as_float(v << 16); }
__device__ __forceinline__ float bflo(unsigned w) { return __uint_as_float(w << 16); }
__device__ __forceinline__ float bfhi(unsigned w) { return __uint_as_float(w & 0xffff0000u); }
__device__ __forceinline__ float wave_sum(float v) {
#pragma unroll
    for (int o = 32; o >= 1; o >>= 1) v += __shfl_xor(v, o);
    return v;
}
__device__ __forceinline__ int seq_rbase(int sq) { return sq < 4 ? sq * 4096 : 16384 + (sq - 4) * 8192; }
__device__ __forceinline__ int seq_row(int sq, int p) { return p < 16 ? TREAL + 16 * sq + p : seq_rbase(sq) + p - 16; }

namespace pg8 {
constexpr int BM = 256, BK = 64, HALF = 128, HTB = HALF * BK * 2, STAGE_BYTES = 8 * HTB, NXCD = 8, WGM = 8;
__device__ __forceinline__ int lds_byte(int r, int c) { const int st = (r >> 4) * 2 + (c >> 5), rr = r & 15, cc = c & 31, ob = rr * 64 + cc * 2; return st * 1024 + (ob ^ (((ob >> 9) & 1) << 5)); }
__device__ __forceinline__ void stage_rc(int b, int& R, int& C) { const int st = b / 1024, sb = b % 1024, swz = sb ^ (((sb >> 9) & 1) << 5); R = (st >> 1) * 16 + swz / 64; C = (st & 1) * 32 + (swz % 64) / 2; }
__device__ __forceinline__ int perm32(int rho) { const int n = rho >> 4, i = rho & 15; return 8 * (i >> 2) + 4 * n + (i & 3); }

struct Unit { const char* a; const char* b; int pm, pn, prob; };
struct Prob { const bf16_t* A; const bf16_t* Bt; int nM, nN; };
struct Sched2 {
    const bf16_t* A0; const bf16_t* B0; const bf16_t* A1; const bf16_t* B1; int nM0, nN0, nM1, nN1, nwg0, nwg1; int K, ld, G, c;
    __device__ __forceinline__ void init(const Prob& p0, const Prob& p1, int K_, int G_, int c_) { A0 = p0.A; B0 = p0.Bt; A1 = p1.A; B1 = p1.Bt; nM0 = p0.nM; nN0 = p0.nN; nM1 = p1.nM; nN1 = p1.nN;
        nwg0 = nM0 * nN0; nwg1 = nM1 * nN1; K = K_; ld = K_; G = G_; c = c_; }
    __device__ __forceinline__ bool next(int i, Unit& u) const {
        long L = (long)i * G + c; int q = 0;
        if (L >= nwg0) { L -= nwg0; q = 1; if (L >= nwg1) return false; }
        const int nM = q ? nM1 : nM0, nN = q ? nN1 : nN0, nw = q ? nwg1 : nwg0;
        int wgid = (int)L; { const int qq = nw / NXCD, r = nw % NXCD, xcd = wgid % NXCD, off = wgid / NXCD; wgid = (xcd < r ? xcd * (qq + 1) : r * (qq + 1) + (xcd - r) * qq) + off; }
        const int nig = WGM * nN, gid = wgid / nig, fm = gid * WGM, gsz = (nM - fm) < WGM ? (nM - fm) : WGM;
        u.pm = fm + ((wgid % nig) % gsz); u.pn = (wgid % nig) / gsz; u.prob = q;
        const size_t tstep = (size_t)BM * K * 2;
        u.a = (const char*)(q ? A1 : A0) + (size_t)u.pm * tstep; u.b = (const char*)(q ? B1 : B0) + (size_t)u.pn * tstep;
        return true;
    }
};

struct EpiStore {
    static constexpr bool PERM = true;
    bf16_t* O[2]; int ldc[2];
    __device__ __forceinline__ void operator()(const f32x4 (&acc)[2][2][4][2], const Unit& u, int wr, int wc, int fr, int fq) const {
        bf16_t* base = u.prob ? O[1] : O[0]; const int ld = u.prob ? ldc[1] : ldc[0];
        const int row0 = u.pm * BM + wr * 64 + fr, col0 = u.pn * BM + wc * 32 + 8 * fq;
#pragma unroll
        for (int ai = 0; ai < 2; ++ai)
#pragma unroll
            for (int m = 0; m < 4; ++m) { bf16_t* rowp = base + (size_t)(row0 + ai * HALF + m * 16) * ld + col0;
#pragma unroll
                for (int bj = 0; bj < 2; ++bj) { const f32x4 v0 = acc[ai][bj][m][0], v1 = acc[ai][bj][m][1];
                    u32x4 w; w.x = cvt_pk_bf16(v0[0], v0[1]); w.y = cvt_pk_bf16(v0[2], v0[3]); w.z = cvt_pk_bf16(v1[0], v1[1]); w.w = cvt_pk_bf16(v1[2], v1[3]);
                    *(u32x4*)(rowp + bj * HALF) = w; } }
    }
};
struct EpiResid {
    static constexpr bool PERM = false;
    float* hmain; float* htail;
    __device__ __forceinline__ void operator()(const f32x4 (&acc)[2][2][4][2], const Unit& u, int wr, int wc, int fr, int fq) const {
        float* base = (u.pm < TREAL / BM) ? hmain + (size_t)u.pm * BM * DM : htail;
        const int row0 = wr * 64 + fr, col0 = u.pn * BM + wc * 32 + 4 * fq;
#pragma unroll
        for (int ai = 0; ai < 2; ++ai)
#pragma unroll
            for (int m = 0; m < 4; ++m) { float* rowp = base + (size_t)(row0 + ai * HALF + m * 16) * DM + col0;
#pragma unroll
                for (int bj = 0; bj < 2; ++bj)
#pragma unroll
                    for (int n = 0; n < 2; ++n) { f32x4* p = (f32x4*)(rowp + bj * HALF + n * 16); *p = *p + acc[ai][bj][m][n]; }
                asm volatile("" ::: "memory"); }
    }
};
struct EpiSwiGLU {
    static constexpr bool PERM = true;
    bf16_t* O;
    __device__ __forceinline__ void operator()(const f32x4 (&acc)[2][2][4][2], const Unit& u, int wr, int wc, int fr, int fq) const {
        const int row0 = u.pm * BM + wr * 64 + fr, col0 = u.pn * HALF + wc * 32 + 8 * fq;
#pragma unroll
        for (int ai = 0; ai < 2; ++ai)
#pragma unroll
            for (int m = 0; m < 4; ++m) { bf16_t* rowp = O + (size_t)(row0 + ai * HALF + m * 16) * DFF + col0;
                float r[8];
#pragma unroll
                for (int n = 0; n < 2; ++n)
#pragma unroll
                    for (int e = 0; e < 4; ++e) { const float g = acc[ai][0][m][n][e], up = acc[ai][1][m][n][e];
                        r[n * 4 + e] = g * __builtin_amdgcn_rcpf(1.0f + __expf(-g)) * up; }
                u32x4 w; w.x = cvt_pk_bf16(r[0], r[1]); w.y = cvt_pk_bf16(r[2], r[3]); w.z = cvt_pk_bf16(r[4], r[5]); w.w = cvt_pk_bf16(r[6], r[7]);
                *(u32x4*)rowp = w; }
    }
};

struct SchedSplit {
    const bf16_t* A; const bf16_t* Bt; int nN, nK, K, ld, G, c;
    __device__ __forceinline__ bool next(int i, Unit& u) const {
        const long L = (long)i * G + c; if (L >= nN * nK) return false;
        const int pn = (int)L % nN, kc = (int)L / nN;
        u.pm = TREAL / BM; u.pn = pn; u.prob = 0;
        u.a = (const char*)(A + (size_t)u.pm * BM * ld + (size_t)kc * K); u.b = (const char*)(Bt + (size_t)pn * BM * ld + (size_t)kc * K);
        return true;
    }
};
struct EpiResidAtomic {
    static constexpr bool PERM = false;
    float* htail;
    __device__ __forceinline__ void operator()(const f32x4 (&acc)[2][2][4][2], const Unit& u, int wr, int wc, int fr, int fq) const {
        const int col0 = u.pn * BM + wc * 32 + 4 * fq;
#pragma unroll
        for (int m = 0; m < 4; ++m) { const int row = wr * 64 + m * 16 + fr;
            if (row < 96) { float* rowp = htail + (size_t)row * DM + col0;
#pragma unroll
                for (int bj = 0; bj < 2; ++bj)
#pragma unroll
                    for (int n = 0; n < 2; ++n)
#pragma unroll
                        for (int e = 0; e < 4; ++e) atomicAdd(rowp + bj * HALF + n * 16 + e, acc[0][bj][m][n][e]); } }
    }
};
template <class Epi, class Sched>
__device__ __forceinline__ void gemm_phase(const DP& p, LAS unsigned char* lds, const Sched& S, const Epi& E) {
    const int tid = p.tid, wid = __builtin_amdgcn_readfirstlane(tid >> 6), lane = tid & 63, wr = wid >> 2, wc = wid & 3, fr = lane & 15, fq = lane >> 4;
    const int K = S.ld, nt = S.K / BK;
    unsigned voffA[2], voffB[2];
#pragma unroll
    for (int i = 0; i < 2; ++i) { int R, C; stage_rc(tid * 16 + i * 8192, R, C); const int Rb = Epi::PERM ? ((R & ~31) + perm32(R & 31)) : R;
        voffA[i] = (unsigned)(R * K + C) * 2u; voffB[i] = (unsigned)(Rb * K + C) * 2u; }
    const size_t kstep = (size_t)(BK * 2);
    const size_t hstep = (size_t)HALF * K * 2;
    const unsigned ldsw = (unsigned)wid * 1024u;
    const int aoff = lds_byte(wr * 64 + fr, fq * 8), boff = lds_byte(wc * 32 + fr, fq * 8);
#define PG8_SA(b, h) (((b) * 2 + (h)) * HTB)
#define PG8_SB(b, h) ((4 + (b) * 2 + (h)) * HTB)
#define PG8_STAGE(bufoff, gbase, voff) do { _Pragma("unroll") for (int _i = 0; _i < 2; ++_i) \
        __builtin_amdgcn_global_load_lds((const unsigned*)((const char*)(gbase) + (voff)[_i]), (LAS unsigned*)(lds + (bufoff) + ldsw + _i * 8192), 16, 0, 0); } while (0)
#define PG8_LDA(dst, b, h) do { _Pragma("unroll") for (int m = 0; m < 4; ++m) _Pragma("unroll") for (int k = 0; k < 2; ++k) dst[m][k] = *(const LAS bf16x8*)(lds + PG8_SA(b, h) + aoff + m * 2048 + k * 1024); } while (0)
#define PG8_LDB(dst, b, h) do { _Pragma("unroll") for (int n = 0; n < 2; ++n) _Pragma("unroll") for (int k = 0; k < 2; ++k) dst[n][k] = *(const LAS bf16x8*)(lds + PG8_SB(b, h) + boff + n * 2048 + k * 1024); } while (0)
#define PG8_MMA(ai, bj, At, Bt) do { __builtin_amdgcn_s_setprio(1); _Pragma("unroll") for (int m = 0; m < 4; ++m) _Pragma("unroll") for (int n = 0; n < 2; ++n) _Pragma("unroll") for (int k = 0; k < 2; ++k) \
        acc[ai][bj][m][n] = __builtin_amdgcn_mfma_f32_16x16x32_bf16(Bt[n][k], At[m][k], acc[ai][bj][m][n], 0, 0, 0); __builtin_amdgcn_s_setprio(0); } while (0)
#define PG8_WAIT_V(n) asm volatile("s_waitcnt vmcnt(" #n ")" ::: "memory")
#define PG8_WAIT_L(n) asm volatile("s_waitcnt lgkmcnt(" #n ")" ::: "memory")
#define PG8_BAR __builtin_amdgcn_s_barrier()
#define PG8_SCHED __builtin_amdgcn_sched_barrier(0)
    Unit cur, nxt; int ui = 0;
    if (!S.next(0, cur)) return;
    f32x4 acc[2][2][4][2];
#pragma unroll
    for (int a = 0; a < 2; ++a)
#pragma unroll
        for (int b = 0; b < 2; ++b)
#pragma unroll
            for (int m = 0; m < 4; ++m)
#pragma unroll
                for (int n = 0; n < 2; ++n) acc[a][b][m][n] = (f32x4){0.f, 0.f, 0.f, 0.f};
    bf16x8 At[4][2], B0[2][2], B1[2][2];
    const char* cA = cur.a; const char* cB = cur.b;
    PG8_STAGE(PG8_SB(0, 0), cB, voffB); PG8_STAGE(PG8_SA(0, 0), cA, voffA); PG8_STAGE(PG8_SB(0, 1), cB + hstep, voffB); PG8_STAGE(PG8_SA(0, 1), cA + hstep, voffA);
    if (wr == 1) PG8_BAR;
    PG8_WAIT_V(4); PG8_BAR;
    PG8_STAGE(PG8_SB(1, 0), cB + kstep, voffB); PG8_STAGE(PG8_SA(1, 0), cA + kstep, voffA); PG8_STAGE(PG8_SB(1, 1), cB + hstep + kstep, voffB);
    PG8_WAIT_V(6); PG8_BAR;
    for (;;) {
        const bool has_next = S.next(ui + 1, nxt);
        const char* nA = has_next ? nxt.a : cA; const char* nB = has_next ? nxt.b : cB;
        for (int t = 0; t < nt; t += 2) {
            const bool last = (t == nt - 2);
            const char* a1 = cA + (size_t)(t + 1) * kstep;
            const char* a2 = last ? nA : cA + (size_t)(t + 2) * kstep; const char* b2 = last ? nB : cB + (size_t)(t + 2) * kstep;
            const char* a3 = a2 + kstep; const char* b3 = b2 + kstep;
            PG8_LDB(B0, 0, 0); PG8_SCHED; PG8_LDA(At, 0, 0); PG8_STAGE(PG8_SA(1, 1), a1 + hstep, voffA);
            PG8_WAIT_L(8); PG8_BAR; PG8_WAIT_L(0); PG8_MMA(0, 0, At, B0); PG8_BAR; PG8_SCHED;
            PG8_LDB(B1, 0, 1); PG8_STAGE(PG8_SB(0, 0), b2, voffB);
            PG8_BAR; PG8_WAIT_L(0); PG8_MMA(0, 1, At, B1); PG8_BAR;
            PG8_LDA(At, 0, 1); PG8_STAGE(PG8_SA(0, 0), a2, voffA);
            PG8_BAR; PG8_WAIT_L(0); PG8_MMA(1, 0, At, B0); PG8_BAR; PG8_SCHED;
            PG8_STAGE(PG8_SB(0, 1), b2 + hstep, voffB);
            PG8_WAIT_V(6); PG8_BAR; PG8_MMA(1, 1, At, B1); PG8_BAR;
            PG8_LDB(B0, 1, 0); PG8_SCHED; PG8_LDA(At, 1, 0); PG8_STAGE(PG8_SA(0, 1), a2 + hstep, voffA);
            PG8_WAIT_L(8); PG8_BAR; PG8_WAIT_L(0); PG8_MMA(0, 0, At, B0); PG8_BAR; PG8_SCHED;
            PG8_LDB(B1, 1, 1); PG8_STAGE(PG8_SB(1, 0), b3, voffB);
            PG8_BAR; PG8_WAIT_L(0); PG8_MMA(0, 1, At, B1); PG8_BAR;
            PG8_LDA(At, 1, 1); PG8_STAGE(PG8_SA(1, 0), a3, voffA);
            PG8_BAR; PG8_WAIT_L(0); PG8_MMA(1, 0, At, B0); PG8_BAR; PG8_SCHED;
            PG8_STAGE(PG8_SB(1, 1), b3 + hstep, voffB);
            PG8_WAIT_V(6); PG8_BAR; PG8_MMA(1, 1, At, B1); PG8_BAR;
        }
        E(acc, cur, wr, wc, fr, fq);
        if (!has_next) break;
#pragma unroll
        for (int a = 0; a < 2; ++a)
#pragma unroll
            for (int b = 0; b < 2; ++b)
#pragma unroll
                for (int m = 0; m < 4; ++m)
#pragma unroll
                    for (int n = 0; n < 2; ++n) acc[a][b][m][n] = (f32x4){0.f, 0.f, 0.f, 0.f};
        cur = nxt; cA = nA; cB = nB; ++ui;
    }
    PG8_WAIT_V(0);
    if (wr == 0) PG8_BAR;
    PG8_BAR;
#undef PG8_SA
#undef PG8_SB
#undef PG8_STAGE
#undef PG8_LDA
#undef PG8_LDB
#undef PG8_MMA
#undef PG8_WAIT_V
#undef PG8_WAIT_L
#undef PG8_BAR
#undef PG8_SCHED
}
}

__device__ __forceinline__ void norm_rows(const DP& p, int mode, const float* gain) {
    const int lane = p.tid & 63, gw = p.bid * 8 + (p.tid >> 6), nw = p.nb * 8;
    float* tail = (float*)(p.ws_() + WS_TAIL); bf16_t* hn = (bf16_t*)(p.ws_() + WS_XA);
    const int nrows = (mode == 2) ? TREAL : TP;
    f32x4 g[8];
#pragma unroll
    for (int j = 0; j < 8; ++j) g[j] = *(const f32x4*)(gain + 4 * (lane + 64 * j));
    for (int r = gw; r < nrows; r += nw) {
        if (r >= TTOK) {
#pragma unroll
            for (int j = 0; j < 8; ++j) { *(u32x2*)(hn + (size_t)r * DM + 4 * (lane + 64 * j)) = (u32x2){0u, 0u};
                if (mode == 0) *(f32x4*)(tail + (size_t)(r - TREAL) * DM + 4 * (lane + 64 * j)) = (f32x4){0.f, 0.f, 0.f, 0.f}; }
            continue;
        }
        float* hrow = (r < TREAL) ? p.out_() + (size_t)r * DM : tail + (size_t)(r - TREAL) * DM;
        const float* src = hrow;
        if (mode == 0) src = (r < 16384) ? p.in_(0) + (size_t)r * DM : (r < TREAL) ? p.in_(1) + (size_t)(r - 16384) * DM : p.in_(2) + (size_t)((r - TREAL) & 15) * DM;
        f32x4 v[8]; float ss = 0.f;
#pragma unroll
        for (int j = 0; j < 8; ++j) { v[j] = *(const f32x4*)(src + 4 * (lane + 64 * j)); ss += v[j][0] * v[j][0] + v[j][1] * v[j][1] + v[j][2] * v[j][2] + v[j][3] * v[j][3]; }
        ss = wave_sum(ss);
        const float rstd = 1.0f / sqrtf(ss * (1.0f / DM) + EPSN);
#pragma unroll
        for (int j = 0; j < 8; ++j) {
            const f32x4 o = v[j] * rstd * g[j];
            if (mode == 0) *(f32x4*)(hrow + 4 * (lane + 64 * j)) = v[j];
            if (mode == 2) *(f32x4*)(hrow + 4 * (lane + 64 * j)) = o;
            else { u32x2 w; w.x = cvt_pk_bf16(o[0], o[1]); w.y = cvt_pk_bf16(o[2], o[3]); *(u32x2*)(hn + (size_t)r * DM + 4 * (lane + 64 * j)) = w; }
        }
    }
}

__device__ __forceinline__ void transpose_cvt(const DP& p, LAS unsigned char* lds, const float* src, int K, int N, bf16_t* dst, int ldd, int koff, int mode) {
    LAS float* tile = (LAS float*)lds;
    const int tid = p.tid, nkt = K / 64, nnt = N / 64;
    for (int t = p.bid; t < nkt * nnt; t += p.nb) {
        const int k0 = (t / nnt) * 64, n0 = (t % nnt) * 64;
#pragma unroll
        for (int it = 0; it < 2; ++it) { const int e = tid + it * 512, kk = e >> 4, n4 = e & 15;
            const f32x4 v = *(const f32x4*)(src + (size_t)(k0 + kk) * N + n0 + 4 * n4);
            tile[kk * 65 + 4 * n4 + 0] = v[0]; tile[kk * 65 + 4 * n4 + 1] = v[1]; tile[kk * 65 + 4 * n4 + 2] = v[2]; tile[kk * 65 + 4 * n4 + 3] = v[3]; }
        __syncthreads();
        { const int nn = tid >> 3, k8 = tid & 7; float f[8];
#pragma unroll
          for (int j = 0; j < 8; ++j) f[j] = tile[(8 * k8 + j) * 65 + nn];
          const int n = n0 + nn; const int drow = (mode == 0) ? n : ((n >> 7) * 256 + (n & 127) + (mode == 2 ? 128 : 0));
          u32x4 w; w.x = cvt_pk_bf16(f[0], f[1]); w.y = cvt_pk_bf16(f[2], f[3]); w.z = cvt_pk_bf16(f[4], f[5]); w.w = cvt_pk_bf16(f[6], f[7]);
          *(u32x4*)(dst + (size_t)drow * ldd + koff + k0 + 8 * k8) = w; }
        __syncthreads();
    }
}
__device__ __forceinline__ void fold_pool(const DP& p, const float* pw, const float* sc, const float* wo, bf16_t* dst) {
    const int tid = p.tid;
    for (int it = p.bid; it < 512; it += p.nb) {
        const int g = it >> 7, c8 = (it >> 2) & 31, n = (it & 3) * 512 + tid;
        float acc[8];
#pragma unroll
        for (int e = 0; e < 8; ++e) acc[e] = 0.f;
        const float* pwr = pw + (size_t)(g * 256 + c8 * 8) * 256;
        for (int d = 0; d < 256; ++d) {
            const float wv = wo[(size_t)(g * 256 + d) * DM + n] * sc[g * 256 + d];
#pragma unroll
            for (int e = 0; e < 8; ++e) acc[e] += pwr[e * 256 + d] * wv;
        }
        u32x4 w; w.x = cvt_pk_bf16(acc[0], acc[1]); w.y = cvt_pk_bf16(acc[2], acc[3]); w.z = cvt_pk_bf16(acc[4], acc[5]); w.w = cvt_pk_bf16(acc[6], acc[7]);
        *(u32x4*)(dst + (size_t)n * DM + g * 256 + c8 * 8) = w;
    }
}
__device__ __forceinline__ void prep_weights(const DP& p, LAS unsigned char* lds, int l) {
    transpose_cvt(p, lds, p.in_(4) + (size_t)l * DM * 4096, DM, 4096, (bf16_t*)(p.ws_() + WS_WIN), DM, 0, 0);
    transpose_cvt(p, lds, p.in_(18) + (size_t)l * DM * DM + (size_t)1024 * DM, 1024, DM, (bf16_t*)(p.ws_() + WS_WOUT), DM, 1024, 0);
    transpose_cvt(p, lds, p.in_(20) + (size_t)l * DM * DFF, DM, DFF, (bf16_t*)(p.ws_() + WS_WGU), DM, 0, 1);
    transpose_cvt(p, lds, p.in_(21) + (size_t)l * DM * DFF, DM, DFF, (bf16_t*)(p.ws_() + WS_WGU), DM, 0, 2);
    transpose_cvt(p, lds, p.in_(22) + (size_t)l * DFF * DM, DFF, DM, (bf16_t*)(p.ws_() + WS_WDN), DFF, 0, 0);
    fold_pool(p, p.in_(5) + (size_t)l * 4 * 256 * 256, p.in_(6) + (size_t)l * 1024, p.in_(18) + (size_t)l * DM * DM, (bf16_t*)(p.ws_() + WS_WOUT));
    { const float* w4 = p.in_(16) + (size_t)l * 64 * 4096; float* w4t = (float*)(p.ws_() + WS_W4T);
      for (int i = p.bid * NTHREADS + p.tid; i < 4096 * 64; i += p.nb * NTHREADS) w4t[i] = w4[(size_t)(i & 63) * 4096 + (i >> 6)]; }
}

__device__ __forceinline__ void mlp_layer(LAS float* hl, int lane, int nin, const float* w, const float* b, const float* fr) {
    float acc[64];
#pragma unroll
    for (int j = 0; j < 64; ++j) acc[j] = b[j];
#pragma unroll 1
    for (int i = 0; i < nin; ++i) {
        const float hv = hl[i * 64 + lane];
#pragma unroll
        for (int j = 0; j < 64; ++j) acc[j] += hv * w[i * 64 + j];
    }
#pragma unroll
    for (int j = 0; j < 64; ++j) hl[j * 64 + lane] = __sinf(fr[j] * acc[j]);
}
__device__ __forceinline__ void filter_h3(const DP& p, LAS unsigned char* lds, int l) {
    const int lane = p.tid & 63, wv = __builtin_amdgcn_readfirstlane(p.tid >> 6), gw = __builtin_amdgcn_readfirstlane(p.bid * 8 + (p.tid >> 6)), nw = p.nb * 8;
    const float* w1 = p.in_(9) + (size_t)l * 33 * 64; const float* b1 = p.in_(10) + l * 64;
    const float* w2 = p.in_(11) + (size_t)l * 64 * 64; const float* b2 = p.in_(12) + l * 64;
    const float* w3 = p.in_(13) + (size_t)l * 64 * 64; const float* b3 = p.in_(14) + l * 64;
    const float* fr = p.in_(15) + l * 64;
    float* h3 = (float*)(p.ws_() + WS_H3);
    LAS float* hl = (LAS float*)lds + wv * 4096;
    for (int item = gw; item < 129 + 65; item += nw) {
        const int tr = item < 129 ? 1 : 0, tile = tr ? item : item - 129, L = tr ? 8208 : 4112;
        const int n = tile * 64 + lane; const bool valid = n < L;
        const float nf = (float)n, t = nf / (float)(L - 1);
        hl[lane] = t;
#pragma unroll
        for (int b = 0; b < 16; ++b) { const float band = 1e-4f + (float)b * ((15.0f - 1e-4f) / 15.0f);
            const float ang = (6.283185307179586f / (float)L) * nf * band; hl[(1 + b) * 64 + lane] = __cosf(ang); hl[(17 + b) * 64 + lane] = -__sinf(ang); }
        mlp_layer(hl, lane, 33, w1, b1, fr);
        mlp_layer(hl, lane, 64, w2, b2, fr);
        mlp_layer(hl, lane, 64, w3, b3, fr);
        if (valid) { float* o = h3 + (size_t)((tr ? 0 : 8208) + n) * 64;
#pragma unroll
            for (int j = 0; j < 16; ++j) *(f32x4*)(o + 4 * j) = (f32x4){hl[(4 * j) * 64 + lane], hl[(4 * j + 1) * 64 + lane], hl[(4 * j + 2) * 64 + lane], hl[(4 * j + 3) * 64 + lane]}; }
    }
}
__device__ __forceinline__ bf16x8 cvt8(const f32x4 a, const f32x4 b) { u32x4 o; o.x = cvt_pk_bf16(a[0], a[1]); o.y = cvt_pk_bf16(a[2], a[3]); o.z = cvt_pk_bf16(b[0], b[1]); o.w = cvt_pk_bf16(b[2], b[3]); return __builtin_bit_cast(bf16x8, o); }
__device__ __forceinline__ void filter_gen(const DP& p, LAS unsigned char* lds, int l) {
    const int lane = p.tid & 63, wv = __builtin_amdgcn_readfirstlane(p.tid >> 6), gw = __builtin_amdgcn_readfirstlane(p.bid * 8 + (p.tid >> 6)), nw = p.nb * 8;
    const float* w4t = (const float*)(p.ws_() + WS_W4T); const float* h3 = (const float*)(p.ws_() + WS_H3);
    const float* skip = p.in_(17) + (size_t)l * 2 * 1024;
    LAS bf16_t* S = (LAS bf16_t*)(lds + wv * 8448);
    const int col = lane & 31, hh = lane >> 5;
    constexpr int NS = 2 * 65 * 8, NPI = 2 * 33 * 8;
    for (int item = gw; item < NS + NPI; item += nw) {
        const int tr = item < NS ? 1 : 0, it2 = tr ? item : item - NS;
        const int L = tr ? 8208 : 4112, GL = 2 * L;
        const int part = it2 & 7, bd = it2 >> 3, dir = bd & 1, b = bd >> 1, o = part >> 2, ct0 = (part & 3) * 8;
        const int nbase = 128 * b + dir;
        const float invL1 = 1.0f / (float)(L - 1);
        bf16x8 A[4][4];
#pragma unroll
        for (int r = 0; r < 4; ++r) {
            int n = nbase + 32 * r + col; n = n < L ? n : L - 1;
            const float* hr = h3 + (size_t)((tr ? 0 : 8208) + n) * 64 + 8 * hh;
#pragma unroll
            for (int s4 = 0; s4 < 4; ++s4) A[r][s4] = cvt8(*(const f32x4*)(hr + 16 * s4), *(const f32x4*)(hr + 16 * s4 + 4));
        }
        bf16_t* gbase = (bf16_t*)(p.ws_() + (tr ? WS_GFS : WS_GFP)) + (size_t)o * 1024 * GL;
        const int ebase = dir ? L + 128 * b : L - 128 * b - 128;
#pragma unroll 1
        for (int ct = 0; ct < 8; ++ct) {
            const int c = (ct0 + ct) * 32 + col;
            const float* wr = w4t + (size_t)(o * 2048 + dir * 1024 + c) * 64 + 8 * hh;
            bf16x8 Bf[4];
#pragma unroll
            for (int s4 = 0; s4 < 4; ++s4) Bf[s4] = cvt8(*(const f32x4*)(wr + 16 * s4), *(const f32x4*)(wr + 16 * s4 + 4));
            const float d0 = -3.0701134573253946f, d1 = -15.350567286626973f;
            const float kc = -fabsf(d0 + (float)c * ((d1 - d0) / 1023.0f)) * 1.4426950408889634f;
            const float sk = skip[o * 1024 + c];
#pragma unroll
            for (int r = 0; r < 4; ++r) {
                f32x16 acc;
#pragma unroll
                for (int i = 0; i < 16; ++i) acc[i] = 0.f;
#pragma unroll
                for (int s4 = 0; s4 < 4; ++s4) acc = __builtin_amdgcn_mfma_f32_32x32x16_bf16(A[r][s4], Bf[s4], acc, 0, 0, 0);
#pragma unroll
                for (int q = 0; q < 4; ++q) {
                    const int nl0 = 32 * r + 8 * q + 4 * hh;
                    float v[4];
#pragma unroll
                    for (int e = 0; e < 4; ++e) { const int n = nbase + nl0 + e; const float t = (float)n * invL1;
                        v[e] = acc[4 * q + e] * __builtin_amdgcn_exp2f(t * kc); }
                    if (r == 0 && q == 0) v[0] += (nbase + nl0 == 0 && dir == 0) ? sk : 0.f;
                    u32x2 w;
                    if (dir) { w.x = cvt_pk_bf16(v[0], v[1]); w.y = cvt_pk_bf16(v[2], v[3]); *(LAS u32x2*)(S + col * 132 + nl0) = w; }
                    else     { w.x = cvt_pk_bf16(v[3], v[2]); w.y = cvt_pk_bf16(v[1], v[0]); *(LAS u32x2*)(S + col * 132 + 124 - nl0) = w; }
                }
            }
#pragma unroll
            for (int u = 0; u < 8; ++u) {
                const int id = u * 64 + lane, colr = id >> 4, k = id & 15;
                const u32x2 lo = *(const LAS u32x2*)(S + colr * 132 + 8 * k), hi = *(const LAS u32x2*)(S + colr * 132 + 8 * k + 4);
                const int e0 = ebase + 8 * k;
                if ((unsigned)e0 <= (unsigned)(GL - 8)) *(u32x4*)(gbase + (size_t)((ct0 + ct) * 32 + colr) * GL + e0) = (u32x4){lo.x, lo.y, hi.x, hi.y};
            }
        }
    }
}

__device__ __forceinline__ void pool_acc(float (&s)[8], const u32x4 v, float sg) {
    s[0] += sg * bflo(v.x); s[1] += sg * bfhi(v.x); s[2] += sg * bflo(v.y); s[3] += sg * bfhi(v.y); s[4] += sg * bflo(v.z); s[5] += sg * bfhi(v.z); s[6] += sg * bflo(v.w); s[7] += sg * bfhi(v.w);
}
__device__ __forceinline__ void pool_window(const DP& p) {
    const bf16_t* P = (const bf16_t*)(p.ws_() + WS_P); bf16_t* mix = (bf16_t*)(p.ws_() + WS_XA);
    const int total = (4 * 257 + 2 * 513) * 128;
    for (int idx = p.bid * NTHREADS + p.tid; idx < total; idx += p.nb * NTHREADS) {
        const int run = idx >> 7, c8 = idx & 127;
        int sq, r, L;
        if (run < 4 * 257) { sq = run / 257; r = run - sq * 257; L = 4112; } else { const int r2 = run - 4 * 257; sq = 4 + r2 / 513; r = r2 - (sq - 4) * 513; L = 8208; }
        const int hw = 1 << (c8 >> 5), p0 = 16 * r;
        const bf16_t* Pc = P + 8 * c8;
        float s[8];
#pragma unroll
        for (int e = 0; e < 8; ++e) s[e] = 0.f;
        { const int lo = p0 - hw < 0 ? 0 : p0 - hw, hi = p0 + hw > L ? L : p0 + hw;
          for (int q = lo; q < hi; ++q) pool_acc(s, *(const u32x4*)(Pc + (size_t)seq_row(sq, q) * 1024), 1.0f); }
#pragma unroll 4
        for (int i = 0; i < 16; ++i) {
            const int pp = p0 + i;
            const int lo = pp - hw < 0 ? 0 : pp - hw, hi = pp + hw > L ? L : pp + hw;
            const float inv = 1.0f / (float)(hi - lo);
            const int row = seq_row(sq, pp);
            const u32x4 v = *(const u32x4*)(Pc + (size_t)row * 1024);
            u32x4 w;
            w.x = cvt_pk_bf16(s[0] * inv - bflo(v.x), s[1] * inv - bfhi(v.x)); w.y = cvt_pk_bf16(s[2] * inv - bflo(v.y), s[3] * inv - bfhi(v.y));
            w.z = cvt_pk_bf16(s[4] * inv - bflo(v.z), s[5] * inv - bfhi(v.z)); w.w = cvt_pk_bf16(s[6] * inv - bflo(v.w), s[7] * inv - bfhi(v.w));
            *(u32x4*)(mix + (size_t)row * DM + 8 * c8) = w;
            if (pp + hw < L) pool_acc(s, *(const u32x4*)(Pc + (size_t)seq_row(sq, pp + hw) * 1024), 1.0f);
            if (pp - hw >= 0) pool_acc(s, *(const u32x4*)(Pc + (size_t)seq_row(sq, pp - hw) * 1024), -1.0f);
        }
    }
}

constexpr int HYH_U = 0, HYH_FB = 35840, HYH_ZB = HYH_FB + 33280, HYH_RED = HYH_ZB + 512, HYH_SIZE = HYH_RED + 1024;
static_assert(2 * HYH_SIZE <= LDS_BYTES, "hyena LDS");
constexpr int FPAD = 176;
template <int TR> struct HG;
template <> struct HG<1> { static constexpr int L = 8208, B = 2, NSB = 16, BSE = 8720, NIN = 513, SQ0 = 4; };
template <> struct HG<0> { static constexpr int L = 4112, B = 4, NSB = 8,  BSE = 4416, NIN = 257, SQ0 = 0; };
__device__ __forceinline__ int uphys(int q) { return q + 8 * (q >> 7); }

struct ARaw { u32x2 w01, w23, w45; };
__device__ __forceinline__ ARaw hy_raw_a(const LAS unsigned char* p8) { ARaw r; r.w01 = *(const LAS u32x2*)p8; r.w23 = *(const LAS u32x2*)(p8 + 8); r.w45 = *(const LAS u32x2*)(p8 + 16); return r; }
__device__ __forceinline__ bf16x8 hy_fin_a(const ARaw& r, bool dsel, unsigned bsh) {
    const unsigned s0 = dsel ? r.w01.y : r.w01.x, s1 = dsel ? r.w23.x : r.w01.y, s2 = dsel ? r.w23.y : r.w23.x, s3 = dsel ? r.w45.x : r.w23.y, s4 = dsel ? r.w45.y : r.w45.x;
    u32x4 o; o.x = __builtin_amdgcn_alignbit(s1, s0, bsh); o.y = __builtin_amdgcn_alignbit(s2, s1, bsh); o.z = __builtin_amdgcn_alignbit(s3, s2, bsh); o.w = __builtin_amdgcn_alignbit(s4, s3, bsh);
    return __builtin_bit_cast(bf16x8, o);
}
template <int TR>
__device__ __forceinline__ void hy_conv(LAS unsigned char* hl, int wq, int lane, f32x16 (&acc)[4]) {
    typedef HG<TR> G;
    const LAS unsigned char* Ub = hl + HYH_U; const LAS unsigned char* FBb = hl + HYH_FB;
    asm volatile("" : "+v"(lane));
    const int n = lane & 31, h = lane >> 5;
    const int sbi = n % G::NSB, beta = n / G::NSB, sb0 = wq * G::NSB;
    const int abase = FPAD + (G::L - 1) - n + 8 * h;
    const int ab2 = 2 * abase, ab8 = ab2 & ~7; const bool dsel = (ab2 & 4) != 0; const unsigned bsh = (ab2 & 2) ? 16u : 0u;
    constexpr int KS = (G::L - 16) / 16 + 8 * (G::NSB - 1) + 1, NIT = (KS + 1) / 2, NOUT = (NIT + 3) / 4;
    const int dlo = 128 * sb0 - (G::L - 16);
    constexpr int MMAX = (G::L - 16) / 128;
#pragma unroll
    for (int r = 0; r < 4; ++r)
#pragma unroll
        for (int i = 0; i < 16; ++i) acc[r][i] = 0.f;
    bf16x8 qe[4], qo[4];
#pragma unroll
    for (int r = 0; r < 4; ++r) { qe[r] = hy_fin_a(hy_raw_a(FBb + (ab8 - 2 * (dlo + 32 * r))), dsel, bsh); qo[r] = hy_fin_a(hy_raw_a(FBb + (ab8 - 2 * (dlo + 16 + 32 * r))), dsel, bsh); }
    const int ub2 = 2 * (beta * G::BSE + 8 * h);
    int M = sbi + MMAX;
    const LAS unsigned char* zb = hl + HYH_ZB + 256;
#define HY_PB(MM, first) ({ const bool v_ = (first) ? ((unsigned)(MM) <= (unsigned)MMAX) : ((unsigned)((MM) - 1) < (unsigned)MMAX); v_ ? (Ub + ub2 + 272 * (MM)) : zb; })
    const LAS unsigned char* pb0 = HY_PB(M, true); const LAS unsigned char* pb1 = HY_PB(M, false);
    bf16x8 be = *(const LAS bf16x8*)pb0, bo = *(const LAS bf16x8*)(pb1 - 2 * (16 + 8));
    const LAS unsigned char* pa = FBb + (ab8 - 2 * (dlo + 128));
    ARaw rac = hy_raw_a(pa), rbc = hy_raw_a(pa - 32);
#pragma unroll 1
    for (int I = 0; I < NOUT; ++I) {
        const LAS unsigned char* pn0 = HY_PB(M - 1, true); const LAS unsigned char* pn1 = HY_PB(M - 1, false);
#pragma unroll
        for (int j = 0; j < 4; ++j) {
            const ARaw ran = hy_raw_a(pa - 64 * (j + 1)), rbn = hy_raw_a(pa - 64 * (j + 1) - 32);
            bf16x8 nbe, nbo;
            if (j < 3) { nbe = *(const LAS bf16x8*)(pb1 - 2 * (32 * (j + 1) + 8)); nbo = *(const LAS bf16x8*)(pb1 - 2 * (32 * (j + 1) + 16 + 8)); }
            else       { nbe = *(const LAS bf16x8*)pn0;                            nbo = *(const LAS bf16x8*)(pn1 - 2 * (16 + 8)); }
#pragma unroll
            for (int r = 0; r < 4; ++r) acc[r] = __builtin_amdgcn_mfma_f32_32x32x16_bf16(qe[(j + r) & 3], be, acc[r], 0, 0, 0);
#pragma unroll
            for (int r = 0; r < 4; ++r) acc[r] = __builtin_amdgcn_mfma_f32_32x32x16_bf16(qo[(j + r) & 3], bo, acc[r], 0, 0, 0);
            qe[j] = hy_fin_a(rac, dsel, bsh); qo[j] = hy_fin_a(rbc, dsel, bsh);
            rac = ran; rbc = rbn; be = nbe; bo = nbo;
        }
        pa -= 256; pb0 = pn0; pb1 = pn1; --M;
    }
#undef HY_PB
    {
        f32x16 at;
#pragma unroll
        for (int i = 0; i < 16; ++i) at[i] = 0.f;
        constexpr int MS = (G::NIN + 3) / 4;
        const int m0 = wq * MS, m1 = (m0 + MS < G::NIN) ? m0 + MS : G::NIN;
        const bool colv = n < G::B;
        const int ut2 = 2 * ((colv ? n : 0) * G::BSE + 8 * h);
#pragma unroll 2
        for (int m = m0; m < m1; ++m) {
            const int d = (G::L - 16) - 16 * m;
            const bf16x8 a = hy_fin_a(hy_raw_a(FBb + (ab8 - 2 * d)), dsel, bsh);
            const bf16x8 b = *(const LAS bf16x8*)(colv ? Ub + ut2 + 2 * (16 * m + 8 * ((16 * m) >> 7)) : zb);
            at = __builtin_amdgcn_mfma_f32_32x32x16_bf16(a, b, at, 0, 0, 0);
        }
        LAS float* RED = (LAS float*)(hl + HYH_RED);
        if (colv) {
#pragma unroll
            for (int i = 0; i < 8; ++i) { const int arow = (i & 3) + 8 * (i >> 2) + 4 * h; RED[(wq * 16 + arow) * 4 + n] = at[i]; }
        }
    }
}
template <int TR>
__device__ __forceinline__ void hy_load_stream(const DP& p, LAS unsigned char* hl, int lt, int l, int k, int c, bool toU) {
    typedef HG<TR> G;
    asm volatile("" : "+v"(lt));
    const int ch = k * 1024 + c;
    const float* cw = p.in_(7) + (size_t)l * 3 * 3072; const float* cb = p.in_(8) + (size_t)l * 3072;
    const float w0 = cw[ch], w1 = cw[3072 + ch], w2 = cw[2 * 3072 + ch], bb = cb[ch];
    const bf16_t* src = (const bf16_t*)(p.ws_() + WS_UT) + (size_t)ch * TP;
    LAS bf16_t* U = (LAS bf16_t*)(hl + HYH_U); LAS bf16_t* X = (LAS bf16_t*)(hl + HYH_FB);
    constexpr int nch = G::L / 8, NCH = G::B * nch, NI = (NCH + 255) / 256;
    constexpr int GB = 3;
#pragma unroll
    for (int g0 = 0; g0 < NI; g0 += GB) {
        u32x4 v[GB]; unsigned short xl[GB], xr[GB];
#pragma unroll
        for (int i = 0; i < GB; ++i) {
            int idx = lt + 256 * (g0 + i); idx = idx < NCH ? idx : NCH - 1;
            const int b = idx / nch, q = idx - b * nch, p0 = 8 * q, sq = G::SQ0 + b;
            const int moff = TREAL + 16 * sq, roff = seq_rbase(sq);
            const int off = p0 < 16 ? moff + p0 : roff + p0 - 16;
            v[i] = *(const u32x4*)(src + off);
            xl[i] = src[p0 == 0 ? off : (p0 == 16 ? moff + 15 : off - 1)];
            xr[i] = src[p0 + 8 >= G::L ? off : (p0 + 8 == 16 ? roff : off + 8)];
        }
#pragma unroll
        for (int i = 0; i < GB; ++i) {
            const int idx = lt + 256 * (g0 + i);
            if (g0 + i < NI && idx < NCH) {
                const int b = idx / nch, q = idx - b * nch, p0 = 8 * q;
                float x[10];
                x[0] = (p0 == 0) ? 0.f : bf2f(xl[i]);
                x[9] = (p0 + 8 >= G::L) ? 0.f : bf2f(xr[i]);
                x[1] = bflo(v[i].x); x[2] = bfhi(v[i].x); x[3] = bflo(v[i].y); x[4] = bfhi(v[i].y); x[5] = bflo(v[i].z); x[6] = bfhi(v[i].z); x[7] = bflo(v[i].w); x[8] = bfhi(v[i].w);
                float y[8];
#pragma unroll
                for (int j = 0; j < 8; ++j) y[j] = w0 * x[j] + w1 * x[j + 1] + w2 * x[j + 2] + bb;
                u32x4 w; w.x = cvt_pk_bf16(y[0], y[1]); w.y = cvt_pk_bf16(y[2], y[3]); w.z = cvt_pk_bf16(y[4], y[5]); w.w = cvt_pk_bf16(y[6], y[7]);
                LAS bf16_t* dst = toU ? U + b * G::BSE + uphys(p0) : X + b * G::L + p0;
                *(LAS u32x4*)dst = w;
            }
        }
    }
}
template <int TR>
__device__ __forceinline__ void hy_load_filter(const DP& p, LAS unsigned char* hl, int lt, int o, int c) {
    typedef HG<TR> G;
    constexpr int GL = 2 * G::L, NCH = GL / 8, NI = (NCH + 255) / 256;
    asm volatile("" : "+v"(lt));
    const bf16_t* gf = (const bf16_t*)(p.ws_() + (TR ? WS_GFS : WS_GFP)) + ((size_t)o * 1024 + c) * GL;
    LAS bf16_t* FB = (LAS bf16_t*)(hl + HYH_FB);
    u32x4 v[NI];
#pragma unroll
    for (int i = 0; i < NI; ++i) { int idx = lt + 256 * i; idx = idx < NCH ? idx : NCH - 1; v[i] = *(const u32x4*)(gf + 8 * idx); }
    if (lt < FPAD / 8) *(LAS u32x4*)(FB + 8 * lt) = (u32x4){0u, 0u, 0u, 0u};
#pragma unroll
    for (int i = 0; i < NI; ++i) { const int idx = lt + 256 * i; if (idx < NCH) *(LAS u32x4*)(FB + FPAD + 8 * idx) = v[i]; }
}
template <int TR>
__device__ __forceinline__ void hy_items(const DP& p, LAS unsigned char* lds, int l, int vcu) {
    typedef HG<TR> G;
    const int tid = p.tid, lane = tid & 63, wave = __builtin_amdgcn_readfirstlane(tid >> 6), hf = wave >> 2, wq = wave & 3, lt = tid & 255;
    LAS unsigned char* hl = lds + hf * HYH_SIZE;
    LAS bf16_t* U = (LAS bf16_t*)(hl + HYH_U); const LAS bf16_t* X = (const LAS bf16_t*)(hl + HYH_FB); const LAS float* RED = (const LAS float*)(hl + HYH_RED);
    bf16_t* UT = (bf16_t*)(p.ws_() + WS_UT);
    for (int pit = vcu; pit < 512; pit += p.nb) {
        const int c = 2 * pit + hf;
        if (lt < 32) *(LAS u32x4*)(hl + HYH_ZB + 16 * lt) = (u32x4){0u, 0u, 0u, 0u};
        hy_load_stream<TR>(p, hl, lt, l, 0, c, true);
        hy_load_filter<TR>(p, hl, lt, 0, c);
        __syncthreads();
        f32x16 acc[4];
#pragma unroll 1
        for (int rep = 0; rep < HYREP; ++rep) { hy_conv<TR>(hl, wq, lane, acc); asm volatile("" ::: "memory"); }
        __syncthreads();
        hy_load_stream<TR>(p, hl, lt, l, 1, c, false);
        __syncthreads();
        { int ln = lane; asm volatile("" : "+v"(ln)); const int n = ln & 31, hh = ln >> 5, sbi = n % G::NSB, beta = n / G::NSB, sb = wq * G::NSB + sbi;
#pragma unroll
        for (int r = 0; r < 4; ++r)
#pragma unroll
            for (int qd = 0; qd < 4; ++qd) {
                const int t0 = 128 * sb + 32 * r + 8 * qd + 4 * hh;
                const u32x2 xv = *(const LAS u32x2*)(X + beta * G::L + t0);
                u32x2 w; w.x = cvt_pk_bf16(bflo(xv.x) * acc[r][4 * qd], bfhi(xv.x) * acc[r][4 * qd + 1]); w.y = cvt_pk_bf16(bflo(xv.y) * acc[r][4 * qd + 2], bfhi(xv.y) * acc[r][4 * qd + 3]);
                *(LAS u32x2*)(U + beta * G::BSE + uphys(t0)) = w;
            }
        }
        if (lt < 16 * G::B) { const int a = lt & 15, b = lt >> 4; float y = 0.f;
#pragma unroll
            for (int w = 0; w < 4; ++w) y += RED[(w * 16 + a) * 4 + b];
            const int t = (G::L - 16) + a;
            U[b * G::BSE + uphys(t)] = f2bf(bf2f(X[b * G::L + t]) * y); }
        __syncthreads();
        hy_load_filter<TR>(p, hl, lt, 1, c);
        __syncthreads();
        hy_conv<TR>(hl, wq, lane, acc);
        __syncthreads();
        hy_load_stream<TR>(p, hl, lt, l, 2, c, false);
        __syncthreads();
        bf16_t* orow = UT + (size_t)c * TP;
        { int ln = lane; asm volatile("" : "+v"(ln)); const int n = ln & 31, hh = ln >> 5, sbi = n % G::NSB, beta = n / G::NSB, sb = wq * G::NSB + sbi;
#pragma unroll
        for (int r = 0; r < 4; ++r)
#pragma unroll
            for (int qd = 0; qd < 4; ++qd) {
                const int t0 = 128 * sb + 32 * r + 8 * qd + 4 * hh;
                const u32x2 xv = *(const LAS u32x2*)(X + beta * G::L + t0);
                u32x2 w; w.x = cvt_pk_bf16(bflo(xv.x) * acc[r][4 * qd], bfhi(xv.x) * acc[r][4 * qd + 1]); w.y = cvt_pk_bf16(bflo(xv.y) * acc[r][4 * qd + 2], bfhi(xv.y) * acc[r][4 * qd + 3]);
                *(u32x2*)(orow + seq_row(G::SQ0 + beta, t0)) = w;
            }
        }
        if (lt < 16 * G::B) { const int a = lt & 15, b = lt >> 4; float y = 0.f;
#pragma unroll
            for (int w = 0; w < 4; ++w) y += RED[(w * 16 + a) * 4 + b];
            const int t = (G::L - 16) + a;
            orow[seq_row(G::SQ0 + b, t)] = f2bf(bf2f(X[b * G::L + t]) * y); }
        __syncthreads();
    }
}
__device__ __forceinline__ void hyena_phase(const DP& p, LAS unsigned char* lds, int l) {
    const int Gd = p.nb, bx = p.bid;
    const int vcu = (Gd % 8 == 0) ? (bx % 8) * (Gd / 8) + bx / 8 : bx;
    hy_items<1>(p, lds, l, vcu);
    hy_items<0>(p, lds, l, vcu);
}
__device__ __forceinline__ void hyena_transpose(const DP& p, LAS unsigned char* lds) {
    const bf16_t* UT = (const bf16_t*)(p.ws_() + WS_UT); bf16_t* mix = (bf16_t*)(p.ws_() + WS_XA);
    LAS bf16_t* tile = (LAS bf16_t*)lds;
    const int tid = p.tid;
    for (int t = p.bid; t < 16 * (TP / 64); t += p.nb) {
        const int c0 = (t & 15) * 64, t0 = (t >> 4) * 64;
        { const int cc = tid >> 3, t8 = tid & 7;
          *(LAS u32x4*)(tile + cc * 72 + 8 * t8) = *(const u32x4*)(UT + (size_t)(c0 + cc) * TP + t0 + 8 * t8); }
        __syncthreads();
        { const int tt = tid >> 3, c8 = tid & 7; unsigned w[4];
#pragma unroll
          for (int j = 0; j < 4; ++j) w[j] = (unsigned)tile[(8 * c8 + 2 * j) * 72 + tt] | ((unsigned)tile[(8 * c8 + 2 * j + 1) * 72 + tt] << 16);
          *(u32x4*)(mix + (size_t)(t0 + tt) * DM + 1024 + c0 + 8 * c8) = (u32x4){w[0], w[1], w[2], w[3]}; }
        __syncthreads();
    }
}

#define XB_TMO      128
#define XB_XCNT(j)  (256  + 64 * (j))
#define XB_XSUB(j)  (1280 + 64 * (j))
#define XB_XGEN(j)  (2304 + 64 * (j))
#define XB_TOP      3328
#define XB_TOPGEN   3392
#define XCD_BAR_WORDS 3456
#define XB_SPIN_CAP (1u << 18)
__device__ __forceinline__ unsigned xb_ld(unsigned* p)              { return __hip_atomic_load(p, __ATOMIC_RELAXED, __HIP_MEMORY_SCOPE_AGENT); }
__device__ __forceinline__ unsigned xb_add(unsigned* p, unsigned v) { return __hip_atomic_fetch_add(p, v, __ATOMIC_RELAXED, __HIP_MEMORY_SCOPE_AGENT); }
__device__ __forceinline__ unsigned xb_xcc_id() { return (unsigned)__builtin_amdgcn_s_getreg((3 << 11) | 20) & 0xFu; }
#define XB_SPIN(cond, bar) do { unsigned _sp = 0; while (cond) { __builtin_amdgcn_s_sleep(1); \
    if ((++_sp & 255u) == 0u) { if (xb_ld(&(bar)[XB_TMO])) break; if (_sp > XB_SPIN_CAP) { atomicAdd(&(bar)[XB_TMO], 1u); break; } } } } while (0)
__device__ __forceinline__ void xcd_barrier_complete(unsigned* bar, unsigned x, unsigned G, unsigned& nloc, unsigned& nx) {
    unsigned sum, cnt, mine, sp = 0u;
    for (;;) {
        sum = 0u; cnt = 0u; mine = 0u;
#pragma unroll
        for (unsigned j = 0; j < 16; ++j) { const unsigned c = xb_ld(&bar[XB_XCNT(j)]); sum += c; cnt += (c > 0u) ? 1u : 0u; mine = (j == x) ? c : mine; }
        if (sum == G) break;
        __builtin_amdgcn_s_sleep(1);
        if ((++sp & 255u) == 0u) { if (xb_ld(&bar[XB_TMO])) break; if (sp > XB_SPIN_CAP) { atomicAdd(&bar[XB_TMO], 1u); break; } }
    }
    nloc = mine > 0u ? mine : 1u; nx = cnt > 0u ? cnt : 1u;
}
__device__ __forceinline__ void xcd_barrier(unsigned* bar, unsigned x, volatile LAS unsigned* st, unsigned G, int tid) {
    asm volatile("s_waitcnt vmcnt(0)" ::: "memory");
    __syncthreads();
    if (tid == 0) {
        __builtin_amdgcn_s_waitcnt(0);
        unsigned nloc = st[0], nx = st[1];
        if (nloc == 0u) { xcd_barrier_complete(bar, x, G, nloc, nx); st[0] = nloc; st[1] = nx; }
        const unsigned old = xb_add(&bar[XB_XSUB(x)], 1u);
        const unsigned gen = old / nloc;
        if (old + 1u == (gen + 1u) * nloc) {
            __builtin_amdgcn_fence(__ATOMIC_RELEASE, "agent");
            asm volatile("s_waitcnt vmcnt(0)" ::: "memory");
            const unsigned og = xb_add(&bar[XB_TOP], 1u);
            const unsigned tg = og / nx;
            if (og + 1u == (tg + 1u) * nx) xb_add(&bar[XB_TOPGEN], 1u);
            else XB_SPIN(xb_ld(&bar[XB_TOPGEN]) == tg, bar);
            __builtin_amdgcn_fence(__ATOMIC_ACQUIRE, "agent");
            xb_add(&bar[XB_XGEN(x)], 1u);
            asm volatile("s_waitcnt vmcnt(0)" ::: "memory");
        } else {
            XB_SPIN(xb_ld(&bar[XB_XGEN(x)]) == gen, bar);
            __builtin_amdgcn_fence(__ATOMIC_ACQUIRE, "agent");
            asm volatile("s_waitcnt vmcnt(0)" ::: "memory");
        }
    }
    __syncthreads();
}

constexpr int NPHASES = 17;
__device__ __forceinline__ void run_phase(const DP& p, LAS unsigned char* lds, int ph) {
    const int l = (ph == 0) ? 0 : (ph - 1) / 8, jj = (ph - 1) % 8, k = (ph == 0) ? 0 : (jj < 2 ? jj + 1 : (jj == 2 ? 8 : jj));
    const int G = p.nb, cbx = p.bid;
    bf16_t* XA = (bf16_t*)(p.ws_() + WS_XA);
    switch (k) {
#if (PHMASK >> 0) & 1
    case 0: {
#if SUB & 1
        norm_rows(p, 0, p.in_(3));
#endif
#if SUB & 2
        prep_weights(p, lds, 0);
#endif
#if SUB & 4
        __syncthreads(); filter_h3(p, lds, 0);
#endif
    } break;
#endif
#if (PHMASK >> 1) & 1
    case 1: {
        pg8::Prob p0{XA, (const bf16_t*)(p.ws_() + WS_WIN), TP / 256, 4};
        pg8::Prob p1{(const bf16_t*)(p.ws_() + WS_WIN) + (size_t)1024 * DM, XA, 12, TP / 256};
        pg8::Sched2 S; S.init(p0, p1, DM, G, cbx);
        pg8::EpiStore E{{(bf16_t*)(p.ws_() + WS_P), (bf16_t*)(p.ws_() + WS_UT)}, {1024, TP}};
#ifndef NOG1
        pg8::gemm_phase<pg8::EpiStore, pg8::Sched2>(p, lds, S, E);
#endif
#ifndef NOFG
        __syncthreads(); filter_gen(p, lds, l);
#endif
    } break;
#endif
#if (PHMASK >> 2) & 1
    case 2: {
#ifndef NOHY
        hyena_phase(p, lds, l);
#endif
#ifndef NOPOOL
        pool_window(p);
#endif
    } break;
#endif
#if (PHMASK >> 8) & 1
    case 8: hyena_transpose(p, lds); break;
#endif
#if (PHMASK >> 3) & 1
    case 3: {
        pg8::Prob p0{XA, (const bf16_t*)(p.ws_() + WS_WOUT), TREAL / 256, DM / 256};
        pg8::Prob p1{XA, XA, 0, 0};
        pg8::Sched2 S; S.init(p0, p1, DM, G, cbx);
        pg8::EpiResid E{p.out_(), (float*)(p.ws_() + WS_TAIL)};
        pg8::gemm_phase<pg8::EpiResid, pg8::Sched2>(p, lds, S, E);
        if (l == 0) {
            pg8::SchedSplit S2{XA, (const bf16_t*)(p.ws_() + WS_WOUT), DM / 256, 8, 256, DM, G, cbx};
            pg8::EpiResidAtomic E2{(float*)(p.ws_() + WS_TAIL)};
            pg8::gemm_phase<pg8::EpiResidAtomic, pg8::SchedSplit>(p, lds, S2, E2);
        }
    } break;
#endif
#if (PHMASK >> 4) & 1
    case 4: norm_rows(p, 1, p.in_(19) + (size_t)l * DM); break;
#endif
#if (PHMASK >> 5) & 1
    case 5: {
        pg8::Prob p0{XA, (const bf16_t*)(p.ws_() + WS_WGU), l == 0 ? TP / 256 : TREAL / 256, 2 * DFF / 256};
        pg8::Prob p1{XA, XA, 0, 0};
        pg8::Sched2 S; S.init(p0, p1, DM, G, cbx);
        pg8::EpiSwiGLU E{(bf16_t*)(p.ws_() + WS_HID)};
        pg8::gemm_phase<pg8::EpiSwiGLU, pg8::Sched2>(p, lds, S, E);
    } break;
#endif
#if (PHMASK >> 6) & 1
    case 6: {
        pg8::Prob p0{(const bf16_t*)(p.ws_() + WS_HID), (const bf16_t*)(p.ws_() + WS_WDN), TREAL / 256, DM / 256};
        pg8::Prob p1{XA, XA, 0, 0};
        pg8::Sched2 S; S.init(p0, p1, DFF, G, cbx);
        pg8::EpiResid E{p.out_(), (float*)(p.ws_() + WS_TAIL)};
        pg8::gemm_phase<pg8::EpiResid, pg8::Sched2>(p, lds, S, E);
        if (l == 0) {
            pg8::SchedSplit S2{(const bf16_t*)(p.ws_() + WS_HID), (const bf16_t*)(p.ws_() + WS_WDN), DM / 256, 11, 512, DFF, G, cbx};
            pg8::EpiResidAtomic E2{(float*)(p.ws_() + WS_TAIL)};
            pg8::gemm_phase<pg8::EpiResidAtomic, pg8::SchedSplit>(p, lds, S2, E2);
        }
    } break;
#endif
#if (PHMASK >> 7) & 1
    case 7: {
        if (l == 0) { norm_rows(p, 1, p.in_(3) + DM); prep_weights(p, lds, 1); __syncthreads(); filter_h3(p, lds, 1); }
        else norm_rows(p, 2, p.in_(23));
    } break;
#endif
    }
}

__global__ void __launch_bounds__(NTHREADS, 2) mega_fwd(Params pk, int ph_lo, int ph_hi) {
    DP p;
    extern __shared__ __attribute__((aligned(16))) unsigned char lds_raw[];
    LAS unsigned char* lds = (LAS unsigned char*)lds_raw;
    cg::grid_group grid = cg::this_grid();
    volatile LAS unsigned* xst = (volatile LAS unsigned*)(lds + (LDS_BYTES - 16));
    if (threadIdx.x == 0) { xst[0] = 0u; xst[1] = 0u; }
    __syncthreads();
    unsigned* xbar = (unsigned*)(pk.ws + WS_BAR);
    const unsigned xcc = xb_xcc_id();
    if (threadIdx.x == 0) (void)xb_add(&xbar[XB_XCNT(xcc)], 1u);
    const int wave_s = __builtin_amdgcn_readfirstlane(threadIdx.x >> 6);
    for (int ph = ph_lo; ph < ph_hi; ++ph) {
        { kseg_t ks = (kseg_t)__builtin_amdgcn_kernarg_segment_ptr(); unsigned z0 = 0u; asm volatile("" : "+s"(z0));
          int t = wave_s * 64 + (int)__builtin_amdgcn_mbcnt_hi(~0u, __builtin_amdgcn_mbcnt_lo(~0u, z0)), b = blockIdx.x, n = gridDim.x;
          asm volatile("" : "+s"(ks), "+v"(t), "+s"(b), "+s"(n));
          p.ks = ks; p.tid = t; p.bid = b; p.nb = n; }
        run_phase(p, lds, ph);
#if REPMASK
        { const int j2 = (ph - 1) % 8, kk = (ph == 0) ? 0 : (j2 < 2 ? j2 + 1 : (j2 == 2 ? 8 : j2));
          if (((REPMASK >> kk) & 1) && ph != 16) { grid.sync(); run_phase(p, lds, ph); } }
#endif
        if (ph + 1 < ph_hi) {
            if (ph == ph_lo) grid.sync();
            else xcd_barrier(xbar, xcc, xst, gridDim.x, p.tid);
        }
    }
}

extern "C" void kernel_launch(void* const* d_in, const int* in_sizes, int n_in, void* d_out, int out_size, void* d_ws, size_t ws_size, hipStream_t stream) {
    static int grid = 0;
    if (grid == 0) {
        if (n_in != 24 || ws_size < WS_END) { fprintf(stderr, "kernel_launch: need 24 inputs and %zu bytes of workspace (got %d, %zu)\n", (size_t)WS_END, n_in, ws_size); grid = -1; return; }
        int dev = 0, cus = 0, per_cu = 0;
        hipGetDevice(&dev);
        hipDeviceGetAttribute(&cus, hipDeviceAttributeMultiprocessorCount, dev);
        if (hipFuncSetAttribute((const void*)mega_fwd, hipFuncAttributeMaxDynamicSharedMemorySize, LDS_BYTES) != hipSuccess) { fprintf(stderr, "hipFuncSetAttribute failed\n"); grid = -1; return; }
        hipOccupancyMaxActiveBlocksPerMultiprocessor(&per_cu, (const void*)mega_fwd, NTHREADS, LDS_BYTES);
        if (per_cu < 1) per_cu = 1;
        (void)hipGetLastError();
        grid = cus;
    }
    if (grid < 0) return;
    Params p{};
    for (int i = 0; i < 24; ++i) p.in[i] = (const float*)d_in[i];
    p.out = (float*)d_out; p.ws = (unsigned char*)d_ws;
#if MEGA
    (void)hipMemsetAsync((char*)d_ws + WS_BAR, 0, 16384, stream);
    int lo = 0, hi = NPHASES;
    void* args[] = {&p, &lo, &hi};
    hipError_t e = hipLaunchCooperativeKernel((const void*)mega_fwd, dim3(grid), dim3(NTHREADS), args, LDS_BYTES, stream);
    if (e != hipSuccess) fprintf(stderr, "cooperative launch failed: %s (grid %d)\n", hipGetErrorString(e), grid);
#else
    for (int ph = 0; ph < NPHASES; ++ph) hipLaunchKernelGGL(mega_fwd, dim3(grid), dim3(NTHREADS), LDS_BYTES, stream, p, ph, ph + 1);
#endif
}
```

```cpp
#include <hip/hip_runtime.h>
#include <hip/hip_cooperative_groups.h>
#include <cstdio>
namespace cg = cooperative_groups;

#ifndef PHMASK
#define PHMASK 511
#endif
#ifndef SUB
#define SUB 7
#endif
#ifndef REPMASK
#define REPMASK 0
#endif
#ifndef HYREP
#define HYREP 1
#endif
#ifndef MEGA
#define MEGA 1
#endif

#define LAS __attribute__((address_space(3)))
typedef unsigned short bf16_t;
typedef short bf16x8 __attribute__((ext_vector_type(8)));
typedef float f32x4 __attribute__((ext_vector_type(4)));
typedef float f32x16 __attribute__((ext_vector_type(16)));
typedef unsigned u32x4 __attribute__((ext_vector_type(4)));
typedef unsigned u32x2 __attribute__((ext_vector_type(2)));

constexpr int DM = 2048, TREAL = 32768, TTOK = 32864, TP = 33024, DFF = 5632;
constexpr int NTHREADS = 512;
constexpr int LDS_BYTES = 147456;
constexpr float EPSN = 1e-6f;

constexpr size_t WS_TAIL = 0;
constexpr size_t WS_XA   = WS_TAIL + (size_t)256 * DM * 4;
constexpr size_t WS_WIN  = WS_XA + (size_t)TP * DM * 2;
constexpr size_t WS_WOUT = WS_WIN + (size_t)4096 * DM * 2;
constexpr size_t WS_WGU  = WS_WOUT + (size_t)DM * DM * 2;
constexpr size_t WS_WDN  = WS_WGU + (size_t)2 * DFF * DM * 2;
constexpr size_t WS_H3   = WS_WDN + (size_t)DM * DFF * 2;
constexpr size_t WS_W4T  = WS_H3 + (size_t)(8208 + 4112) * 64 * 4;
constexpr size_t WS_BIG  = WS_W4T + (size_t)4096 * 64 * 4;
constexpr size_t WS_P    = WS_BIG;
constexpr size_t WS_UT   = WS_P + (size_t)TP * 1024 * 2;
constexpr size_t WS_GFS  = WS_UT + (size_t)3072 * TP * 2;
constexpr size_t WS_GFP  = WS_GFS + (size_t)2048 * 16416 * 2;
constexpr size_t WS_HID  = WS_BIG;
constexpr size_t WS_BAR  = WS_BIG + (size_t)TP * DFF * 2;
constexpr size_t WS_END  = WS_BAR + 16384;
static_assert(WS_GFP + (size_t)2048 * 8224 * 2 <= WS_BAR, "big region");

struct Params {
    const float* in[24];
    float* out;
    unsigned char* ws;
};
typedef const __attribute__((address_space(4))) unsigned long long* kseg_t;
struct DP {
    kseg_t ks; int tid, bid, nb;
    __device__ __forceinline__ const float* in_(int k) const { return (const float*)ks[k]; }
    __device__ __forceinline__ float* out_() const { return (float*)ks[24]; }
    __device__ __forceinline__ unsigned char* ws_() const { return (unsigned char*)ks[25]; }
};

__device__ __forceinline__ unsigned cvt_pk_bf16(float lo, float hi) { unsigned r; asm volatile("v_cvt_pk_bf16_f32 %0, %1, %2" : "=v"(r) : "v"(lo), "v"(hi)); return r; }
__device__ __forceinline__ bf16_t f2bf(float f) { return (bf16_t)(cvt_pk_bf16(f, 0.f) & 0xffffu); }
__device__ __forceinline__ float bf2f(unsigned v) { return __uint_as_float(v << 16); }
__device__ __forceinline__ float bflo(unsigned w) { return __uint_as_float(w << 16); }
__device__ __forceinline__ float bfhi(unsigned w) { return __uint_as_float(w & 0xffff0000u); }
__device__ __forceinline__ float wave_sum(float v) {
#pragma unroll
    for (int o = 32; o >= 1; o >>= 1) v += __shfl_xor(v, o);
    return v;
}
__device__ __forceinline__ int seq_rbase(int sq) { return sq < 4 ? sq * 4096 : 16384 + (sq - 4) * 8192; }
__device__ __forceinline__ int seq_row(int sq, int p) { return p < 16 ? TREAL + 16 * sq + p : seq_rbase(sq) + p - 16; }

namespace pg8 {
constexpr int BM = 256, BK = 64, HALF = 128, HTB = HALF * BK * 2, STAGE_BYTES = 8 * HTB, NXCD = 8, WGM = 8;
__device__ __forceinline__ int lds_byte(int r, int c) { const int st = (r >> 4) * 2 + (c >> 5), rr = r & 15, cc = c & 31, ob = rr * 64 + cc * 2; return st * 1024 + (ob ^ (((ob >> 9) & 1) << 5)); }
__device__ __forceinline__ void stage_rc(int b, int& R, int& C) { const int st = b / 1024, sb = b % 1024, swz = sb ^ (((sb >> 9) & 1) << 5); R = (st >> 1) * 16 + swz / 64; C = (st & 1) * 32 + (swz % 64) / 2; }
__device__ __forceinline__ int perm32(int rho) { const int n = rho >> 4, i = rho & 15; return 8 * (i >> 2) + 4 * n + (i & 3); }

struct Unit { const char* a; const char* b; int pm, pn, prob; };
struct Prob { const bf16_t* A; const bf16_t* Bt; int nM, nN; };
struct Sched2 {
    const bf16_t* A0; const bf16_t* B0; const bf16_t* A1; const bf16_t* B1; int nM0, nN0, nM1, nN1, nwg0, nwg1; int K, ld, G, c;
    __device__ __forceinline__ void init(const Prob& p0, const Prob& p1, int K_, int G_, int c_) { A0 = p0.A; B0 = p0.Bt; A1 = p1.A; B1 = p1.Bt; nM0 = p0.nM; nN0 = p0.nN; nM1 = p1.nM; nN1 = p1.nN;
        nwg0 = nM0 * nN0; nwg1 = nM1 * nN1; K = K_; ld = K_; G = G_; c = c_; }
    __device__ __forceinline__ bool next(int i, Unit& u) const {
        long L = (long)i * G + c; int q = 0;
        if (L >= nwg0) { L -= nwg0; q = 1; if (L >= nwg1) return false; }
        const int nM = q ? nM1 : nM0, nN = q ? nN1 : nN0, nw = q ? nwg1 : nwg0;
        int wgid = (int)L; { const int qq = nw / NXCD, r = nw % NXCD, xcd = wgid % NXCD, off = wgid / NXCD; wgid = (xcd < r ? xcd * (qq + 1) : r * (qq + 1) + (xcd - r) * qq) + off; }
        const int nig = WGM * nN, gid = wgid / nig, fm = gid * WGM, gsz = (nM - fm) < WGM ? (nM - fm) : WGM;
        u.pm = fm + ((wgid % nig) % gsz); u.pn = (wgid % nig) / gsz; u.prob = q;
        const size_t tstep = (size_t)BM * K * 2;
        u.a = (const char*)(q ? A1 : A0) + (size_t)u.pm * tstep; u.b = (const char*)(q ? B1 : B0) + (size_t)u.pn * tstep;
        return true;
    }
};

struct EpiStore {
    static constexpr bool PERM = true;
    bf16_t* O[2]; int ldc[2];
    __device__ __forceinline__ void operator()(const f32x4 (&acc)[2][2][4][2], const Unit& u, int wr, int wc, int fr, int fq) const {
        bf16_t* base = u.prob ? O[1] : O[0]; const int ld = u.prob ? ldc[1] : ldc[0];
        const int row0 = u.pm * BM + wr * 64 + fr, col0 = u.pn * BM + wc * 32 + 8 * fq;
#pragma unroll
        for (int ai = 0; ai < 2; ++ai)
#pragma unroll
            for (int m = 0; m < 4; ++m) { bf16_t* rowp = base + (size_t)(row0 + ai * HALF + m * 16) * ld + col0;
#pragma unroll
                for (int bj = 0; bj < 2; ++bj) { const f32x4 v0 = acc[ai][bj][m][0], v1 = acc[ai][bj][m][1];
                    u32x4 w; w.x = cvt_pk_bf16(v0[0], v0[1]); w.y = cvt_pk_bf16(v0[2], v0[3]); w.z = cvt_pk_bf16(v1[0], v1[1]); w.w = cvt_pk_bf16(v1[2], v1[3]);
                    *(u32x4*)(rowp + bj * HALF) = w; } }
    }
};
struct EpiResid {
    static constexpr bool PERM = false;
    float* hmain; float* htail;
    __device__ __forceinline__ void operator()(const f32x4 (&acc)[2][2][4][2], const Unit& u, int wr, int wc, int fr, int fq) const {
        float* base = (u.pm < TREAL / BM) ? hmain + (size_t)u.pm * BM * DM : htail;
        const int row0 = wr * 64 + fr, col0 = u.pn * BM + wc * 32 + 4 * fq;
#pragma unroll
        for (int ai = 0; ai < 2; ++ai)
#pragma unroll
            for (int m = 0; m < 4; ++m) { float* rowp = base + (size_t)(row0 + ai * HALF + m * 16) * DM + col0;
#pragma unroll
                for (int bj = 0; bj < 2; ++bj)
#pragma unroll
                    for (int n = 0; n < 2; ++n) { f32x4* p = (f32x4*)(rowp + bj * HALF + n * 16); *p = *p + acc[ai][bj][m][n]; }
                asm volatile("" ::: "memory"); }
    }
};
struct EpiSwiGLU {
    static constexpr bool PERM = true;
    bf16_t* O;
    __device__ __forceinline__ void operator()(const f32x4 (&acc)[2][2][4][2], const Unit& u, int wr, int wc, int fr, int fq) const {
        const int row0 = u.pm * BM + wr * 64 + fr, col0 = u.pn * HALF + wc * 32 + 8 * fq;
#pragma unroll
        for (int ai = 0; ai < 2; ++ai)
#pragma unroll
            for (int m = 0; m < 4; ++m) { bf16_t* rowp = O + (size_t)(row0 + ai * HALF + m * 16) * DFF + col0;
                float r[8];
#pragma unroll
                for (int n = 0; n < 2; ++n)
#pragma unroll
                    for (int e = 0; e < 4; ++e) { const float g = acc[ai][0][m][n][e], up = acc[ai][1][m][n][e];
                        r[n * 4 + e] = g * __builtin_amdgcn_rcpf(1.0f + __expf(-g)) * up; }
                u32x4 w; w.x = cvt_pk_bf16(r[0], r[1]); w.y = cvt_pk_bf16(r[2], r[3]); w.z = cvt_pk_bf16(r[4], r[5]); w.w = cvt_pk_bf16(r[6], r[7]);
                *(u32x4*)rowp = w; }
    }
};

struct SchedSplit {
    const bf16_t* A; const bf16_t* Bt; int nN, nK, K, ld, G, c;
    __device__ __forceinline__ bool next(int i, Unit& u) const {
        const long L = (long)i * G + c; if (L >= nN * nK) return false;
        const int pn = (int)L % nN, kc = (int)L / nN;
        u.pm = TREAL / BM; u.pn = pn; u.prob = 0;
        u.a = (const char*)(A + (size_t)u.pm * BM * ld + (size_t)kc * K); u.b = (const char*)(Bt + (size_t)pn * BM * ld + (size_t)kc * K);
        return true;
    }
};
struct EpiResidAtomic {
    static constexpr bool PERM = false;
    float* htail;
    __device__ __forceinline__ void operator()(const f32x4 (&acc)[2][2][4][2], const Unit& u, int wr, int wc, int fr, int fq) const {
        const int col0 = u.pn * BM + wc * 32 + 4 * fq;
#pragma unroll
        for (int m = 0; m < 4; ++m) { const int row = wr * 64 + m * 16 + fr;
            if (row < 96) { float* rowp = htail + (size_t)row * DM + col0;
#pragma unroll
                for (int bj = 0; bj < 2; ++bj)
#pragma unroll
                    for (int n = 0; n < 2; ++n)
#pragma unroll
                        for (int e = 0; e < 4; ++e) atomicAdd(rowp + bj * HALF + n * 16 + e, acc[0][bj][m][n][e]); } }
    }
};
template <class Epi, class Sched>
__device__ __forceinline__ void gemm_phase(const DP& p, LAS unsigned char* lds, const Sched& S, const Epi& E) {
    const int tid = p.tid, wid = __builtin_amdgcn_readfirstlane(tid >> 6), lane = tid & 63, wr = wid >> 2, wc = wid & 3, fr = lane & 15, fq = lane >> 4;
    const int K = S.ld, nt = S.K / BK;
    unsigned voffA[2], voffB[2];
#pragma unroll
    for (int i = 0; i < 2; ++i) { int R, C; stage_rc(tid * 16 + i * 8192, R, C); const int Rb = Epi::PERM ? ((R & ~31) + perm32(R & 31)) : R;
        voffA[i] = (unsigned)(R * K + C) * 2u; voffB[i] = (unsigned)(Rb * K + C) * 2u; }
    const size_t kstep = (size_t)(BK * 2);
    const size_t hstep = (size_t)HALF * K * 2;
    const unsigned ldsw = (unsigned)wid * 1024u;
    const int aoff = lds_byte(wr * 64 + fr, fq * 8), boff = lds_byte(wc * 32 + fr, fq * 8);
#define PG8_SA(b, h) (((b) * 2 + (h)) * HTB)
#define PG8_SB(b, h) ((4 + (b) * 2 + (h)) * HTB)
#define PG8_STAGE(bufoff, gbase, voff) do { _Pragma("unroll") for (int _i = 0; _i < 2; ++_i) \
        __builtin_amdgcn_global_load_lds((const unsigned*)((const char*)(gbase) + (voff)[_i]), (LAS unsigned*)(lds + (bufoff) + ldsw + _i * 8192), 16, 0, 0); } while (0)
#define PG8_LDA(dst, b, h) do { _Pragma("unroll") for (int m = 0; m < 4; ++m) _Pragma("unroll") for (int k = 0; k < 2; ++k) dst[m][k] = *(const LAS bf16x8*)(lds + PG8_SA(b, h) + aoff + m * 2048 + k * 1024); } while (0)
#define PG8_LDB(dst, b, h) do { _Pragma("unroll") for (int n = 0; n < 2; ++n) _Pragma("unroll") for (int k = 0; k < 2; ++k) dst[n][k] = *(const LAS bf16x8*)(lds + PG8_SB(b, h) + boff + n * 2048 + k * 1024); } while (0)
#define PG8_MMA(ai, bj, At, Bt) do { __builtin_amdgcn_s_setprio(1); _Pragma("unroll") for (int m = 0; m < 4; ++m) _Pragma("unroll") for (int n = 0; n < 2; ++n) _Pragma("unroll") for (int k = 0; k < 2; ++k) \
        acc[ai][bj][m][n] = __builtin_amdgcn_mfma_f32_16x16x32_bf16(Bt[n][k], At[m][k], acc[ai][bj][m][n], 0, 0, 0); __builtin_amdgcn_s_setprio(0); } while (0)
#define PG8_WAIT_V(n) asm volatile("s_waitcnt vmcnt(" #n ")" ::: "memory")
#define PG8_WAIT_L(n) asm volatile("s_waitcnt lgkmcnt(" #n ")" ::: "memory")
#define PG8_BAR __builtin_amdgcn_s_barrier()
#define PG8_SCHED __builtin_amdgcn_sched_barrier(0)
    Unit cur, nxt; int ui = 0;
    if (!S.next(0, cur)) return;
    f32x4 acc[2][2][4][2];
#pragma unroll
    for (int a = 0; a < 2; ++a)
#pragma unroll
        for (int b = 0; b < 2; ++b)
#pragma unroll
            for (int m = 0; m < 4; ++m)
#pragma unroll
                for (int n = 0; n < 2; ++n) acc[a][b][m][n] = (f32x4){0.f, 0.f, 0.f, 0.f};
    bf16x8 At[4][2], B0[2][2], B1[2][2];
    const char* cA = cur.a; const char* cB = cur.b;
    PG8_STAGE(PG8_SB(0, 0), cB, voffB); PG8_STAGE(PG8_SA(0, 0), cA, voffA); PG8_STAGE(PG8_SB(0, 1), cB + hstep, voffB); PG8_STAGE(PG8_SA(0, 1), cA + hstep, voffA);
    if (wr == 1) PG8_BAR;
    PG8_WAIT_V(4); PG8_BAR;
    PG8_STAGE(PG8_SB(1, 0), cB + kstep, voffB); PG8_STAGE(PG8_SA(1, 0), cA + kstep, voffA); PG8_STAGE(PG8_SB(1, 1), cB + hstep + kstep, voffB);
    PG8_WAIT_V(6); PG8_BAR;
    for (;;) {
        const bool has_next = S.next(ui + 1, nxt);
        const char* nA = has_next ? nxt.a : cA; const char* nB = has_next ? nxt.b : cB;
        for (int t = 0; t < nt; t += 2) {
            const bool last = (t == nt - 2);
            const char* a1 = cA + (size_t)(t + 1) * kstep;
            const char* a2 = last ? nA : cA + (size_t)(t + 2) * kstep; const char* b2 = last ? nB : cB + (size_t)(t + 2) * kstep;
            const char* a3 = a2 + kstep; const char* b3 = b2 + kstep;
            PG8_LDB(B0, 0, 0); PG8_SCHED; PG8_LDA(At, 0, 0); PG8_STAGE(PG8_SA(1, 1), a1 + hstep, voffA);
            PG8_WAIT_L(8); PG8_BAR; PG8_WAIT_L(0); PG8_MMA(0, 0, At, B0); PG8_BAR; PG8_SCHED;
            PG8_LDB(B1, 0, 1); PG8_STAGE(PG8_SB(0, 0), b2, voffB);
            PG8_BAR; PG8_WAIT_L(0); PG8_MMA(0, 1, At, B1); PG8_BAR;
            PG8_LDA(At, 0, 1); PG8_STAGE(PG8_SA(0, 0), a2, voffA);
            PG8_BAR; PG8_WAIT_L(0); PG8_MMA(1, 0, At, B0); PG8_BAR; PG8_SCHED;
            PG8_STAGE(PG8_SB(0, 1), b2 + hstep, voffB);
            PG8_WAIT_V(6); PG8_BAR; PG8_MMA(1, 1, At, B1); PG8_BAR;
            PG8_LDB(B0, 1, 0); PG8_SCHED; PG8_LDA(At, 1, 0); PG8_STAGE(PG8_SA(0, 1), a2 + hstep, voffA);
            PG8_WAIT_L(8); PG8_BAR; PG8_WAIT_L(0); PG8_MMA(0, 0, At, B0); PG8_BAR; PG8_SCHED;
            PG8_LDB(B1, 1, 1); PG8_STAGE(PG8_SB(1, 0), b3, voffB);
            PG8_BAR; PG8_WAIT_L(0); PG8_MMA(0, 1, At, B1); PG8_BAR;
            PG8_LDA(At, 1, 1); PG8_STAGE(PG8_SA(1, 0), a3, voffA);
            PG8_BAR; PG8_WAIT_L(0); PG8_MMA(1, 0, At, B0); PG8_BAR; PG8_SCHED;
            PG8_STAGE(PG8_SB(1, 1), b3 + hstep, voffB);
            PG8_WAIT_V(6); PG8_BAR; PG8_MMA(1, 1, At, B1); PG8_BAR;
        }
        E(acc, cur, wr, wc, fr, fq);
        if (!has_next) break;
#pragma unroll
        for (int a = 0; a < 2; ++a)
#pragma unroll
            for (int b = 0; b < 2; ++b)
#pragma unroll
                for (int m = 0; m < 4; ++m)
#pragma unroll
                    for (int n = 0; n < 2; ++n) acc[a][b][m][n] = (f32x4){0.f, 0.f, 0.f, 0.f};
        cur = nxt; cA = nA; cB = nB; ++ui;
    }
    PG8_WAIT_V(0);
    if (wr == 0) PG8_BAR;
    PG8_BAR;
#undef PG8_SA
#undef PG8_SB
#undef PG8_STAGE
#undef PG8_LDA
#undef PG8_LDB
#undef PG8_MMA
#undef PG8_WAIT_V
#undef PG8_WAIT_L
#undef PG8_BAR
#undef PG8_SCHED
}
}

__device__ __forceinline__ void norm_rows(const DP& p, int mode, const float* gain) {
    const int lane = p.tid & 63, gw = p.bid * 8 + (p.tid >> 6), nw = p.nb * 8;
    float* tail = (float*)(p.ws_() + WS_TAIL); bf16_t* hn = (bf16_t*)(p.ws_() + WS_XA);
    const int nrows = (mode == 2) ? TREAL : TP;
    f32x4 g[8];
#pragma unroll
    for (int j = 0; j < 8; ++j) g[j] = *(const f32x4*)(gain + 4 * (lane + 64 * j));
    for (int r = gw; r < nrows; r += nw) {
        if (r >= TTOK) {
#pragma unroll
            for (int j = 0; j < 8; ++j) { *(u32x2*)(hn + (size_t)r * DM + 4 * (lane + 64 * j)) = (u32x2){0u, 0u};
                if (mode == 0) *(f32x4*)(tail + (size_t)(r - TREAL) * DM + 4 * (lane + 64 * j)) = (f32x4){0.f, 0.f, 0.f, 0.f}; }
            continue;
        }
        float* hrow = (r < TREAL) ? p.out_() + (size_t)r * DM : tail + (size_t)(r - TREAL) * DM;
        const float* src = hrow;
        if (mode == 0) src = (r < 16384) ? p.in_(0) + (size_t)r * DM : (r < TREAL) ? p.in_(1) + (size_t)(r - 16384) * DM : p.in_(2) + (size_t)((r - TREAL) & 15) * DM;
        f32x4 v[8]; float ss = 0.f;
#pragma unroll
        for (int j = 0; j < 8; ++j) { v[j] = *(const f32x4*)(src + 4 * (lane + 64 * j)); ss += v[j][0] * v[j][0] + v[j][1] * v[j][1] + v[j][2] * v[j][2] + v[j][3] * v[j][3]; }
        ss = wave_sum(ss);
        const float rstd = 1.0f / sqrtf(ss * (1.0f / DM) + EPSN);
#pragma unroll
        for (int j = 0; j < 8; ++j) {
            const f32x4 o = v[j] * rstd * g[j];
            if (mode == 0) *(f32x4*)(hrow + 4 * (lane + 64 * j)) = v[j];
            if (mode == 2) *(f32x4*)(hrow + 4 * (lane + 64 * j)) = o;
            else { u32x2 w; w.x = cvt_pk_bf16(o[0], o[1]); w.y = cvt_pk_bf16(o[2], o[3]); *(u32x2*)(hn + (size_t)r * DM + 4 * (lane + 64 * j)) = w; }
        }
    }
}

__device__ __forceinline__ void transpose_cvt(const DP& p, LAS unsigned char* lds, const float* src, int K, int N, bf16_t* dst, int ldd, int koff, int mode) {
    LAS float* tile = (LAS float*)lds;
    const int tid = p.tid, nkt = K / 64, nnt = N / 64, ntile = nkt * nnt;
    for (int t0 = p.bid * 4; t0 < ntile; t0 += p.nb * 4) {
        f32x4 v[4][2];
#pragma unroll
        for (int u = 0; u < 4; ++u) { const int t = (t0 + u < ntile) ? t0 + u : ntile - 1; const int k0 = (t / nnt) * 64, n0 = (t % nnt) * 64;
#pragma unroll
            for (int it = 0; it < 2; ++it) { const int e = tid + it * 512, kk = e >> 4, n4 = e & 15; v[u][it] = *(const f32x4*)(src + (size_t)(k0 + kk) * N + n0 + 4 * n4); } }
#pragma unroll
        for (int u = 0; u < 4; ++u)
#pragma unroll
            for (int it = 0; it < 2; ++it) { const int e = tid + it * 512, kk = e >> 4, n4 = e & 15; LAS float* tp = tile + u * 4160 + kk * 65 + 4 * n4;
                tp[0] = v[u][it][0]; tp[1] = v[u][it][1]; tp[2] = v[u][it][2]; tp[3] = v[u][it][3]; }
        __syncthreads();
#pragma unroll
        for (int u = 0; u < 4; ++u) if (t0 + u < ntile) { const int t = t0 + u, k0 = (t / nnt) * 64, n0 = (t % nnt) * 64;
            const int nn = tid >> 3, k8 = tid & 7; float f[8];
#pragma unroll
            for (int j = 0; j < 8; ++j) f[j] = tile[u * 4160 + (8 * k8 + j) * 65 + nn];
            const int n = n0 + nn; const int drow = (mode == 0) ? n : ((n >> 7) * 256 + (n & 127) + (mode == 2 ? 128 : 0));
            u32x4 w; w.x = cvt_pk_bf16(f[0], f[1]); w.y = cvt_pk_bf16(f[2], f[3]); w.z = cvt_pk_bf16(f[4], f[5]); w.w = cvt_pk_bf16(f[6], f[7]);
            *(u32x4*)(dst + (size_t)drow * ldd + koff + k0 + 8 * k8) = w; }
        __syncthreads();
    }
}
__device__ __forceinline__ void fold_pool(const DP& p, const float* pw, const float* sc, const float* wo, bf16_t* dst) {
    const int tid = p.tid;
    for (int it = p.bid; it < 512; it += p.nb) {
        const int g = it >> 7, c8 = (it >> 2) & 31, n = (it & 3) * 512 + tid;
        float acc[8];
#pragma unroll
        for (int e = 0; e < 8; ++e) acc[e] = 0.f;
        const float* pwr = pw + (size_t)(g * 256 + c8 * 8) * 256;
        for (int d = 0; d < 256; ++d) {
            const float wv = wo[(size_t)(g * 256 + d) * DM + n] * sc[g * 256 + d];
#pragma unroll
            for (int e = 0; e < 8; ++e) acc[e] += pwr[e * 256 + d] * wv;
        }
        u32x4 w; w.x = cvt_pk_bf16(acc[0], acc[1]); w.y = cvt_pk_bf16(acc[2], acc[3]); w.z = cvt_pk_bf16(acc[4], acc[5]); w.w = cvt_pk_bf16(acc[6], acc[7]);
        *(u32x4*)(dst + (size_t)n * DM + g * 256 + c8 * 8) = w;
    }
}
__device__ __forceinline__ void prep_weights(const DP& p, LAS unsigned char* lds, int l) {
    transpose_cvt(p, lds, p.in_(4) + (size_t)l * DM * 4096, DM, 4096, (bf16_t*)(p.ws_() + WS_WIN), DM, 0, 0);
    transpose_cvt(p, lds, p.in_(18) + (size_t)l * DM * DM + (size_t)1024 * DM, 1024, DM, (bf16_t*)(p.ws_() + WS_WOUT), DM, 1024, 0);
    transpose_cvt(p, lds, p.in_(20) + (size_t)l * DM * DFF, DM, DFF, (bf16_t*)(p.ws_() + WS_WGU), DM, 0, 1);
    transpose_cvt(p, lds, p.in_(21) + (size_t)l * DM * DFF, DM, DFF, (bf16_t*)(p.ws_() + WS_WGU), DM, 0, 2);
    transpose_cvt(p, lds, p.in_(22) + (size_t)l * DFF * DM, DFF, DM, (bf16_t*)(p.ws_() + WS_WDN), DFF, 0, 0);
    fold_pool(p, p.in_(5) + (size_t)l * 4 * 256 * 256, p.in_(6) + (size_t)l * 1024, p.in_(18) + (size_t)l * DM * DM, (bf16_t*)(p.ws_() + WS_WOUT));
    { const float* w4 = p.in_(16) + (size_t)l * 64 * 4096; float* w4t = (float*)(p.ws_() + WS_W4T);
      for (int i = p.bid * NTHREADS + p.tid; i < 4096 * 64; i += p.nb * NTHREADS) w4t[i] = w4[(size_t)(i & 63) * 4096 + (i >> 6)]; }
}

__device__ __forceinline__ void mlp_layer(LAS float* hl, int lane, int nin, const float* w, const float* b, const float* fr) {
    float acc[64];
#pragma unroll
    for (int j = 0; j < 64; ++j) acc[j] = b[j];
#pragma unroll 1
    for (int i = 0; i < nin; ++i) {
        const float hv = hl[i * 64 + lane];
#pragma unroll
        for (int j = 0; j < 64; ++j) acc[j] += hv * w[i * 64 + j];
    }
#pragma unroll
    for (int j = 0; j < 64; ++j) hl[j * 64 + lane] = __sinf(fr[j] * acc[j]);
}
__device__ __forceinline__ void filter_h3(const DP& p, LAS unsigned char* lds, int l) {
    const int lane = p.tid & 63, wv = __builtin_amdgcn_readfirstlane(p.tid >> 6), gw = __builtin_amdgcn_readfirstlane(p.bid * 8 + (p.tid >> 6)), nw = p.nb * 8;
    const float* w1 = p.in_(9) + (size_t)l * 33 * 64; const float* b1 = p.in_(10) + l * 64;
    const float* w2 = p.in_(11) + (size_t)l * 64 * 64; const float* b2 = p.in_(12) + l * 64;
    const float* w3 = p.in_(13) + (size_t)l * 64 * 64; const float* b3 = p.in_(14) + l * 64;
    const float* fr = p.in_(15) + l * 64;
    float* h3 = (float*)(p.ws_() + WS_H3);
    LAS float* hl = (LAS float*)lds + wv * 4096;
    for (int item = gw; item < 129 + 65; item += nw) {
        const int tr = item < 129 ? 1 : 0, tile = tr ? item : item - 129, L = tr ? 8208 : 4112;
        const int n = tile * 64 + lane; const bool valid = n < L;
        const float nf = (float)n, t = nf / (float)(L - 1);
        hl[lane] = t;
#pragma unroll
        for (int b = 0; b < 16; ++b) { const float band = 1e-4f + (float)b * ((15.0f - 1e-4f) / 15.0f);
            const float ang = (6.283185307179586f / (float)L) * nf * band; hl[(1 + b) * 64 + lane] = __cosf(ang); hl[(17 + b) * 64 + lane] = -__sinf(ang); }
        mlp_layer(hl, lane, 33, w1, b1, fr);
        mlp_layer(hl, lane, 64, w2, b2, fr);
        mlp_layer(hl, lane, 64, w3, b3, fr);
        if (valid) { float* o = h3 + (size_t)((tr ? 0 : 8208) + n) * 64;
#pragma unroll
            for (int j = 0; j < 16; ++j) *(f32x4*)(o + 4 * j) = (f32x4){hl[(4 * j) * 64 + lane], hl[(4 * j + 1) * 64 + lane], hl[(4 * j + 2) * 64 + lane], hl[(4 * j + 3) * 64 + lane]}; }
    }
}
__device__ __forceinline__ bf16x8 cvt8(const f32x4 a, const f32x4 b) { u32x4 o; o.x = cvt_pk_bf16(a[0], a[1]); o.y = cvt_pk_bf16(a[2], a[3]); o.z = cvt_pk_bf16(b[0], b[1]); o.w = cvt_pk_bf16(b[2], b[3]); return __builtin_bit_cast(bf16x8, o); }
__device__ __forceinline__ void filter_gen(const DP& p, LAS unsigned char* lds, int l) {
    const int skipb = (p.nb == 256) ? 16 : 0;
    if (p.bid < skipb) return;
    const int lane = p.tid & 63, wv = __builtin_amdgcn_readfirstlane(p.tid >> 6), gw = __builtin_amdgcn_readfirstlane((p.bid - skipb) * 8 + (p.tid >> 6)), nw = (p.nb - skipb) * 8;
    const float* w4t = (const float*)(p.ws_() + WS_W4T); const float* h3 = (const float*)(p.ws_() + WS_H3);
    const float* skip = p.in_(17) + (size_t)l * 2 * 1024;
    LAS bf16_t* S = (LAS bf16_t*)(lds + wv * 8448);
    const int col = lane & 31, hh = lane >> 5;
    constexpr int NS = 2 * 65 * 8, NPI = 2 * 33 * 8;
    for (int item = gw; item < NS + NPI; item += nw) {
        const int tr = item < NS ? 1 : 0, it2 = tr ? item : item - NS;
        const int L = tr ? 8208 : 4112, GL = 2 * L;
        const int part = it2 & 7, bd = it2 >> 3, dir = bd & 1, b = bd >> 1, o = part >> 2, ct0 = (part & 3) * 8;
        const int nbase = 128 * b + dir;
        const float invL1 = 1.0f / (float)(L - 1);
        bf16x8 A[4][4];
#pragma unroll
        for (int r = 0; r < 4; ++r) {
            int n = nbase + 32 * r + col; n = n < L ? n : L - 1;
            const float* hr = h3 + (size_t)((tr ? 0 : 8208) + n) * 64 + 8 * hh;
#pragma unroll
            for (int s4 = 0; s4 < 4; ++s4) A[r][s4] = cvt8(*(const f32x4*)(hr + 16 * s4), *(const f32x4*)(hr + 16 * s4 + 4));
        }
        bf16_t* gbase = (bf16_t*)(p.ws_() + (tr ? WS_GFS : WS_GFP)) + (size_t)o * 1024 * GL;
        const int ebase = dir ? L + 128 * b : L - 128 * b - 128;
#pragma unroll 1
        for (int ct = 0; ct < 8; ++ct) {
            const int c = (ct0 + ct) * 32 + col;
            const float* wr = w4t + (size_t)(o * 2048 + dir * 1024 + c) * 64 + 8 * hh;
            bf16x8 Bf[4];
#pragma unroll
            for (int s4 = 0; s4 < 4; ++s4) Bf[s4] = cvt8(*(const f32x4*)(wr + 16 * s4), *(const f32x4*)(wr + 16 * s4 + 4));
            const float d0 = -3.0701134573253946f, d1 = -15.350567286626973f;
            const float kc = -fabsf(d0 + (float)c * ((d1 - d0) / 1023.0f)) * 1.4426950408889634f;
            const float sk = skip[o * 1024 + c];
#pragma unroll
            for (int r = 0; r < 4; ++r) {
                f32x16 acc;
#pragma unroll
                for (int i = 0; i < 16; ++i) acc[i] = 0.f;
#pragma unroll
                for (int s4 = 0; s4 < 4; ++s4) acc = __builtin_amdgcn_mfma_f32_32x32x16_bf16(A[r][s4], Bf[s4], acc, 0, 0, 0);
#pragma unroll
                for (int q = 0; q < 4; ++q) {
                    const int nl0 = 32 * r + 8 * q + 4 * hh;
                    float v[4];
#pragma unroll
                    for (int e = 0; e < 4; ++e) { const int n = nbase + nl0 + e; const float t = (float)n * invL1;
                        v[e] = acc[4 * q + e] * __builtin_amdgcn_exp2f(t * kc); }
                    if (r == 0 && q == 0) v[0] += (nbase + nl0 == 0 && dir == 0) ? sk : 0.f;
                    u32x2 w;
                    if (dir) { w.x = cvt_pk_bf16(v[0], v[1]); w.y = cvt_pk_bf16(v[2], v[3]); *(LAS u32x2*)(S + col * 132 + nl0) = w; }
                    else     { w.x = cvt_pk_bf16(v[3], v[2]); w.y = cvt_pk_bf16(v[1], v[0]); *(LAS u32x2*)(S + col * 132 + 124 - nl0) = w; }
                }
            }
#pragma unroll
            for (int u = 0; u < 8; ++u) {
                const int id = u * 64 + lane, colr = id >> 4, k = id & 15;
                const u32x2 lo = *(const LAS u32x2*)(S + colr * 132 + 8 * k), hi = *(const LAS u32x2*)(S + colr * 132 + 8 * k + 4);
                const int e0 = ebase + 8 * k;
                if ((unsigned)e0 <= (unsigned)(GL - 8)) *(u32x4*)(gbase + (size_t)((ct0 + ct) * 32 + colr) * GL + e0) = (u32x4){lo.x, lo.y, hi.x, hi.y};
            }
        }
    }
}

__device__ __forceinline__ void pool_acc(float (&s)[8], const u32x4 v, float sg) {
    s[0] += sg * bflo(v.x); s[1] += sg * bfhi(v.x); s[2] += sg * bflo(v.y); s[3] += sg * bfhi(v.y); s[4] += sg * bflo(v.z); s[5] += sg * bfhi(v.z); s[6] += sg * bflo(v.w); s[7] += sg * bfhi(v.w);
}
__device__ __forceinline__ void pool_window(const DP& p) {
    const bf16_t* P = (const bf16_t*)(p.ws_() + WS_P); bf16_t* mix = (bf16_t*)(p.ws_() + WS_XA);
    const int total = (4 * 257 + 2 * 513) * 128;
    for (int idx = p.bid * NTHREADS + p.tid; idx < total; idx += p.nb * NTHREADS) {
        const int run = idx >> 7, c8 = idx & 127;
        int sq, r, L;
        if (run < 4 * 257) { sq = run / 257; r = run - sq * 257; L = 4112; } else { const int r2 = run - 4 * 257; sq = 4 + r2 / 513; r = r2 - (sq - 4) * 513; L = 8208; }
        const int hw = 1 << (c8 >> 5), p0 = 16 * r;
        const bf16_t* Pc = P + 8 * c8;
        float s[8];
#pragma unroll
        for (int e = 0; e < 8; ++e) s[e] = 0.f;
        { const int lo = p0 - hw < 0 ? 0 : p0 - hw, hi = p0 + hw > L ? L : p0 + hw;
          for (int q = lo; q < hi; ++q) pool_acc(s, *(const u32x4*)(Pc + (size_t)seq_row(sq, q) * 1024), 1.0f); }
#pragma unroll 4
        for (int i = 0; i < 16; ++i) {
            const int pp = p0 + i;
            const int lo = pp - hw < 0 ? 0 : pp - hw, hi = pp + hw > L ? L : pp + hw;
            const float inv = 1.0f / (float)(hi - lo);
            const int row = seq_row(sq, pp);
            const u32x4 v = *(const u32x4*)(Pc + (size_t)row * 1024);
            u32x4 w;
            w.x = cvt_pk_bf16(s[0] * inv - bflo(v.x), s[1] * inv - bfhi(v.x)); w.y = cvt_pk_bf16(s[2] * inv - bflo(v.y), s[3] * inv - bfhi(v.y));
            w.z = cvt_pk_bf16(s[4] * inv - bflo(v.z), s[5] * inv - bfhi(v.z)); w.w = cvt_pk_bf16(s[6] * inv - bflo(v.w), s[7] * inv - bfhi(v.w));
            *(u32x4*)(mix + (size_t)row * DM + 8 * c8) = w;
            if (pp + hw < L) pool_acc(s, *(const u32x4*)(Pc + (size_t)seq_row(sq, pp + hw) * 1024), 1.0f);
            if (pp - hw >= 0) pool_acc(s, *(const u32x4*)(Pc + (size_t)seq_row(sq, pp - hw) * 1024), -1.0f);
        }
    }
}

constexpr int HYH_U = 0, HYH_FB = 35840, HYH_ZB = HYH_FB + 33280, HYH_RED = HYH_ZB + 512, HYH_SIZE = HYH_RED + 1024;
static_assert(2 * HYH_SIZE <= LDS_BYTES, "hyena LDS");
constexpr int FPAD = 176;
template <int TR> struct HG;
template <> struct HG<1> { static constexpr int L = 8208, B = 2, NSB = 16, BSE = 8720, NIN = 513, SQ0 = 4; };
template <> struct HG<0> { static constexpr int L = 4112, B = 4, NSB = 8,  BSE = 4416, NIN = 257, SQ0 = 0; };
__device__ __forceinline__ int uphys(int q) { return q + 8 * (q >> 7); }

struct ARaw { u32x2 w01, w23, w45; };
__device__ __forceinline__ ARaw hy_raw_a(const LAS unsigned char* p8) { ARaw r; r.w01 = *(const LAS u32x2*)p8; r.w23 = *(const LAS u32x2*)(p8 + 8); r.w45 = *(const LAS u32x2*)(p8 + 16); return r; }
__device__ __forceinline__ bf16x8 hy_fin_a(const ARaw& r, bool dsel, unsigned bsh) {
    const unsigned s0 = dsel ? r.w01.y : r.w01.x, s1 = dsel ? r.w23.x : r.w01.y, s2 = dsel ? r.w23.y : r.w23.x, s3 = dsel ? r.w45.x : r.w23.y, s4 = dsel ? r.w45.y : r.w45.x;
    u32x4 o; o.x = __builtin_amdgcn_alignbit(s1, s0, bsh); o.y = __builtin_amdgcn_alignbit(s2, s1, bsh); o.z = __builtin_amdgcn_alignbit(s3, s2, bsh); o.w = __builtin_amdgcn_alignbit(s4, s3, bsh);
    return __builtin_bit_cast(bf16x8, o);
}
template <int TR>
__device__ __forceinline__ void hy_conv(LAS unsigned char* hl, int wq, int lane, f32x16 (&acc)[4]) {
    typedef HG<TR> G;
    const LAS unsigned char* Ub = hl + HYH_U; const LAS unsigned char* FBb = hl + HYH_FB;
    asm volatile("" : "+v"(lane));
    const int n = lane & 31, h = lane >> 5;
    const int sbi = n % G::NSB, beta = n / G::NSB, sb0 = wq * G::NSB;
    const int abase = FPAD + (G::L - 1) - n + 8 * h;
    const int ab2 = 2 * abase, ab8 = ab2 & ~7; const bool dsel = (ab2 & 4) != 0; const unsigned bsh = (ab2 & 2) ? 16u : 0u;
    constexpr int KS = (G::L - 16) / 16 + 8 * (G::NSB - 1) + 1, NIT = (KS + 1) / 2, NOUT = (NIT + 3) / 4;
    const int dlo = 128 * sb0 - (G::L - 16);
    constexpr int MMAX = (G::L - 16) / 128;
#pragma unroll
    for (int r = 0; r < 4; ++r)
#pragma unroll
        for (int i = 0; i < 16; ++i) acc[r][i] = 0.f;
    bf16x8 qe[4], qo[4];
#pragma unroll
    for (int r = 0; r < 4; ++r) { qe[r] = hy_fin_a(hy_raw_a(FBb + (ab8 - 2 * (dlo + 32 * r))), dsel, bsh); qo[r] = hy_fin_a(hy_raw_a(FBb + (ab8 - 2 * (dlo + 16 + 32 * r))), dsel, bsh); }
    const int ub2 = 2 * (beta * G::BSE + 8 * h);
    int M = sbi + MMAX;
    const LAS unsigned char* zb = hl + HYH_ZB + 256;
#define HY_PB(MM, first) ({ const bool v_ = (first) ? ((unsigned)(MM) <= (unsigned)MMAX) : ((unsigned)((MM) - 1) < (unsigned)MMAX); v_ ? (Ub + ub2 + 272 * (MM)) : zb; })
    const LAS unsigned char* pb0 = HY_PB(M, true); const LAS unsigned char* pb1 = HY_PB(M, false);
    bf16x8 be = *(const LAS bf16x8*)pb0, bo = *(const LAS bf16x8*)(pb1 - 2 * (16 + 8));
    unsigned pa = (unsigned)(size_t)(FBb + (ab8 - 2 * (dlo + 128))) - 320u;
#define HY_DSR64(dst, addr, off)  asm volatile("ds_read_b64 %0, %1 offset:%2"  : "=v"(dst) : "v"(addr), "n"(off))
#define HY_DSR128(dst, addr, off) asm volatile("ds_read_b128 %0, %1 offset:%2" : "=v"(dst) : "v"(addr), "n"(off))
#pragma unroll 1
    for (int I = 0; I < NOUT; ++I) {
        const LAS unsigned char* pn0 = HY_PB(M - 1, true); const LAS unsigned char* pn1 = HY_PB(M - 1, false);
        const unsigned b1a = (unsigned)(size_t)pb1 - 256u, n0a = (unsigned)(size_t)pn0, n1a = (unsigned)(size_t)pn1 - 256u;
#pragma unroll
        for (int j = 0; j < 4; ++j) {
            ARaw ra, rb; bf16x8 nbe, nbo;
            HY_DSR64(ra.w01, pa, 320 - 64 * j);      HY_DSR64(ra.w23, pa, 320 - 64 * j + 8);      HY_DSR64(ra.w45, pa, 320 - 64 * j + 16);
            HY_DSR64(rb.w01, pa, 320 - 64 * j - 32); HY_DSR64(rb.w23, pa, 320 - 64 * j - 32 + 8); HY_DSR64(rb.w45, pa, 320 - 64 * j - 32 + 16);
            if (j < 3) { HY_DSR128(nbe, b1a, 256 - 2 * (32 * (j + 1) + 8)); HY_DSR128(nbo, b1a, 256 - 2 * (32 * (j + 1) + 16 + 8)); }
            else       { HY_DSR128(nbe, n0a, 0);                            HY_DSR128(nbo, n1a, 256 - 2 * (16 + 8)); }
#pragma unroll
            for (int r = 0; r < 4; ++r) acc[r] = __builtin_amdgcn_mfma_f32_32x32x16_bf16(qe[(j + r) & 3], be, acc[r], 0, 0, 0);
#pragma unroll
            for (int r = 0; r < 4; ++r) acc[r] = __builtin_amdgcn_mfma_f32_32x32x16_bf16(qo[(j + r) & 3], bo, acc[r], 0, 0, 0);
            asm volatile("s_waitcnt lgkmcnt(0)" : "+v"(ra.w01), "+v"(ra.w23), "+v"(ra.w45), "+v"(rb.w01), "+v"(rb.w23), "+v"(rb.w45), "+v"(nbe), "+v"(nbo), "+v"(acc[0]), "+v"(acc[1]), "+v"(acc[2]), "+v"(acc[3]));
            qe[j] = hy_fin_a(ra, dsel, bsh); qo[j] = hy_fin_a(rb, dsel, bsh);
            be = nbe; bo = nbo;
        }
        pa -= 256u; pb0 = pn0; pb1 = pn1; --M;
    }
#undef HY_DSR64
#undef HY_DSR128
#undef HY_PB
    {
        f32x16 at;
#pragma unroll
        for (int i = 0; i < 16; ++i) at[i] = 0.f;
        constexpr int MS = (G::NIN + 3) / 4;
        const int m0 = wq * MS, m1 = (m0 + MS < G::NIN) ? m0 + MS : G::NIN;
        const bool colv = n < G::B;
        const int ut2 = 2 * ((colv ? n : 0) * G::BSE + 8 * h);
#pragma unroll 4
        for (int m = m0; m < m1; ++m) {
            const int d = (G::L - 16) - 16 * m;
            const bf16x8 a = hy_fin_a(hy_raw_a(FBb + (ab8 - 2 * d)), dsel, bsh);
            const bf16x8 b = *(const LAS bf16x8*)(colv ? Ub + ut2 + 2 * (16 * m + 8 * ((16 * m) >> 7)) : zb);
            at = __builtin_amdgcn_mfma_f32_32x32x16_bf16(a, b, at, 0, 0, 0);
        }
        LAS float* RED = (LAS float*)(hl + HYH_RED);
        if (colv) {
#pragma unroll
            for (int i = 0; i < 8; ++i) { const int arow = (i & 3) + 8 * (i >> 2) + 4 * h; RED[(wq * 16 + arow) * 4 + n] = at[i]; }
        }
    }
}
template <int TR>
__device__ __forceinline__ void hy_load_stream(const DP& p, LAS unsigned char* hl, int lt, int l, int k, int c, bool toU) {
    typedef HG<TR> G;
    asm volatile("" : "+v"(lt));
    const int ch = k * 1024 + c;
    const float* cw = p.in_(7) + (size_t)l * 3 * 3072; const float* cb = p.in_(8) + (size_t)l * 3072;
    const float w0 = cw[ch], w1 = cw[3072 + ch], w2 = cw[2 * 3072 + ch], bb = cb[ch];
    const bf16_t* src = (const bf16_t*)(p.ws_() + WS_UT) + (size_t)ch * TP;
    LAS bf16_t* U = (LAS bf16_t*)(hl + HYH_U); LAS bf16_t* X = (LAS bf16_t*)(hl + HYH_FB);
    constexpr int nch = G::L / 8, NCH = G::B * nch, NI = (NCH + 255) / 256;
    constexpr int GB = 3;
#pragma unroll
    for (int g0 = 0; g0 < NI; g0 += GB) {
        u32x4 v[GB]; unsigned short xl[GB], xr[GB];
#pragma unroll
        for (int i = 0; i < GB; ++i) {
            int idx = lt + 256 * (g0 + i); idx = idx < NCH ? idx : NCH - 1;
            const int b = idx / nch, q = idx - b * nch, p0 = 8 * q, sq = G::SQ0 + b;
            const int moff = TREAL + 16 * sq, roff = seq_rbase(sq);
            const int off = p0 < 16 ? moff + p0 : roff + p0 - 16;
            v[i] = *(const u32x4*)(src + off);
            xl[i] = src[p0 == 0 ? off : (p0 == 16 ? moff + 15 : off - 1)];
            xr[i] = src[p0 + 8 >= G::L ? off : (p0 + 8 == 16 ? roff : off + 8)];
        }
#pragma unroll
        for (int i = 0; i < GB; ++i) {
            const int idx = lt + 256 * (g0 + i);
            if (g0 + i < NI && idx < NCH) {
                const int b = idx / nch, q = idx - b * nch, p0 = 8 * q;
                float x[10];
                x[0] = (p0 == 0) ? 0.f : bf2f(xl[i]);
                x[9] = (p0 + 8 >= G::L) ? 0.f : bf2f(xr[i]);
                x[1] = bflo(v[i].x); x[2] = bfhi(v[i].x); x[3] = bflo(v[i].y); x[4] = bfhi(v[i].y); x[5] = bflo(v[i].z); x[6] = bfhi(v[i].z); x[7] = bflo(v[i].w); x[8] = bfhi(v[i].w);
                float y[8];
#pragma unroll
                for (int j = 0; j < 8; ++j) y[j] = w0 * x[j] + w1 * x[j + 1] + w2 * x[j + 2] + bb;
                u32x4 w; w.x = cvt_pk_bf16(y[0], y[1]); w.y = cvt_pk_bf16(y[2], y[3]); w.z = cvt_pk_bf16(y[4], y[5]); w.w = cvt_pk_bf16(y[6], y[7]);
                LAS bf16_t* dst = toU ? U + b * G::BSE + uphys(p0) : X + b * G::L + p0;
                *(LAS u32x4*)dst = w;
            }
        }
    }
}
template <int TR>
__device__ __forceinline__ void hy_load_filter(const DP& p, LAS unsigned char* hl, int lt, int o, int c) {
    typedef HG<TR> G;
    constexpr int GL = 2 * G::L, NCH = GL / 8, NI = (NCH + 255) / 256;
    asm volatile("" : "+v"(lt));
    const bf16_t* gf = (const bf16_t*)(p.ws_() + (TR ? WS_GFS : WS_GFP)) + ((size_t)o * 1024 + c) * GL;
    LAS bf16_t* FB = (LAS bf16_t*)(hl + HYH_FB);
    u32x4 v[NI];
#pragma unroll
    for (int i = 0; i < NI; ++i) { int idx = lt + 256 * i; idx = idx < NCH ? idx : NCH - 1; v[i] = *(const u32x4*)(gf + 8 * idx); }
    if (lt < FPAD / 8) *(LAS u32x4*)(FB + 8 * lt) = (u32x4){0u, 0u, 0u, 0u};
#pragma unroll
    for (int i = 0; i < NI; ++i) { const int idx = lt + 256 * i; if (idx < NCH) *(LAS u32x4*)(FB + FPAD + 8 * idx) = v[i]; }
}
template <int TR>
__device__ __forceinline__ void hy_items(const DP& p, LAS unsigned char* lds, int l, int vcu) {
    typedef HG<TR> G;
    const int tid = p.tid, lane = tid & 63, wave = __builtin_amdgcn_readfirstlane(tid >> 6), hf = wave >> 2, wq = wave & 3, lt = tid & 255;
    LAS unsigned char* hl = lds + hf * HYH_SIZE;
    LAS bf16_t* U = (LAS bf16_t*)(hl + HYH_U); const LAS bf16_t* X = (const LAS bf16_t*)(hl + HYH_FB); const LAS float* RED = (const LAS float*)(hl + HYH_RED);
    bf16_t* UT = (bf16_t*)(p.ws_() + WS_UT);
    for (int pit = vcu; pit < 512; pit += p.nb) {
        const int c = 2 * pit + hf;
        if (lt < 32) *(LAS u32x4*)(hl + HYH_ZB + 16 * lt) = (u32x4){0u, 0u, 0u, 0u};
        hy_load_stream<TR>(p, hl, lt, l, 0, c, true);
        hy_load_filter<TR>(p, hl, lt, 0, c);
        __syncthreads();
        f32x16 acc[4];
#pragma unroll 1
        for (int rep = 0; rep < HYREP; ++rep) { hy_conv<TR>(hl, wq, lane, acc); asm volatile("" ::: "memory"); }
        __syncthreads();
        hy_load_stream<TR>(p, hl, lt, l, 1, c, false);
        __syncthreads();
        { int ln = lane; asm volatile("" : "+v"(ln)); const int n = ln & 31, hh = ln >> 5, sbi = n % G::NSB, beta = n / G::NSB, sb = wq * G::NSB + sbi;
#pragma unroll
        for (int r = 0; r < 4; ++r)
#pragma unroll
            for (int qd = 0; qd < 4; ++qd) {
                const int t0 = 128 * sb + 32 * r + 8 * qd + 4 * hh;
                const u32x2 xv = *(const LAS u32x2*)(X + beta * G::L + t0);
                u32x2 w; w.x = cvt_pk_bf16(bflo(xv.x) * acc[r][4 * qd], bfhi(xv.x) * acc[r][4 * qd + 1]); w.y = cvt_pk_bf16(bflo(xv.y) * acc[r][4 * qd + 2], bfhi(xv.y) * acc[r][4 * qd + 3]);
                *(LAS u32x2*)(U + beta * G::BSE + uphys(t0)) = w;
            }
        }
        if (lt < 16 * G::B) { const int a = lt & 15, b = lt >> 4; float y = 0.f;
#pragma unroll
            for (int w = 0; w < 4; ++w) y += RED[(w * 16 + a) * 4 + b];
            const int t = (G::L - 16) + a;
            U[b * G::BSE + uphys(t)] = f2bf(bf2f(X[b * G::L + t]) * y); }
        __syncthreads();
        hy_load_filter<TR>(p, hl, lt, 1, c);
        __syncthreads();
        hy_conv<TR>(hl, wq, lane, acc);
        __syncthreads();
        hy_load_stream<TR>(p, hl, lt, l, 2, c, false);
        __syncthreads();
        bf16_t* orow = UT + (size_t)c * TP;
        { int ln = lane; asm volatile("" : "+v"(ln)); const int n = ln & 31, hh = ln >> 5, sbi = n % G::NSB, beta = n / G::NSB, sb = wq * G::NSB + sbi;
#pragma unroll
        for (int r = 0; r < 4; ++r)
#pragma unroll
            for (int qd = 0; qd < 4; ++qd) {
                const int t0 = 128 * sb + 32 * r + 8 * qd + 4 * hh;
                const u32x2 xv = *(const LAS u32x2*)(X + beta * G::L + t0);
                u32x2 w; w.x = cvt_pk_bf16(bflo(xv.x) * acc[r][4 * qd], bfhi(xv.x) * acc[r][4 * qd + 1]); w.y = cvt_pk_bf16(bflo(xv.y) * acc[r][4 * qd + 2], bfhi(xv.y) * acc[r][4 * qd + 3]);
                *(u32x2*)(orow + seq_row(G::SQ0 + beta, t0)) = w;
            }
        }
        if (lt < 16 * G::B) { const int a = lt & 15, b = lt >> 4; float y = 0.f;
#pragma unroll
            for (int w = 0; w < 4; ++w) y += RED[(w * 16 + a) * 4 + b];
            const int t = (G::L - 16) + a;
            orow[seq_row(G::SQ0 + b, t)] = f2bf(bf2f(X[b * G::L + t]) * y); }
        __syncthreads();
    }
}
__device__ __forceinline__ void hyena_phase(const DP& p, LAS unsigned char* lds, int l) {
    const int Gd = p.nb, bx = p.bid;
    const int vcu = (Gd % 8 == 0) ? (bx % 8) * (Gd / 8) + bx / 8 : bx;
    hy_items<1>(p, lds, l, vcu);
    hy_items<0>(p, lds, l, vcu);
}
__device__ __forceinline__ void hyena_transpose(const DP& p, LAS unsigned char* lds) {
    const bf16_t* UT = (const bf16_t*)(p.ws_() + WS_UT); bf16_t* mix = (bf16_t*)(p.ws_() + WS_XA);
    LAS bf16_t* tile = (LAS bf16_t*)lds;
    const int tid = p.tid, ntile = 16 * (TP / 64);
    for (int t0 = p.bid * 4; t0 < ntile; t0 += p.nb * 4) {
        u32x4 v[4];
#pragma unroll
        for (int u = 0; u < 4; ++u) { const int t = (t0 + u < ntile) ? t0 + u : ntile - 1; const int c0 = (t & 15) * 64, tk0 = (t >> 4) * 64, cc = tid >> 3, t8 = tid & 7;
            v[u] = *(const u32x4*)(UT + (size_t)(c0 + cc) * TP + tk0 + 8 * t8); }
#pragma unroll
        for (int u = 0; u < 4; ++u) { const int cc = tid >> 3, t8 = tid & 7; *(LAS u32x4*)(tile + u * 4608 + cc * 72 + 8 * t8) = v[u]; }
        __syncthreads();
#pragma unroll
        for (int u = 0; u < 4; ++u) if (t0 + u < ntile) { const int t = t0 + u, c0 = (t & 15) * 64, tk0 = (t >> 4) * 64;
            const int tt = tid >> 3, c8 = tid & 7; unsigned w[4];
#pragma unroll
            for (int j = 0; j < 4; ++j) w[j] = (unsigned)tile[u * 4608 + (8 * c8 + 2 * j) * 72 + tt] | ((unsigned)tile[u * 4608 + (8 * c8 + 2 * j + 1) * 72 + tt] << 16);
            *(u32x4*)(mix + (size_t)(tk0 + tt) * DM + 1024 + c0 + 8 * c8) = (u32x4){w[0], w[1], w[2], w[3]}; }
        __syncthreads();
    }
}

#define XB_TMO      128
#define XB_XCNT(j)  (256  + 64 * (j))
#define XB_XSUB(j)  (1280 + 64 * (j))
#define XB_XGEN(j)  (2304 + 64 * (j))
#define XB_TOP      3328
#define XB_TOPGEN   3392
#define XCD_BAR_WORDS 3456
#define XB_SPIN_CAP (1u << 18)
__device__ __forceinline__ unsigned xb_ld(unsigned* p)              { return __hip_atomic_load(p, __ATOMIC_RELAXED, __HIP_MEMORY_SCOPE_AGENT); }
__device__ __forceinline__ unsigned xb_add(unsigned* p, unsigned v) { return __hip_atomic_fetch_add(p, v, __ATOMIC_RELAXED, __HIP_MEMORY_SCOPE_AGENT); }
__device__ __forceinline__ unsigned xb_xcc_id() { return (unsigned)__builtin_amdgcn_s_getreg((3 << 11) | 20) & 0xFu; }
#define XB_SPIN(cond, bar) do { unsigned _sp = 0; while (cond) { __builtin_amdgcn_s_sleep(1); \
    if ((++_sp & 255u) == 0u) { if (xb_ld(&(bar)[XB_TMO])) break; if (_sp > XB_SPIN_CAP) { atomicAdd(&(bar)[XB_TMO], 1u); break; } } } } while (0)
__device__ __forceinline__ void xcd_barrier_complete(unsigned* bar, unsigned x, unsigned G, unsigned& nloc, unsigned& nx) {
    unsigned sum, cnt, mine, sp = 0u;
    for (;;) {
        sum = 0u; cnt = 0u; mine = 0u;
#pragma unroll
        for (unsigned j = 0; j < 16; ++j) { const unsigned c = xb_ld(&bar[XB_XCNT(j)]); sum += c; cnt += (c > 0u) ? 1u : 0u; mine = (j == x) ? c : mine; }
        if (sum == G) break;
        __builtin_amdgcn_s_sleep(1);
        if ((++sp & 255u) == 0u) { if (xb_ld(&bar[XB_TMO])) break; if (sp > XB_SPIN_CAP) { atomicAdd(&bar[XB_TMO], 1u); break; } }
    }
    nloc = mine > 0u ? mine : 1u; nx = cnt > 0u ? cnt : 1u;
}
__device__ __forceinline__ void xcd_barrier(unsigned* bar, unsigned x, volatile LAS unsigned* st, unsigned G, int tid) {
    asm volatile("s_waitcnt vmcnt(0)" ::: "memory");
    __syncthreads();
    if (tid == 0) {
        __builtin_amdgcn_s_waitcnt(0);
        unsigned nloc = st[0], nx = st[1];
        if (nloc == 0u) { xcd_barrier_complete(bar, x, G, nloc, nx); st[0] = nloc; st[1] = nx; }
        const unsigned old = xb_add(&bar[XB_XSUB(x)], 1u);
        const unsigned gen = old / nloc;
        if (old + 1u == (gen + 1u) * nloc) {
            __builtin_amdgcn_fence(__ATOMIC_RELEASE, "agent");
            asm volatile("s_waitcnt vmcnt(0)" ::: "memory");
            const unsigned og = xb_add(&bar[XB_TOP], 1u);
            const unsigned tg = og / nx;
            if (og + 1u == (tg + 1u) * nx) xb_add(&bar[XB_TOPGEN], 1u);
            else XB_SPIN(xb_ld(&bar[XB_TOPGEN]) == tg, bar);
            __builtin_amdgcn_fence(__ATOMIC_ACQUIRE, "agent");
            xb_add(&bar[XB_XGEN(x)], 1u);
            asm volatile("s_waitcnt vmcnt(0)" ::: "memory");
        } else {
            XB_SPIN(xb_ld(&bar[XB_XGEN(x)]) == gen, bar);
            __builtin_amdgcn_fence(__ATOMIC_ACQUIRE, "agent");
            asm volatile("s_waitcnt vmcnt(0)" ::: "memory");
        }
    }
    __syncthreads();
}

constexpr int NPHASES = 17;
__device__ __forceinline__ void run_phase(const DP& p, LAS unsigned char* lds, int ph) {
    const int l = (ph == 0) ? 0 : (ph - 1) / 8, jj = (ph - 1) % 8, k = (ph == 0) ? 0 : (jj < 2 ? jj + 1 : (jj == 2 ? 8 : jj));
    const int G = p.nb, cbx = p.bid;
    bf16_t* XA = (bf16_t*)(p.ws_() + WS_XA);
    switch (k) {
#if (PHMASK >> 0) & 1
    case 0: {
#if SUB & 1
        norm_rows(p, 0, p.in_(3));
#endif
#if SUB & 2
        prep_weights(p, lds, 0);
#endif
#if SUB & 4
        __syncthreads(); filter_h3(p, lds, 0);
#endif
    } break;
#endif
#if (PHMASK >> 1) & 1
    case 1: {
        pg8::Prob p0{XA, (const bf16_t*)(p.ws_() + WS_WIN), TP / 256, 4};
        pg8::Prob p1{(const bf16_t*)(p.ws_() + WS_WIN) + (size_t)1024 * DM, XA, 12, TP / 256};
        pg8::Sched2 S; S.init(p0, p1, DM, G, cbx);
        pg8::EpiStore E{{(bf16_t*)(p.ws_() + WS_P), (bf16_t*)(p.ws_() + WS_UT)}, {1024, TP}};
#ifndef NOG1
        pg8::gemm_phase<pg8::EpiStore, pg8::Sched2>(p, lds, S, E);
#endif
#ifndef NOFG
        { DP p2 = p; asm volatile("" : "+v"(p2.tid));
          __syncthreads(); filter_gen(p2, lds, l); }
#endif
    } break;
#endif
#if (PHMASK >> 2) & 1
    case 2: {
#ifndef NOHY
        hyena_phase(p, lds, l);
#endif
#ifndef NOPOOL
        pool_window(p);
#endif
    } break;
#endif
#if (PHMASK >> 8) & 1
    case 8: hyena_transpose(p, lds); break;
#endif
#if (PHMASK >> 3) & 1
    case 3: {
        pg8::Prob p0{XA, (const bf16_t*)(p.ws_() + WS_WOUT), TREAL / 256, DM / 256};
        pg8::Prob p1{XA, XA, 0, 0};
        pg8::Sched2 S; S.init(p0, p1, DM, G, cbx);
        pg8::EpiResid E{p.out_(), (float*)(p.ws_() + WS_TAIL)};
        pg8::gemm_phase<pg8::EpiResid, pg8::Sched2>(p, lds, S, E);
        if (l == 0) {
            pg8::SchedSplit S2{XA, (const bf16_t*)(p.ws_() + WS_WOUT), DM / 256, 8, 256, DM, G, cbx};
            pg8::EpiResidAtomic E2{(float*)(p.ws_() + WS_TAIL)};
            DP p2 = p; asm volatile("" : "+v"(p2.tid));
            pg8::gemm_phase<pg8::EpiResidAtomic, pg8::SchedSplit>(p2, lds, S2, E2);
        }
    } break;
#endif
#if (PHMASK >> 4) & 1
    case 4: norm_rows(p, 1, p.in_(19) + (size_t)l * DM); break;
#endif
#if (PHMASK >> 5) & 1
    case 5: {
        pg8::Prob p0{XA, (const bf16_t*)(p.ws_() + WS_WGU), l == 0 ? TP / 256 : TREAL / 256, 2 * DFF / 256};
        pg8::Prob p1{XA, XA, 0, 0};
        pg8::Sched2 S; S.init(p0, p1, DM, G, cbx);
        pg8::EpiSwiGLU E{(bf16_t*)(p.ws_() + WS_HID)};
        pg8::gemm_phase<pg8::EpiSwiGLU, pg8::Sched2>(p, lds, S, E);
    } break;
#endif
#if (PHMASK >> 6) & 1
    case 6: {
        pg8::Prob p0{(const bf16_t*)(p.ws_() + WS_HID), (const bf16_t*)(p.ws_() + WS_WDN), TREAL / 256, DM / 256};
        pg8::Prob p1{XA, XA, 0, 0};
        pg8::Sched2 S; S.init(p0, p1, DFF, G, cbx);
        pg8::EpiResid E{p.out_(), (float*)(p.ws_() + WS_TAIL)};
        pg8::gemm_phase<pg8::EpiResid, pg8::Sched2>(p, lds, S, E);
        if (l == 0) {
            pg8::SchedSplit S2{(const bf16_t*)(p.ws_() + WS_HID), (const bf16_t*)(p.ws_() + WS_WDN), DM / 256, 11, 512, DFF, G, cbx};
            pg8::EpiResidAtomic E2{(float*)(p.ws_() + WS_TAIL)};
            DP p2 = p; asm volatile("" : "+v"(p2.tid));
            pg8::gemm_phase<pg8::EpiResidAtomic, pg8::SchedSplit>(p2, lds, S2, E2);
        }
    } break;
#endif
#if (PHMASK >> 7) & 1
    case 7: {
        if (l == 0) { norm_rows(p, 1, p.in_(3) + DM); prep_weights(p, lds, 1); __syncthreads(); filter_h3(p, lds, 1); }
        else norm_rows(p, 2, p.in_(23));
    } break;
#endif
    }
}

__global__ void __launch_bounds__(NTHREADS, 2) mega_fwd(Params pk, int ph_lo, int ph_hi) {
    DP p;
    extern __shared__ __attribute__((aligned(16))) unsigned char lds_raw[];
    LAS unsigned char* lds = (LAS unsigned char*)lds_raw;
    cg::grid_group grid = cg::this_grid();
    volatile LAS unsigned* xst = (volatile LAS unsigned*)(lds + (LDS_BYTES - 16));
    if (threadIdx.x == 0) { xst[0] = 0u; xst[1] = 0u; }
    __syncthreads();
    unsigned* xbar = (unsigned*)(pk.ws + WS_BAR);
    const unsigned xcc = xb_xcc_id();
    if (threadIdx.x == 0) (void)xb_add(&xbar[XB_XCNT(xcc)], 1u);
    const int wave_s = __builtin_amdgcn_readfirstlane(threadIdx.x >> 6);
    for (int ph = ph_lo; ph < ph_hi; ++ph) {
        { kseg_t ks = (kseg_t)__builtin_amdgcn_kernarg_segment_ptr(); unsigned z0 = 0u; asm volatile("" : "+s"(z0));
          int t = wave_s * 64 + (int)__builtin_amdgcn_mbcnt_hi(~0u, __builtin_amdgcn_mbcnt_lo(~0u, z0)), b = blockIdx.x, n = gridDim.x;
          asm volatile("" : "+s"(ks), "+v"(t), "+s"(b), "+s"(n));
          p.ks = ks; p.tid = t; p.bid = b; p.nb = n; }
        run_phase(p, lds, ph);
#if REPMASK
        { const int j2 = (ph - 1) % 8, kk = (ph == 0) ? 0 : (j2 < 2 ? j2 + 1 : (j2 == 2 ? 8 : j2));
          if (((REPMASK >> kk) & 1) && ph != 16) { grid.sync(); run_phase(p, lds, ph); } }
#endif
        if (ph + 1 < ph_hi) {
            if (ph == ph_lo) grid.sync();
            else xcd_barrier(xbar, xcc, xst, gridDim.x, p.tid);
        }
    }
}

extern "C" void kernel_launch(void* const* d_in, const int* in_sizes, int n_in, void* d_out, int out_size, void* d_ws, size_t ws_size, hipStream_t stream) {
    static int grid = 0;
    if (grid == 0) {
        if (n_in != 24 || ws_size < WS_END) { fprintf(stderr, "kernel_launch: need 24 inputs and %zu bytes of workspace (got %d, %zu)\n", (size_t)WS_END, n_in, ws_size); grid = -1; return; }
        int dev = 0, cus = 0, per_cu = 0;
        hipGetDevice(&dev);
        hipDeviceGetAttribute(&cus, hipDeviceAttributeMultiprocessorCount, dev);
        if (hipFuncSetAttribute((const void*)mega_fwd, hipFuncAttributeMaxDynamicSharedMemorySize, LDS_BYTES) != hipSuccess) { fprintf(stderr, "hipFuncSetAttribute failed\n"); grid = -1; return; }
        hipOccupancyMaxActiveBlocksPerMultiprocessor(&per_cu, (const void*)mega_fwd, NTHREADS, LDS_BYTES);
        if (per_cu < 1) per_cu = 1;
        (void)hipGetLastError();
        grid = cus;
    }
    if (grid < 0) return;
    Params p{};
    for (int i = 0; i < 24; ++i) p.in[i] = (const float*)d_in[i];
    p.out = (float*)d_out; p.ws = (unsigned char*)d_ws;
#if MEGA
    (void)hipMemsetAsync((char*)d_ws + WS_BAR, 0, 16384, stream);
    int lo = 0, hi = NPHASES;
    void* args[] = {&p, &lo, &hi};
    hipError_t e = hipLaunchCooperativeKernel((const void*)mega_fwd, dim3(grid), dim3(NTHREADS), args, LDS_BYTES, stream);
    if (e != hipSuccess) fprintf(stderr, "cooperative launch failed: %s (grid %d)\n", hipGetErrorString(e), grid);
#else
    for (int ph = 0; ph < NPHASES; ++ph) hipLaunchKernelGGL(mega_fwd, dim3(grid), dim3(NTHREADS), LDS_BYTES, stream, p, ph, ph + 1);
#endif
}
```

```cpp
#include <hip/hip_runtime.h>
#include <hip/hip_cooperative_groups.h>
#include <cstdio>
namespace cg = cooperative_groups;

#ifndef PHMASK
#define PHMASK 511
#endif
#ifndef SUB
#define SUB 7
#endif
#ifndef REPMASK
#define REPMASK 0
#endif
#ifndef HYREP
#define HYREP 1
#endif
#ifndef MEGA
#define MEGA 1
#endif

#define LAS __attribute__((address_space(3)))
typedef unsigned short bf16_t;
typedef short bf16x8 __attribute__((ext_vector_type(8)));
typedef float f32x4 __attribute__((ext_vector_type(4)));
typedef float f32x16 __attribute__((ext_vector_type(16)));
typedef unsigned u32x4 __attribute__((ext_vector_type(4)));
typedef unsigned u32x2 __attribute__((ext_vector_type(2)));

constexpr int DM = 2048, TREAL = 32768, TTOK = 32864, TP = 33024, DFF = 5632;
constexpr int NTHREADS = 512;
constexpr int LDS_BYTES = 147456;
constexpr float EPSN = 1e-6f;

constexpr size_t WS_TAIL = 0;
constexpr size_t WS_XA   = WS_TAIL + (size_t)256 * DM * 4;
constexpr size_t WS_WIN  = WS_XA + (size_t)TP * DM * 2;
constexpr size_t WS_WOUT = WS_WIN + (size_t)4096 * DM * 2;
constexpr size_t WS_WGU  = WS_WOUT + (size_t)DM * DM * 2;
constexpr size_t WS_WDN  = WS_WGU + (size_t)2 * DFF * DM * 2;
constexpr size_t WS_H3   = WS_WDN + (size_t)DM * DFF * 2;
constexpr size_t WS_W4T  = WS_H3 + (size_t)2 * (8208 + 4112) * 64 * 4;
constexpr size_t WS_BIG  = WS_W4T + (size_t)4096 * 64 * 4;
constexpr size_t WS_P    = WS_BIG;
constexpr size_t WS_UT   = WS_P + (size_t)TP * 1024 * 2;
constexpr size_t WS_GFS  = WS_UT + (size_t)3072 * TP * 2;
constexpr size_t WS_GFP  = WS_GFS + (size_t)2048 * 16416 * 2;
constexpr size_t WS_HID  = WS_BIG;
constexpr size_t WS_BAR  = WS_BIG + (size_t)TP * DFF * 2;
constexpr size_t WS_END  = WS_BAR + 16384;
static_assert(WS_GFP + (size_t)2048 * 8224 * 2 <= WS_BAR, "big region");

struct Params {
    const float* in[24];
    float* out;
    unsigned char* ws;
};
typedef const __attribute__((address_space(4))) unsigned long long* kseg_t;
struct DP {
    kseg_t ks; int tid, bid, nb;
    __device__ __forceinline__ const float* in_(int k) const { return (const float*)ks[k]; }
    __device__ __forceinline__ float* out_() const { return (float*)ks[24]; }
    __device__ __forceinline__ unsigned char* ws_() const { return (unsigned char*)ks[25]; }
};

__device__ __forceinline__ unsigned cvt_pk_bf16(float lo, float hi) { unsigned r; asm volatile("v_cvt_pk_bf16_f32 %0, %1, %2" : "=v"(r) : "v"(lo), "v"(hi)); return r; }
__device__ __forceinline__ bf16_t f2bf(float f) { return (bf16_t)(cvt_pk_bf16(f, 0.f) & 0xffffu); }
__device__ __forceinline__ float bf2f(unsigned v) { return __uint_as_float(v << 16); }
__device__ __forceinline__ float bflo(unsigned w) { return __uint_as_float(w << 16); }
__device__ __forceinline__ float bfhi(unsigned w) { return __uint_as_float(w & 0xffff0000u); }
__device__ __forceinline__ float wave_sum(float v) {
#pragma unroll
    for (int o = 32; o >= 1; o >>= 1) v += __shfl_xor(v, o);
    return v;
}
__device__ __forceinline__ int seq_rbase(int sq) { return sq < 4 ? sq * 4096 : 16384 + (sq - 4) * 8192; }
__device__ __forceinline__ int seq_row(int sq, int p) { return p < 16 ? TREAL + 16 * sq + p : seq_rbase(sq) + p - 16; }

namespace pg8 {
constexpr int BM = 256, BK = 64, HALF = 128, HTB = HALF * BK * 2, STAGE_BYTES = 8 * HTB, NXCD = 8, WGM = 8;
__device__ __forceinline__ int lds_byte(int r, int c) { const int st = (r >> 4) * 2 + (c >> 5), rr = r & 15, cc = c & 31, ob = rr * 64 + cc * 2; return st * 1024 + (ob ^ (((ob >> 9) & 1) << 5)); }
__device__ __forceinline__ void stage_rc(int b, int& R, int& C) { const int st = b / 1024, sb = b % 1024, swz = sb ^ (((sb >> 9) & 1) << 5); R = (st >> 1) * 16 + swz / 64; C = (st & 1) * 32 + (swz % 64) / 2; }
__device__ __forceinline__ int perm32(int rho) { const int n = rho >> 4, i = rho & 15; return 8 * (i >> 2) + 4 * n + (i & 3); }

struct Unit { const char* a; const char* b; int pm, pn, prob; };
struct Prob { const bf16_t* A; const bf16_t* Bt; int nM, nN; };
struct Sched2 {
    const bf16_t* A0; const bf16_t* B0; const bf16_t* A1; const bf16_t* B1; int nM0, nN0, nM1, nN1, nwg0, nwg1; int K, ld, G, c;
    __device__ __forceinline__ void init(const Prob& p0, const Prob& p1, int K_, int G_, int c_) { A0 = p0.A; B0 = p0.Bt; A1 = p1.A; B1 = p1.Bt; nM0 = p0.nM; nN0 = p0.nN; nM1 = p1.nM; nN1 = p1.nN;
        nwg0 = nM0 * nN0; nwg1 = nM1 * nN1; K = K_; ld = K_; G = G_; c = c_; }
    __device__ __forceinline__ bool next(int i, Unit& u) const {
        long L = (long)i * G + c; int q = 0;
        if (L >= nwg0) { L -= nwg0; q = 1; if (L >= nwg1) return false; }
        const int nM = q ? nM1 : nM0, nN = q ? nN1 : nN0, nw = q ? nwg1 : nwg0;
        int wgid = (int)L; { const int qq = nw / NXCD, r = nw % NXCD, xcd = wgid % NXCD, off = wgid / NXCD; wgid = (xcd < r ? xcd * (qq + 1) : r * (qq + 1) + (xcd - r) * qq) + off; }
        const int nig = WGM * nN, gid = wgid / nig, fm = gid * WGM, gsz = (nM - fm) < WGM ? (nM - fm) : WGM;
        u.pm = fm + ((wgid % nig) % gsz); u.pn = (wgid % nig) / gsz; u.prob = q;
        const size_t tstep = (size_t)BM * K * 2;
        u.a = (const char*)(q ? A1 : A0) + (size_t)u.pm * tstep; u.b = (const char*)(q ? B1 : B0) + (size_t)u.pn * tstep;
        return true;
    }
};

struct EpiStore {
    static constexpr bool PERM = true;
    bf16_t* O[2]; int ldc[2];
    __device__ __forceinline__ void operator()(const f32x4 (&acc)[2][2][4][2], const Unit& u, int wr, int wc, int fr, int fq) const {
        bf16_t* base = u.prob ? O[1] : O[0]; const int ld = u.prob ? ldc[1] : ldc[0];
        const int row0 = u.pm * BM + wr * 64 + fr, col0 = u.pn * BM + wc * 32 + 8 * fq;
#pragma unroll
        for (int ai = 0; ai < 2; ++ai)
#pragma unroll
            for (int m = 0; m < 4; ++m) { bf16_t* rowp = base + (size_t)(row0 + ai * HALF + m * 16) * ld + col0;
#pragma unroll
                for (int bj = 0; bj < 2; ++bj) { const f32x4 v0 = acc[ai][bj][m][0], v1 = acc[ai][bj][m][1];
                    u32x4 w; w.x = cvt_pk_bf16(v0[0], v0[1]); w.y = cvt_pk_bf16(v0[2], v0[3]); w.z = cvt_pk_bf16(v1[0], v1[1]); w.w = cvt_pk_bf16(v1[2], v1[3]);
                    *(u32x4*)(rowp + bj * HALF) = w; } }
    }
};
struct EpiResid {
    static constexpr bool PERM = false;
    float* hmain; float* htail;
    __device__ __forceinline__ void operator()(const f32x4 (&acc)[2][2][4][2], const Unit& u, int wr, int wc, int fr, int fq) const {
        float* base = (u.pm < TREAL / BM) ? hmain + (size_t)u.pm * BM * DM : htail;
        const int row0 = wr * 64 + fr, col0 = u.pn * BM + wc * 32 + 4 * fq;
#pragma unroll
        for (int ai = 0; ai < 2; ++ai)
#pragma unroll
            for (int m = 0; m < 4; ++m) { float* rowp = base + (size_t)(row0 + ai * HALF + m * 16) * DM + col0;
#pragma unroll
                for (int bj = 0; bj < 2; ++bj)
#pragma unroll
                    for (int n = 0; n < 2; ++n) { f32x4* p = (f32x4*)(rowp + bj * HALF + n * 16); *p = *p + acc[ai][bj][m][n]; }
                asm volatile("" ::: "memory"); }
    }
};
struct EpiSwiGLU {
    static constexpr bool PERM = true;
    bf16_t* O;
    __device__ __forceinline__ void operator()(const f32x4 (&acc)[2][2][4][2], const Unit& u, int wr, int wc, int fr, int fq) const {
        const int row0 = u.pm * BM + wr * 64 + fr, col0 = u.pn * HALF + wc * 32 + 8 * fq;
#pragma unroll
        for (int ai = 0; ai < 2; ++ai)
#pragma unroll
            for (int m = 0; m < 4; ++m) { bf16_t* rowp = O + (size_t)(row0 + ai * HALF + m * 16) * DFF + col0;
                float r[8];
#pragma unroll
                for (int n = 0; n < 2; ++n)
#pragma unroll
                    for (int e = 0; e < 4; ++e) { const float g = acc[ai][0][m][n][e], up = acc[ai][1][m][n][e];
                        r[n * 4 + e] = g * __builtin_amdgcn_rcpf(1.0f + __expf(-g)) * up; }
                u32x4 w; w.x = cvt_pk_bf16(r[0], r[1]); w.y = cvt_pk_bf16(r[2], r[3]); w.z = cvt_pk_bf16(r[4], r[5]); w.w = cvt_pk_bf16(r[6], r[7]);
                *(u32x4*)rowp = w; }
    }
};

struct SchedSplit {
    const bf16_t* A; const bf16_t* Bt; int nN, nK, K, ld, G, c;
    __device__ __forceinline__ bool next(int i, Unit& u) const {
        const long L = (long)i * G + c; if (L >= nN * nK) return false;
        const int pn = (int)L % nN, kc = (int)L / nN;
        u.pm = TREAL / BM; u.pn = pn; u.prob = 0;
        u.a = (const char*)(A + (size_t)u.pm * BM * ld + (size_t)kc * K); u.b = (const char*)(Bt + (size_t)pn * BM * ld + (size_t)kc * K);
        return true;
    }
};
struct EpiResidAtomic {
    static constexpr bool PERM = false;
    float* htail;
    __device__ __forceinline__ void operator()(const f32x4 (&acc)[2][2][4][2], const Unit& u, int wr, int wc, int fr, int fq) const {
        const int col0 = u.pn * BM + wc * 32 + 4 * fq;
#pragma unroll
        for (int m = 0; m < 4; ++m) { const int row = wr * 64 + m * 16 + fr;
            if (row < 96) { float* rowp = htail + (size_t)row * DM + col0;
#pragma unroll
                for (int bj = 0; bj < 2; ++bj)
#pragma unroll
                    for (int n = 0; n < 2; ++n)
#pragma unroll
                        for (int e = 0; e < 4; ++e) atomicAdd(rowp + bj * HALF + n * 16 + e, acc[0][bj][m][n][e]); } }
    }
};
template <class Epi, class Sched>
__device__ __forceinline__ void gemm_phase(const DP& p, LAS unsigned char* lds, const Sched& S, const Epi& E) {
    const int tid = p.tid, wid = __builtin_amdgcn_readfirstlane(tid >> 6), lane = tid & 63, wr = wid >> 2, wc = wid & 3, fr = lane & 15, fq = lane >> 4;
    const int K = S.ld, nt = S.K / BK;
    unsigned voffA[2], voffB[2];
#pragma unroll
    for (int i = 0; i < 2; ++i) { int R, C; stage_rc(tid * 16 + i * 8192, R, C); const int Rb = Epi::PERM ? ((R & ~31) + perm32(R & 31)) : R;
        voffA[i] = (unsigned)(R * K + C) * 2u; voffB[i] = (unsigned)(Rb * K + C) * 2u; }
    const size_t kstep = (size_t)(BK * 2);
    const size_t hstep = (size_t)HALF * K * 2;
    const unsigned ldsw = (unsigned)wid * 1024u;
    const int aoff = lds_byte(wr * 64 + fr, fq * 8), boff = lds_byte(wc * 32 + fr, fq * 8);
#define PG8_SA(b, h) (((b) * 2 + (h)) * HTB)
#define PG8_SB(b, h) ((4 + (b) * 2 + (h)) * HTB)
#define PG8_STAGE(bufoff, gbase, voff) do { _Pragma("unroll") for (int _i = 0; _i < 2; ++_i) \
        __builtin_amdgcn_global_load_lds((const unsigned*)((const char*)(gbase) + (voff)[_i]), (LAS unsigned*)(lds + (bufoff) + ldsw + _i * 8192), 16, 0, 0); } while (0)
#define PG8_LDA(dst, b, h) do { _Pragma("unroll") for (int m = 0; m < 4; ++m) _Pragma("unroll") for (int k = 0; k < 2; ++k) dst[m][k] = *(const LAS bf16x8*)(lds + PG8_SA(b, h) + aoff + m * 2048 + k * 1024); } while (0)
#define PG8_LDB(dst, b, h) do { _Pragma("unroll") for (int n = 0; n < 2; ++n) _Pragma("unroll") for (int k = 0; k < 2; ++k) dst[n][k] = *(const LAS bf16x8*)(lds + PG8_SB(b, h) + boff + n * 2048 + k * 1024); } while (0)
#define PG8_MMA(ai, bj, At, Bt) do { __builtin_amdgcn_s_setprio(1); _Pragma("unroll") for (int m = 0; m < 4; ++m) _Pragma("unroll") for (int n = 0; n < 2; ++n) _Pragma("unroll") for (int k = 0; k < 2; ++k) \
        acc[ai][bj][m][n] = __builtin_amdgcn_mfma_f32_16x16x32_bf16(Bt[n][k], At[m][k], acc[ai][bj][m][n], 0, 0, 0); __builtin_amdgcn_s_setprio(0); } while (0)
#define PG8_WAIT_V(n) asm volatile("s_waitcnt vmcnt(" #n ")" ::: "memory")
#define PG8_WAIT_L(n) asm volatile("s_waitcnt lgkmcnt(" #n ")" ::: "memory")
#define PG8_BAR __builtin_amdgcn_s_barrier()
#define PG8_SCHED __builtin_amdgcn_sched_barrier(0)
    Unit cur, nxt; int ui = 0;
    if (!S.next(0, cur)) return;
    f32x4 acc[2][2][4][2];
#pragma unroll
    for (int a = 0; a < 2; ++a)
#pragma unroll
        for (int b = 0; b < 2; ++b)
#pragma unroll
            for (int m = 0; m < 4; ++m)
#pragma unroll
                for (int n = 0; n < 2; ++n) acc[a][b][m][n] = (f32x4){0.f, 0.f, 0.f, 0.f};
    bf16x8 At[4][2], B0[2][2], B1[2][2];
    const char* cA = cur.a; const char* cB = cur.b;
    PG8_STAGE(PG8_SB(0, 0), cB, voffB); PG8_STAGE(PG8_SA(0, 0), cA, voffA); PG8_STAGE(PG8_SB(0, 1), cB + hstep, voffB); PG8_STAGE(PG8_SA(0, 1), cA + hstep, voffA);
    if (wr == 1) PG8_BAR;
    PG8_WAIT_V(4); PG8_BAR;
    PG8_STAGE(PG8_SB(1, 0), cB + kstep, voffB); PG8_STAGE(PG8_SA(1, 0), cA + kstep, voffA); PG8_STAGE(PG8_SB(1, 1), cB + hstep + kstep, voffB);
    PG8_WAIT_V(6); PG8_BAR;
    for (;;) {
        const bool has_next = S.next(ui + 1, nxt);
        const char* nA = has_next ? nxt.a : cA; const char* nB = has_next ? nxt.b : cB;
        for (int t = 0; t < nt; t += 2) {
            const bool last = (t == nt - 2);
            const char* a1 = cA + (size_t)(t + 1) * kstep;
            const char* a2 = last ? nA : cA + (size_t)(t + 2) * kstep; const char* b2 = last ? nB : cB + (size_t)(t + 2) * kstep;
            const char* a3 = a2 + kstep; const char* b3 = b2 + kstep;
            PG8_LDB(B0, 0, 0); PG8_SCHED; PG8_LDA(At, 0, 0); PG8_STAGE(PG8_SA(1, 1), a1 + hstep, voffA);
            PG8_WAIT_L(8); PG8_BAR; PG8_WAIT_L(0); PG8_MMA(0, 0, At, B0); PG8_BAR; PG8_SCHED;
            PG8_LDB(B1, 0, 1); PG8_STAGE(PG8_SB(0, 0), b2, voffB);
            PG8_BAR; PG8_WAIT_L(0); PG8_MMA(0, 1, At, B1); PG8_BAR;
            PG8_LDA(At, 0, 1); PG8_STAGE(PG8_SA(0, 0), a2, voffA);
            PG8_BAR; PG8_WAIT_L(0); PG8_MMA(1, 0, At, B0); PG8_BAR; PG8_SCHED;
            PG8_STAGE(PG8_SB(0, 1), b2 + hstep, voffB);
            PG8_WAIT_V(6); PG8_BAR; PG8_MMA(1, 1, At, B1); PG8_BAR;
            PG8_LDB(B0, 1, 0); PG8_SCHED; PG8_LDA(At, 1, 0); PG8_STAGE(PG8_SA(0, 1), a2 + hstep, voffA);
            PG8_WAIT_L(8); PG8_BAR; PG8_WAIT_L(0); PG8_MMA(0, 0, At, B0); PG8_BAR; PG8_SCHED;
            PG8_LDB(B1, 1, 1); PG8_STAGE(PG8_SB(1, 0), b3, voffB);
            PG8_BAR; PG8_WAIT_L(0); PG8_MMA(0, 1, At, B1); PG8_BAR;
            PG8_LDA(At, 1, 1); PG8_STAGE(PG8_SA(1, 0), a3, voffA);
            PG8_BAR; PG8_WAIT_L(0); PG8_MMA(1, 0, At, B0); PG8_BAR; PG8_SCHED;
            PG8_STAGE(PG8_SB(1, 1), b3 + hstep, voffB);
            PG8_WAIT_V(6); PG8_BAR; PG8_MMA(1, 1, At, B1); PG8_BAR;
        }
        E(acc, cur, wr, wc, fr, fq);
        if (!has_next) break;
#pragma unroll
        for (int a = 0; a < 2; ++a)
#pragma unroll
            for (int b = 0; b < 2; ++b)
#pragma unroll
                for (int m = 0; m < 4; ++m)
#pragma unroll
                    for (int n = 0; n < 2; ++n) acc[a][b][m][n] = (f32x4){0.f, 0.f, 0.f, 0.f};
        cur = nxt; cA = nA; cB = nB; ++ui;
    }
    PG8_WAIT_V(0);
    if (wr == 0) PG8_BAR;
    PG8_BAR;
#undef PG8_SA
#undef PG8_SB
#undef PG8_STAGE
#undef PG8_LDA
#undef PG8_LDB
#undef PG8_MMA
#undef PG8_WAIT_V
#undef PG8_WAIT_L
#undef PG8_BAR
#undef PG8_SCHED
}
}

__device__ __forceinline__ void norm_rows(const DP& p, int mode, const float* gain) {
    const int lane = p.tid & 63, gw = p.bid * 8 + (p.tid >> 6), nw = p.nb * 8;
    float* tail = (float*)(p.ws_() + WS_TAIL); bf16_t* hn = (bf16_t*)(p.ws_() + WS_XA);
    const int nrows = (mode == 2) ? TREAL : TP;
    f32x4 g[8];
#pragma unroll
    for (int j = 0; j < 8; ++j) g[j] = *(const f32x4*)(gain + 4 * (lane + 64 * j));
#define NR_SRC(rr) ((mode == 0) ? (((rr) < 16384) ? p.in_(0) + (size_t)(rr) * DM : ((rr) < TREAL) ? p.in_(1) + (size_t)((rr) - 16384) * DM : p.in_(2) + (size_t)(((rr) - TREAL) & 15) * DM) \
                                : (((rr) < TREAL) ? p.out_() + (size_t)(rr) * DM : tail + (size_t)((rr) - TREAL) * DM))
    f32x4 v[8], vn[8];
    if (gw < nrows && gw < TTOK) { const float* src = NR_SRC(gw);
#pragma unroll
        for (int j = 0; j < 8; ++j) v[j] = *(const f32x4*)(src + 4 * (lane + 64 * j)); }
    for (int r = gw; r < nrows; r += nw) {
        const int rn = r + nw;
        if (rn < nrows && rn < TTOK) { const float* srcn = NR_SRC(rn);
#pragma unroll
            for (int j = 0; j < 8; ++j) vn[j] = *(const f32x4*)(srcn + 4 * (lane + 64 * j)); }
        if (r >= TTOK) {
#pragma unroll
            for (int j = 0; j < 8; ++j) { *(u32x2*)(hn + (size_t)r * DM + 4 * (lane + 64 * j)) = (u32x2){0u, 0u};
                if (mode == 0) *(f32x4*)(tail + (size_t)(r - TREAL) * DM + 4 * (lane + 64 * j)) = (f32x4){0.f, 0.f, 0.f, 0.f}; }
        } else {
            float* hrow = (r < TREAL) ? p.out_() + (size_t)r * DM : tail + (size_t)(r - TREAL) * DM;
            float ss = 0.f;
#pragma unroll
            for (int j = 0; j < 8; ++j) ss += v[j][0] * v[j][0] + v[j][1] * v[j][1] + v[j][2] * v[j][2] + v[j][3] * v[j][3];
            ss = wave_sum(ss);
            const float rstd = 1.0f / sqrtf(ss * (1.0f / DM) + EPSN);
#pragma unroll
            for (int j = 0; j < 8; ++j) {
                const f32x4 o = v[j] * rstd * g[j];
                if (mode == 0) *(f32x4*)(hrow + 4 * (lane + 64 * j)) = v[j];
                if (mode == 2) *(f32x4*)(hrow + 4 * (lane + 64 * j)) = o;
                else { u32x2 w; w.x = cvt_pk_bf16(o[0], o[1]); w.y = cvt_pk_bf16(o[2], o[3]); *(u32x2*)(hn + (size_t)r * DM + 4 * (lane + 64 * j)) = w; }
            }
        }
#pragma unroll
        for (int j = 0; j < 8; ++j) v[j] = vn[j];
    }
#undef NR_SRC
}

__device__ __forceinline__ void transpose_cvt(const DP& p, LAS unsigned char* lds, const float* src, int K, int N, bf16_t* dst, int ldd, int koff, int mode) {
    LAS float* tile = (LAS float*)lds;
    const int tid = p.tid, nkt = K / 64, nnt = N / 64, ntile = nkt * nnt;
    for (int t0 = p.bid * 4; t0 < ntile; t0 += p.nb * 4) {
        f32x4 v[4][2];
#pragma unroll
        for (int u = 0; u < 4; ++u) { const int t = (t0 + u < ntile) ? t0 + u : ntile - 1; const int k0 = (t / nnt) * 64, n0 = (t % nnt) * 64;
#pragma unroll
            for (int it = 0; it < 2; ++it) { const int e = tid + it * 512, kk = e >> 4, n4 = e & 15; v[u][it] = *(const f32x4*)(src + (size_t)(k0 + kk) * N + n0 + 4 * n4); } }
#pragma unroll
        for (int u = 0; u < 4; ++u)
#pragma unroll
            for (int it = 0; it < 2; ++it) { const int e = tid + it * 512, kk = e >> 4, n4 = e & 15; LAS float* tp = tile + u * 4160 + kk * 65 + 4 * n4;
                tp[0] = v[u][it][0]; tp[1] = v[u][it][1]; tp[2] = v[u][it][2]; tp[3] = v[u][it][3]; }
        __syncthreads();
#pragma unroll
        for (int u = 0; u < 4; ++u) if (t0 + u < ntile) { const int t = t0 + u, k0 = (t / nnt) * 64, n0 = (t % nnt) * 64;
            const int nn = tid >> 3, k8 = tid & 7; float f[8];
#pragma unroll
            for (int j = 0; j < 8; ++j) f[j] = tile[u * 4160 + (8 * k8 + j) * 65 + nn];
            const int n = n0 + nn; const int drow = (mode == 0) ? n : ((n >> 7) * 256 + (n & 127) + (mode == 2 ? 128 : 0));
            u32x4 w; w.x = cvt_pk_bf16(f[0], f[1]); w.y = cvt_pk_bf16(f[2], f[3]); w.z = cvt_pk_bf16(f[4], f[5]); w.w = cvt_pk_bf16(f[6], f[7]);
            *(u32x4*)(dst + (size_t)drow * ldd + koff + k0 + 8 * k8) = w; }
        __syncthreads();
    }
}
__device__ __forceinline__ void fold_pool(const DP& p, const float* pw, const float* sc, const float* wo, bf16_t* dst) {
    const int tid = p.tid;
    for (int it = p.bid; it < 512; it += p.nb) {
        const int g = it >> 7, c8 = (it >> 2) & 31, n = (it & 3) * 512 + tid;
        float acc[8];
#pragma unroll
        for (int e = 0; e < 8; ++e) acc[e] = 0.f;
        const float* pwr = pw + (size_t)(g * 256 + c8 * 8) * 256;
        for (int d = 0; d < 256; ++d) {
            const float wv = wo[(size_t)(g * 256 + d) * DM + n] * sc[g * 256 + d];
#pragma unroll
            for (int e = 0; e < 8; ++e) acc[e] += pwr[e * 256 + d] * wv;
        }
        u32x4 w; w.x = cvt_pk_bf16(acc[0], acc[1]); w.y = cvt_pk_bf16(acc[2], acc[3]); w.z = cvt_pk_bf16(acc[4], acc[5]); w.w = cvt_pk_bf16(acc[6], acc[7]);
        *(u32x4*)(dst + (size_t)n * DM + g * 256 + c8 * 8) = w;
    }
}
__device__ __forceinline__ void prep_weights(const DP& p, LAS unsigned char* lds, int l) {
    transpose_cvt(p, lds, p.in_(4) + (size_t)l * DM * 4096, DM, 4096, (bf16_t*)(p.ws_() + WS_WIN), DM, 0, 0);
    transpose_cvt(p, lds, p.in_(18) + (size_t)l * DM * DM + (size_t)1024 * DM, 1024, DM, (bf16_t*)(p.ws_() + WS_WOUT), DM, 1024, 0);
    transpose_cvt(p, lds, p.in_(20) + (size_t)l * DM * DFF, DM, DFF, (bf16_t*)(p.ws_() + WS_WGU), DM, 0, 1);
    transpose_cvt(p, lds, p.in_(21) + (size_t)l * DM * DFF, DM, DFF, (bf16_t*)(p.ws_() + WS_WGU), DM, 0, 2);
    transpose_cvt(p, lds, p.in_(22) + (size_t)l * DFF * DM, DFF, DM, (bf16_t*)(p.ws_() + WS_WDN), DFF, 0, 0);
    fold_pool(p, p.in_(5) + (size_t)l * 4 * 256 * 256, p.in_(6) + (size_t)l * 1024, p.in_(18) + (size_t)l * DM * DM, (bf16_t*)(p.ws_() + WS_WOUT));
    { const float* w4 = p.in_(16) + (size_t)l * 64 * 4096; float* w4t = (float*)(p.ws_() + WS_W4T);
      for (int i = p.bid * NTHREADS + p.tid; i < 4096 * 64; i += p.nb * NTHREADS) w4t[i] = w4[(size_t)(i & 63) * 4096 + (i >> 6)]; }
}

__device__ __forceinline__ void mlp_layer(LAS float* hl, int lane, int nin, const float* w, const float* b, const float* fr) {
    float acc[64];
#pragma unroll
    for (int j = 0; j < 64; ++j) acc[j] = b[j];
#pragma unroll 1
    for (int i = 0; i < nin; ++i) {
        const float hv = hl[i * 64 + lane];
#pragma unroll
        for (int j = 0; j < 64; ++j) acc[j] += hv * w[i * 64 + j];
    }
#pragma unroll
    for (int j = 0; j < 64; ++j) hl[j * 64 + lane] = __sinf(fr[j] * acc[j]);
}
__device__ __forceinline__ void filter_h3(const DP& p, LAS unsigned char* lds, int l) {
    const int lane = p.tid & 63, wv = __builtin_amdgcn_readfirstlane(p.tid >> 6), gw = __builtin_amdgcn_readfirstlane(p.bid * 8 + (p.tid >> 6)), nw = p.nb * 8;
    const float* w1 = p.in_(9) + (size_t)l * 33 * 64; const float* b1 = p.in_(10) + l * 64;
    const float* w2 = p.in_(11) + (size_t)l * 64 * 64; const float* b2 = p.in_(12) + l * 64;
    const float* w3 = p.in_(13) + (size_t)l * 64 * 64; const float* b3 = p.in_(14) + l * 64;
    const float* fr = p.in_(15) + l * 64;
    float* h3 = (float*)(p.ws_() + WS_H3) + (size_t)l * (8208 + 4112) * 64;
    LAS float* hl = (LAS float*)lds + wv * 4096;
    int item0 = gw - l * (nw / 2); if (item0 < 0) item0 += nw;
    for (int item = item0; item < 129 + 65; item += nw) {
        const int tr = item < 129 ? 1 : 0, tile = tr ? item : item - 129, L = tr ? 8208 : 4112;
        const int n = tile * 64 + lane; const bool valid = n < L;
        const float nf = (float)n, t = nf / (float)(L - 1);
        hl[lane] = t;
#pragma unroll
        for (int b = 0; b < 16; ++b) { const float band = 1e-4f + (float)b * ((15.0f - 1e-4f) / 15.0f);
            const float ang = (6.283185307179586f / (float)L) * nf * band; hl[(1 + b) * 64 + lane] = __cosf(ang); hl[(17 + b) * 64 + lane] = -__sinf(ang); }
        mlp_layer(hl, lane, 33, w1, b1, fr);
        mlp_layer(hl, lane, 64, w2, b2, fr);
        mlp_layer(hl, lane, 64, w3, b3, fr);
        if (valid) { float* o = h3 + (size_t)((tr ? 0 : 8208) + n) * 64;
#pragma unroll
            for (int j = 0; j < 16; ++j) *(f32x4*)(o + 4 * j) = (f32x4){hl[(4 * j) * 64 + lane], hl[(4 * j + 1) * 64 + lane], hl[(4 * j + 2) * 64 + lane], hl[(4 * j + 3) * 64 + lane]}; }
    }
}
__device__ __forceinline__ bf16x8 cvt8(const f32x4 a, const f32x4 b) { u32x4 o; o.x = cvt_pk_bf16(a[0], a[1]); o.y = cvt_pk_bf16(a[2], a[3]); o.z = cvt_pk_bf16(b[0], b[1]); o.w = cvt_pk_bf16(b[2], b[3]); return __builtin_bit_cast(bf16x8, o); }
__device__ __forceinline__ void filter_gen(const DP& p, LAS unsigned char* lds, int l) {
    const int skipb = (p.nb == 256) ? 16 : 0;
    if (p.bid < skipb) return;
    const int lane = p.tid & 63, wv = __builtin_amdgcn_readfirstlane(p.tid >> 6), gw = __builtin_amdgcn_readfirstlane((p.bid - skipb) * 8 + (p.tid >> 6)), nw = (p.nb - skipb) * 8;
    const float* w4t = (const float*)(p.ws_() + WS_W4T); const float* h3 = (const float*)(p.ws_() + WS_H3) + (size_t)l * (8208 + 4112) * 64;
    const float* skip = p.in_(17) + (size_t)l * 2 * 1024;
    LAS bf16_t* S = (LAS bf16_t*)(lds + wv * 8448);
    const int col = lane & 31, hh = lane >> 5;
    constexpr int NS = 2 * 65 * 8, NPI = 2 * 33 * 8;
    for (int item = gw; item < NS + NPI; item += nw) {
        const int tr = item < NS ? 1 : 0, it2 = tr ? item : item - NS;
        const int L = tr ? 8208 : 4112, GL = 2 * L;
        const int part = it2 & 7, bd = it2 >> 3, dir = bd & 1, b = bd >> 1, o = part >> 2, ct0 = (part & 3) * 8;
        const int nbase = 128 * b + dir;
        const float invL1 = 1.0f / (float)(L - 1);
        bf16x8 A[4][4];
#pragma unroll
        for (int r = 0; r < 4; ++r) {
            int n = nbase + 32 * r + col; n = n < L ? n : L - 1;
            const float* hr = h3 + (size_t)((tr ? 0 : 8208) + n) * 64 + 8 * hh;
#pragma unroll
            for (int s4 = 0; s4 < 4; ++s4) A[r][s4] = cvt8(*(const f32x4*)(hr + 16 * s4), *(const f32x4*)(hr + 16 * s4 + 4));
        }
        bf16_t* gbase = (bf16_t*)(p.ws_() + (tr ? WS_GFS : WS_GFP)) + (size_t)o * 1024 * GL;
        const int ebase = dir ? L + 128 * b : L - 128 * b - 128;
#pragma unroll 1
        for (int ct = 0; ct < 8; ++ct) {
            const int c = (ct0 + ct) * 32 + col;
            const float* wr = w4t + (size_t)(o * 2048 + dir * 1024 + c) * 64 + 8 * hh;
            bf16x8 Bf[4];
#pragma unroll
            for (int s4 = 0; s4 < 4; ++s4) Bf[s4] = cvt8(*(const f32x4*)(wr + 16 * s4), *(const f32x4*)(wr + 16 * s4 + 4));
            const float d0 = -3.0701134573253946f, d1 = -15.350567286626973f;
            const float kc = -fabsf(d0 + (float)c * ((d1 - d0) / 1023.0f)) * 1.4426950408889634f;
            const float sk = skip[o * 1024 + c];
#pragma unroll
            for (int r = 0; r < 4; ++r) {
                f32x16 acc;
#pragma unroll
                for (int i = 0; i < 16; ++i) acc[i] = 0.f;
#pragma unroll
                for (int s4 = 0; s4 < 4; ++s4) acc = __builtin_amdgcn_mfma_f32_32x32x16_bf16(A[r][s4], Bf[s4], acc, 0, 0, 0);
#pragma unroll
                for (int q = 0; q < 4; ++q) {
                    const int nl0 = 32 * r + 8 * q + 4 * hh;
                    float v[4];
#pragma unroll
                    for (int e = 0; e < 4; ++e) { const int n = nbase + nl0 + e; const float t = (float)n * invL1;
                        v[e] = acc[4 * q + e] * __builtin_amdgcn_exp2f(t * kc); }
                    if (r == 0 && q == 0) v[0] += (nbase + nl0 == 0 && dir == 0) ? sk : 0.f;
                    u32x2 w;
                    if (dir) { w.x = cvt_pk_bf16(v[0], v[1]); w.y = cvt_pk_bf16(v[2], v[3]); *(LAS u32x2*)(S + col * 132 + nl0) = w; }
                    else     { w.x = cvt_pk_bf16(v[3], v[2]); w.y = cvt_pk_bf16(v[1], v[0]); *(LAS u32x2*)(S + col * 132 + 124 - nl0) = w; }
                }
            }
#pragma unroll
            for (int u = 0; u < 8; ++u) {
                const int id = u * 64 + lane, colr = id >> 4, k = id & 15;
                const u32x2 lo = *(const LAS u32x2*)(S + colr * 132 + 8 * k), hi = *(const LAS u32x2*)(S + colr * 132 + 8 * k + 4);
                const int e0 = ebase + 8 * k;
                if ((unsigned)e0 <= (unsigned)(GL - 8)) *(u32x4*)(gbase + (size_t)((ct0 + ct) * 32 + colr) * GL + e0) = (u32x4){lo.x, lo.y, hi.x, hi.y};
            }
        }
    }
}

__device__ __forceinline__ void pool_acc(float (&s)[8], const u32x4 v, float sg) {
    s[0] += sg * bflo(v.x); s[1] += sg * bfhi(v.x); s[2] += sg * bflo(v.y); s[3] += sg * bfhi(v.y); s[4] += sg * bflo(v.z); s[5] += sg * bfhi(v.z); s[6] += sg * bflo(v.w); s[7] += sg * bfhi(v.w);
}
__device__ __forceinline__ void pool_window(const DP& p, LAS unsigned char* lds) {
    const bf16_t* P = (const bf16_t*)(p.ws_() + WS_P); bf16_t* mix = (bf16_t*)(p.ws_() + WS_XA);
    LAS bf16_t* T = (LAS bf16_t*)lds;
    const int tid = p.tid;
    const int nitem = (4 * 65 + 2 * 129) * 4;
    for (int item = p.bid; item < nitem; item += p.nb) {
        const int g = item & 3, ch = item >> 2;
        int sq, r, L;
        if (ch < 4 * 65) { sq = ch / 65; r = ch - sq * 65; L = 4112; } else { const int c2 = ch - 4 * 65; sq = 4 + c2 / 129; r = c2 - (sq - 4) * 129; L = 8208; }
        const int hw = 1 << g, p0 = 64 * r, nrow = 64 + 2 * hw;
        for (int idx = tid; idx < nrow * 32; idx += NTHREADS) {
            const int j = idx >> 5, c8 = idx & 31, q = p0 - hw + j;
            u32x4 v = (u32x4){0u, 0u, 0u, 0u};
            if (q >= 0 && q < L) v = *(const u32x4*)(P + (size_t)seq_row(sq, q) * 1024 + g * 256 + 8 * c8);
            *(LAS u32x4*)(T + j * 264 + 8 * c8) = v;
        }
        __syncthreads();
        {
            const int c8 = tid & 31, run = tid >> 5, pb = p0 + 4 * run;
            if (pb < L) {
                float s[8];
#pragma unroll
                for (int e = 0; e < 8; ++e) s[e] = 0.f;
                for (int t = 0; t < 2 * hw; ++t) pool_acc(s, *(const LAS u32x4*)(T + (4 * run + t) * 264 + 8 * c8), 1.0f);
#pragma unroll
                for (int i = 0; i < 4; ++i) {
                    const int pp = pb + i;
                    const int lo = pp - hw < 0 ? 0 : pp - hw, hi = pp + hw > L ? L : pp + hw;
                    const float inv = 1.0f / (float)(hi - lo);
                    const u32x4 v = *(const LAS u32x4*)(T + (4 * run + i + hw) * 264 + 8 * c8);
                    u32x4 w;
                    w.x = cvt_pk_bf16(s[0] * inv - bflo(v.x), s[1] * inv - bfhi(v.x)); w.y = cvt_pk_bf16(s[2] * inv - bflo(v.y), s[3] * inv - bfhi(v.y));
                    w.z = cvt_pk_bf16(s[4] * inv - bflo(v.z), s[5] * inv - bfhi(v.z)); w.w = cvt_pk_bf16(s[6] * inv - bflo(v.w), s[7] * inv - bfhi(v.w));
                    if (pp < L) *(u32x4*)(mix + (size_t)seq_row(sq, pp) * DM + g * 256 + 8 * c8) = w;
                    if (i < 3) { pool_acc(s, *(const LAS u32x4*)(T + (4 * run + i + 2 * hw) * 264 + 8 * c8), 1.0f); pool_acc(s, *(const LAS u32x4*)(T + (4 * run + i) * 264 + 8 * c8), -1.0f); }
                }
            }
        }
        __syncthreads();
    }
}

constexpr int HYH_U = 0, HYH_FB = 35840, HYH_ZB = HYH_FB + 33280, HYH_RED = HYH_ZB + 512, HYH_SIZE = HYH_RED + 1024;
static_assert(2 * HYH_SIZE <= LDS_BYTES, "hyena LDS");
constexpr int FPAD = 176;
template <int TR> struct HG;
template <> struct HG<1> { static constexpr int L = 8208, B = 2, NSB = 16, BSE = 8720, NIN = 513, SQ0 = 4; };
template <> struct HG<0> { static constexpr int L = 4112, B = 4, NSB = 8,  BSE = 4416, NIN = 257, SQ0 = 0; };
__device__ __forceinline__ int uphys(int q) { return q + 8 * (q >> 7); }

struct ARaw { u32x2 w01, w23, w45; };
__device__ __forceinline__ ARaw hy_raw_a(const LAS unsigned char* p8) { ARaw r; r.w01 = *(const LAS u32x2*)p8; r.w23 = *(const LAS u32x2*)(p8 + 8); r.w45 = *(const LAS u32x2*)(p8 + 16); return r; }
__device__ __forceinline__ bf16x8 hy_fin_a(const ARaw& r, bool dsel, unsigned bsh) {
    const unsigned s0 = dsel ? r.w01.y : r.w01.x, s1 = dsel ? r.w23.x : r.w01.y, s2 = dsel ? r.w23.y : r.w23.x, s3 = dsel ? r.w45.x : r.w23.y, s4 = dsel ? r.w45.y : r.w45.x;
    u32x4 o; o.x = __builtin_amdgcn_alignbit(s1, s0, bsh); o.y = __builtin_amdgcn_alignbit(s2, s1, bsh); o.z = __builtin_amdgcn_alignbit(s3, s2, bsh); o.w = __builtin_amdgcn_alignbit(s4, s3, bsh);
    return __builtin_bit_cast(bf16x8, o);
}
template <int TR>
__device__ __forceinline__ void hy_conv(LAS unsigned char* hl, int wq, int lane, f32x16 (&acc)[4]) {
    typedef HG<TR> G;
    const LAS unsigned char* Ub = hl + HYH_U; const LAS unsigned char* FBb = hl + HYH_FB;
    asm volatile("" : "+v"(lane));
    const int n = lane & 31, h = lane >> 5;
    const int sbi = n % G::NSB, beta = n / G::NSB, sb0 = wq * G::NSB;
    const int abase = FPAD + (G::L - 1) - n + 8 * h;
    const int ab2 = 2 * abase, ab8 = ab2 & ~7; const bool dsel = (ab2 & 4) != 0; const unsigned bsh = (ab2 & 2) ? 16u : 0u;
    constexpr int KS = (G::L - 16) / 16 + 8 * (G::NSB - 1) + 1, NIT = (KS + 1) / 2, NOUT = (NIT + 3) / 4;
    const int dlo = 128 * sb0 - (G::L - 16);
    constexpr int MMAX = (G::L - 16) / 128;
#pragma unroll
    for (int r = 0; r < 4; ++r)
#pragma unroll
        for (int i = 0; i < 16; ++i) acc[r][i] = 0.f;
    bf16x8 qe[4], qo[4];
#pragma unroll
    for (int r = 0; r < 4; ++r) { qe[r] = hy_fin_a(hy_raw_a(FBb + (ab8 - 2 * (dlo + 32 * r))), dsel, bsh); qo[r] = hy_fin_a(hy_raw_a(FBb + (ab8 - 2 * (dlo + 16 + 32 * r))), dsel, bsh); }
    const int ub2 = 2 * (beta * G::BSE + 8 * h);
    int M = sbi + MMAX;
    const LAS unsigned char* zb = hl + HYH_ZB + 256;
#define HY_PB(MM, first) ({ const bool v_ = (first) ? ((unsigned)(MM) <= (unsigned)MMAX) : ((unsigned)((MM) - 1) < (unsigned)MMAX); v_ ? (Ub + ub2 + 272 * (MM)) : zb; })
    const LAS unsigned char* pb0 = HY_PB(M, true); const LAS unsigned char* pb1 = HY_PB(M, false);
    bf16x8 be = *(const LAS bf16x8*)pb0, bo = *(const LAS bf16x8*)(pb1 - 2 * (16 + 8));
    unsigned pa = (unsigned)(size_t)(FBb + (ab8 - 2 * (dlo + 128))) - 320u;
#define HY_DSR64(dst, addr, off)  asm volatile("ds_read_b64 %0, %1 offset:%2"  : "=v"(dst) : "v"(addr), "n"(off))
#define HY_DSR128(dst, addr, off) asm volatile("ds_read_b128 %0, %1 offset:%2" : "=v"(dst) : "v"(addr), "n"(off))
#pragma unroll 1
    for (int I = 0; I < NOUT; ++I) {
        const LAS unsigned char* pn0 = HY_PB(M - 1, true); const LAS unsigned char* pn1 = HY_PB(M - 1, false);
        const unsigned b1a = (unsigned)(size_t)pb1 - 256u, n0a = (unsigned)(size_t)pn0, n1a = (unsigned)(size_t)pn1 - 256u;
#pragma unroll
        for (int j = 0; j < 4; ++j) {
            ARaw ra, rb; bf16x8 nbe, nbo;
            HY_DSR64(ra.w01, pa, 320 - 64 * j);      HY_DSR64(ra.w23, pa, 320 - 64 * j + 8);      HY_DSR64(ra.w45, pa, 320 - 64 * j + 16);
            HY_DSR64(rb.w01, pa, 320 - 64 * j - 32); HY_DSR64(rb.w23, pa, 320 - 64 * j - 32 + 8); HY_DSR64(rb.w45, pa, 320 - 64 * j - 32 + 16);
            if (j < 3) { HY_DSR128(nbe, b1a, 256 - 2 * (32 * (j + 1) + 8)); HY_DSR128(nbo, b1a, 256 - 2 * (32 * (j + 1) + 16 + 8)); }
            else       { HY_DSR128(nbe, n0a, 0);                            HY_DSR128(nbo, n1a, 256 - 2 * (16 + 8)); }
#pragma unroll
            for (int r = 0; r < 4; ++r) acc[r] = __builtin_amdgcn_mfma_f32_32x32x16_bf16(qe[(j + r) & 3], be, acc[r], 0, 0, 0);
#pragma unroll
            for (int r = 0; r < 4; ++r) acc[r] = __builtin_amdgcn_mfma_f32_32x32x16_bf16(qo[(j + r) & 3], bo, acc[r], 0, 0, 0);
            asm volatile("s_waitcnt lgkmcnt(0)" : "+v"(ra.w01), "+v"(ra.w23), "+v"(ra.w45), "+v"(rb.w01), "+v"(rb.w23), "+v"(rb.w45), "+v"(nbe), "+v"(nbo), "+v"(acc[0]), "+v"(acc[1]), "+v"(acc[2]), "+v"(acc[3]));
            qe[j] = hy_fin_a(ra, dsel, bsh); qo[j] = hy_fin_a(rb, dsel, bsh);
            be = nbe; bo = nbo;
        }
        pa -= 256u; pb0 = pn0; pb1 = pn1; --M;
    }
#undef HY_DSR64
#undef HY_DSR128
#undef HY_PB
    {
        f32x16 at;
#pragma unroll
        for (int i = 0; i < 16; ++i) at[i] = 0.f;
        constexpr int MS = (G::NIN + 3) / 4;
        const int m0 = wq * MS, m1 = (m0 + MS < G::NIN) ? m0 + MS : G::NIN;
        const bool colv = n < G::B;
        const int ut2 = 2 * ((colv ? n : 0) * G::BSE + 8 * h);
#pragma unroll 4
        for (int m = m0; m < m1; ++m) {
            const int d = (G::L - 16) - 16 * m;
            const bf16x8 a = hy_fin_a(hy_raw_a(FBb + (ab8 - 2 * d)), dsel, bsh);
            const bf16x8 b = *(const LAS bf16x8*)(colv ? Ub + ut2 + 2 * (16 * m + 8 * ((16 * m) >> 7)) : zb);
            at = __builtin_amdgcn_mfma_f32_32x32x16_bf16(a, b, at, 0, 0, 0);
        }
        LAS float* RED = (LAS float*)(hl + HYH_RED);
        if (colv) {
#pragma unroll
            for (int i = 0; i < 8; ++i) { const int arow = (i & 3) + 8 * (i >> 2) + 4 * h; RED[(wq * 16 + arow) * 4 + n] = at[i]; }
        }
    }
}
template <int TR>
__device__ __forceinline__ void hy_load_stream(const DP& p, LAS unsigned char* hl, int lt, int l, int k, int c, bool toU) {
    typedef HG<TR> G;
    asm volatile("" : "+v"(lt));
    const int ch = k * 1024 + c;
    const float* cw = p.in_(7) + (size_t)l * 3 * 3072; const float* cb = p.in_(8) + (size_t)l * 3072;
    const float w0 = cw[ch], w1 = cw[3072 + ch], w2 = cw[2 * 3072 + ch], bb = cb[ch];
    const bf16_t* src = (const bf16_t*)(p.ws_() + WS_UT) + (size_t)ch * TP;
    LAS bf16_t* U = (LAS bf16_t*)(hl + HYH_U); LAS bf16_t* X = (LAS bf16_t*)(hl + HYH_FB);
    constexpr int nch = G::L / 8, NCH = G::B * nch, NI = (NCH + 255) / 256;
    constexpr int GB = 3;
#pragma unroll
    for (int g0 = 0; g0 < NI; g0 += GB) {
        u32x4 v[GB]; unsigned short xl[GB], xr[GB];
#pragma unroll
        for (int i = 0; i < GB; ++i) {
            int idx = lt + 256 * (g0 + i); idx = idx < NCH ? idx : NCH - 1;
            const int b = idx / nch, q = idx - b * nch, p0 = 8 * q, sq = G::SQ0 + b;
            const int moff = TREAL + 16 * sq, roff = seq_rbase(sq);
            const int off = p0 < 16 ? moff + p0 : roff + p0 - 16;
            v[i] = *(const u32x4*)(src + off);
            xl[i] = src[p0 == 0 ? off : (p0 == 16 ? moff + 15 : off - 1)];
            xr[i] = src[p0 + 8 >= G::L ? off : (p0 + 8 == 16 ? roff : off + 8)];
        }
#pragma unroll
        for (int i = 0; i < GB; ++i) {
            const int idx = lt + 256 * (g0 + i);
            if (g0 + i < NI && idx < NCH) {
                const int b = idx / nch, q = idx - b * nch, p0 = 8 * q;
                float x[10];
                x[0] = (p0 == 0) ? 0.f : bf2f(xl[i]);
                x[9] = (p0 + 8 >= G::L) ? 0.f : bf2f(xr[i]);
                x[1] = bflo(v[i].x); x[2] = bfhi(v[i].x); x[3] = bflo(v[i].y); x[4] = bfhi(v[i].y); x[5] = bflo(v[i].z); x[6] = bfhi(v[i].z); x[7] = bflo(v[i].w); x[8] = bfhi(v[i].w);
                float y[8];
#pragma unroll
                for (int j = 0; j < 8; ++j) y[j] = w0 * x[j] + w1 * x[j + 1] + w2 * x[j + 2] + bb;
                u32x4 w; w.x = cvt_pk_bf16(y[0], y[1]); w.y = cvt_pk_bf16(y[2], y[3]); w.z = cvt_pk_bf16(y[4], y[5]); w.w = cvt_pk_bf16(y[6], y[7]);
                LAS bf16_t* dst = toU ? U + b * G::BSE + uphys(p0) : X + b * G::L + p0;
                *(LAS u32x4*)dst = w;
            }
        }
    }
}
template <int TR>
__device__ __forceinline__ void hy_load_filter(const DP& p, LAS unsigned char* hl, int lt, int o, int c) {
    typedef HG<TR> G;
    constexpr int GL = 2 * G::L, NCH = GL / 8, NI = (NCH + 255) / 256;
    asm volatile("" : "+v"(lt));
    const bf16_t* gf = (const bf16_t*)(p.ws_() + (TR ? WS_GFS : WS_GFP)) + ((size_t)o * 1024 + c) * GL;
    LAS bf16_t* FB = (LAS bf16_t*)(hl + HYH_FB);
    u32x4 v[NI];
#pragma unroll
    for (int i = 0; i < NI; ++i) { int idx = lt + 256 * i; idx = idx < NCH ? idx : NCH - 1; v[i] = *(const u32x4*)(gf + 8 * idx); }
    if (lt < FPAD / 8) *(LAS u32x4*)(FB + 8 * lt) = (u32x4){0u, 0u, 0u, 0u};
#pragma unroll
    for (int i = 0; i < NI; ++i) { const int idx = lt + 256 * i; if (idx < NCH) *(LAS u32x4*)(FB + FPAD + 8 * idx) = v[i]; }
}
template <int TR>
__device__ __forceinline__ void hy_items(const DP& p, LAS unsigned char* lds, int l, int vcu) {
    typedef HG<TR> G;
    const int tid = p.tid, lane = tid & 63, wave = __builtin_amdgcn_readfirstlane(tid >> 6), hf = wave >> 2, wq = wave & 3, lt = tid & 255;
    LAS unsigned char* hl = lds + hf * HYH_SIZE;
    LAS bf16_t* U = (LAS bf16_t*)(hl + HYH_U); const LAS bf16_t* X = (const LAS bf16_t*)(hl + HYH_FB); const LAS float* RED = (const LAS float*)(hl + HYH_RED);
    bf16_t* UT = (bf16_t*)(p.ws_() + WS_UT);
    for (int pit = vcu; pit < 512; pit += p.nb) {
        const int c = 2 * pit + hf;
        if (lt < 32) *(LAS u32x4*)(hl + HYH_ZB + 16 * lt) = (u32x4){0u, 0u, 0u, 0u};
        hy_load_stream<TR>(p, hl, lt, l, 0, c, true);
        hy_load_filter<TR>(p, hl, lt, 0, c);
        __syncthreads();
        f32x16 acc[4];
#pragma unroll 1
        for (int rep = 0; rep < HYREP; ++rep) { hy_conv<TR>(hl, wq, lane, acc); asm volatile("" ::: "memory"); }
        __syncthreads();
        hy_load_stream<TR>(p, hl, lt, l, 1, c, false);
        __syncthreads();
        { int ln = lane; asm volatile("" : "+v"(ln)); const int n = ln & 31, hh = ln >> 5, sbi = n % G::NSB, beta = n / G::NSB, sb = wq * G::NSB + sbi;
#pragma unroll
        for (int r = 0; r < 4; ++r)
#pragma unroll
            for (int qd = 0; qd < 4; ++qd) {
                const int t0 = 128 * sb + 32 * r + 8 * qd + 4 * hh;
                const u32x2 xv = *(const LAS u32x2*)(X + beta * G::L + t0);
                u32x2 w; w.x = cvt_pk_bf16(bflo(xv.x) * acc[r][4 * qd], bfhi(xv.x) * acc[r][4 * qd + 1]); w.y = cvt_pk_bf16(bflo(xv.y) * acc[r][4 * qd + 2], bfhi(xv.y) * acc[r][4 * qd + 3]);
                *(LAS u32x2*)(U + beta * G::BSE + uphys(t0)) = w;
            }
        }
        if (lt < 16 * G::B) { const int a = lt & 15, b = lt >> 4; float y = 0.f;
#pragma unroll
            for (int w = 0; w < 4; ++w) y += RED[(w * 16 + a) * 4 + b];
            const int t = (G::L - 16) + a;
            U[b * G::BSE + uphys(t)] = f2bf(bf2f(X[b * G::L + t]) * y); }
        __syncthreads();
        hy_load_filter<TR>(p, hl, lt, 1, c);
        __syncthreads();
        hy_conv<TR>(hl, wq, lane, acc);
        __syncthreads();
        hy_load_stream<TR>(p, hl, lt, l, 2, c, false);
        __syncthreads();
        bf16_t* orow = UT + (size_t)c * TP;
        { int ln = lane; asm volatile("" : "+v"(ln)); const int n = ln & 31, hh = ln >> 5, sbi = n % G::NSB, beta = n / G::NSB, sb = wq * G::NSB + sbi;
#pragma unroll
        for (int r = 0; r < 4; ++r)
#pragma unroll
            for (int qd = 0; qd < 4; ++qd) {
                const int t0 = 128 * sb + 32 * r + 8 * qd + 4 * hh;
                const u32x2 xv = *(const LAS u32x2*)(X + beta * G::L + t0);
                u32x2 w; w.x = cvt_pk_bf16(bflo(xv.x) * acc[r][4 * qd], bfhi(xv.x) * acc[r][4 * qd + 1]); w.y = cvt_pk_bf16(bflo(xv.y) * acc[r][4 * qd + 2], bfhi(xv.y) * acc[r][4 * qd + 3]);
                *(u32x2*)(orow + seq_row(G::SQ0 + beta, t0)) = w;
            }
        }
        if (lt < 16 * G::B) { const int a = lt & 15, b = lt >> 4; float y = 0.f;
#pragma unroll
            for (int w = 0; w < 4; ++w) y += RED[(w * 16 + a) * 4 + b];
            const int t = (G::L - 16) + a;
            orow[seq_row(G::SQ0 + b, t)] = f2bf(bf2f(X[b * G::L + t]) * y); }
        __syncthreads();
    }
}
__device__ __forceinline__ void hyena_phase(const DP& p, LAS unsigned char* lds, int l) {
    const int Gd = p.nb, bx = p.bid;
    const int vcu = (Gd % 8 == 0) ? (bx % 8) * (Gd / 8) + bx / 8 : bx;
    hy_items<1>(p, lds, l, vcu);
    hy_items<0>(p, lds, l, vcu);
}
__device__ __forceinline__ void hyena_transpose(const DP& p, LAS unsigned char* lds) {
    const bf16_t* UT = (const bf16_t*)(p.ws_() + WS_UT); bf16_t* mix = (bf16_t*)(p.ws_() + WS_XA);
    LAS bf16_t* tile = (LAS bf16_t*)lds;
    const int tid = p.tid, ntile = 16 * (TP / 64);
    for (int t0 = p.bid * 4; t0 < ntile; t0 += p.nb * 4) {
        u32x4 v[4];
#pragma unroll
        for (int u = 0; u < 4; ++u) { const int t = (t0 + u < ntile) ? t0 + u : ntile - 1; const int c0 = (t & 15) * 64, tk0 = (t >> 4) * 64, cc = tid >> 3, t8 = tid & 7;
            v[u] = *(const u32x4*)(UT + (size_t)(c0 + cc) * TP + tk0 + 8 * t8); }
#pragma unroll
        for (int u = 0; u < 4; ++u) { const int cc = tid >> 3, t8 = tid & 7; *(LAS u32x4*)(tile + u * 4608 + cc * 72 + 8 * t8) = v[u]; }
        __syncthreads();
#pragma unroll
        for (int u = 0; u < 4; ++u) if (t0 + u < ntile) { const int t = t0 + u, c0 = (t & 15) * 64, tk0 = (t >> 4) * 64;
            const int tt = tid >> 3, c8 = tid & 7; unsigned w[4];
#pragma unroll
            for (int j = 0; j < 4; ++j) w[j] = (unsigned)tile[u * 4608 + (8 * c8 + 2 * j) * 72 + tt] | ((unsigned)tile[u * 4608 + (8 * c8 + 2 * j + 1) * 72 + tt] << 16);
            *(u32x4*)(mix + (size_t)(tk0 + tt) * DM + 1024 + c0 + 8 * c8) = (u32x4){w[0], w[1], w[2], w[3]}; }
        __syncthreads();
    }
}

#define XB_TMO      128
#define XB_XCNT(j)  (256  + 64 * (j))
#define XB_XSUB(j)  (1280 + 64 * (j))
#define XB_XGEN(j)  (2304 + 64 * (j))
#define XB_TOP      3328
#define XB_TOPGEN   3392
#define XCD_BAR_WORDS 3456
#define XB_SPIN_CAP (1u << 18)
__device__ __forceinline__ unsigned xb_ld(unsigned* p)              { return __hip_atomic_load(p, __ATOMIC_RELAXED, __HIP_MEMORY_SCOPE_AGENT); }
__device__ __forceinline__ unsigned xb_add(unsigned* p, unsigned v) { return __hip_atomic_fetch_add(p, v, __ATOMIC_RELAXED, __HIP_MEMORY_SCOPE_AGENT); }
__device__ __forceinline__ unsigned xb_xcc_id() { return (unsigned)__builtin_amdgcn_s_getreg((3 << 11) | 20) & 0xFu; }
#define XB_SPIN(cond, bar) do { unsigned _sp = 0; while (cond) { __builtin_amdgcn_s_sleep(1); \
    if ((++_sp & 255u) == 0u) { if (xb_ld(&(bar)[XB_TMO])) break; if (_sp > XB_SPIN_CAP) { atomicAdd(&(bar)[XB_TMO], 1u); break; } } } } while (0)
__device__ __forceinline__ void xcd_barrier_complete(unsigned* bar, unsigned x, unsigned G, unsigned& nloc, unsigned& nx) {
    unsigned sum, cnt, mine, sp = 0u;
    for (;;) {
        sum = 0u; cnt = 0u; mine = 0u;
#pragma unroll
        for (unsigned j = 0; j < 16; ++j) { const unsigned c = xb_ld(&bar[XB_XCNT(j)]); sum += c; cnt += (c > 0u) ? 1u : 0u; mine = (j == x) ? c : mine; }
        if (sum == G) break;
        __builtin_amdgcn_s_sleep(1);
        if ((++sp & 255u) == 0u) { if (xb_ld(&bar[XB_TMO])) break; if (sp > XB_SPIN_CAP) { atomicAdd(&bar[XB_TMO], 1u); break; } }
    }
    nloc = mine > 0u ? mine : 1u; nx = cnt > 0u ? cnt : 1u;
}
__device__ __forceinline__ void xcd_barrier(unsigned* bar, unsigned x, volatile LAS unsigned* st, unsigned G, int tid) {
    asm volatile("s_waitcnt vmcnt(0)" ::: "memory");
    __syncthreads();
    if (tid == 0) {
        __builtin_amdgcn_s_waitcnt(0);
        unsigned nloc = st[0], nx = st[1];
        if (nloc == 0u) { xcd_barrier_complete(bar, x, G, nloc, nx); st[0] = nloc; st[1] = nx; }
        const unsigned old = xb_add(&bar[XB_XSUB(x)], 1u);
        const unsigned gen = old / nloc;
        if (old + 1u == (gen + 1u) * nloc) {
            __builtin_amdgcn_fence(__ATOMIC_RELEASE, "agent");
            asm volatile("s_waitcnt vmcnt(0)" ::: "memory");
            const unsigned og = xb_add(&bar[XB_TOP], 1u);
            const unsigned tg = og / nx;
            if (og + 1u == (tg + 1u) * nx) xb_add(&bar[XB_TOPGEN], 1u);
            else XB_SPIN(xb_ld(&bar[XB_TOPGEN]) == tg, bar);
            __builtin_amdgcn_fence(__ATOMIC_ACQUIRE, "agent");
            xb_add(&bar[XB_XGEN(x)], 1u);
            asm volatile("s_waitcnt vmcnt(0)" ::: "memory");
        } else {
            XB_SPIN(xb_ld(&bar[XB_XGEN(x)]) == gen, bar);
            __builtin_amdgcn_fence(__ATOMIC_ACQUIRE, "agent");
            asm volatile("s_waitcnt vmcnt(0)" ::: "memory");
        }
    }
    __syncthreads();
}

constexpr int NPHASES = 17;
__device__ __forceinline__ void run_phase(const DP& p, LAS unsigned char* lds, int ph) {
    const int l = (ph == 0) ? 0 : (ph - 1) / 8, jj = (ph - 1) % 8, k = (ph == 0) ? 0 : (jj < 2 ? jj + 1 : (jj == 2 ? 8 : jj));
    const int G = p.nb, cbx = p.bid;
    bf16_t* XA = (bf16_t*)(p.ws_() + WS_XA);
    switch (k) {
#if (PHMASK >> 0) & 1
    case 0: {
#if SUB & 1
        norm_rows(p, 0, p.in_(3));
#endif
#if SUB & 2
        prep_weights(p, lds, 0);
#endif
#if SUB & 4
        __syncthreads(); filter_h3(p, lds, 0); filter_h3(p, lds, 1);
#endif
    } break;
#endif
#if (PHMASK >> 1) & 1
    case 1: {
        pg8::Prob p0{XA, (const bf16_t*)(p.ws_() + WS_WIN), TP / 256, 4};
        pg8::Prob p1{(const bf16_t*)(p.ws_() + WS_WIN) + (size_t)1024 * DM, XA, 12, TP / 256};
        pg8::Sched2 S; S.init(p0, p1, DM, G, cbx);
        pg8::EpiStore E{{(bf16_t*)(p.ws_() + WS_P), (bf16_t*)(p.ws_() + WS_UT)}, {1024, TP}};
#ifndef NOG1
        pg8::gemm_phase<pg8::EpiStore, pg8::Sched2>(p, lds, S, E);
#endif
#ifndef NOFG
        { DP p2 = p; asm volatile("" : "+v"(p2.tid));
          __syncthreads(); filter_gen(p2, lds, l); }
#endif
    } break;
#endif
#if (PHMASK >> 2) & 1
    case 2: {
#ifndef NOHY
        hyena_phase(p, lds, l);
#endif
#ifndef NOPOOL
        __syncthreads(); pool_window(p, lds);
#endif
    } break;
#endif
#if (PHMASK >> 8) & 1
    case 8: hyena_transpose(p, lds); break;
#endif
#if (PHMASK >> 3) & 1
    case 3: {
        pg8::Prob p0{XA, (const bf16_t*)(p.ws_() + WS_WOUT), TREAL / 256, DM / 256};
        pg8::Prob p1{XA, XA, 0, 0};
        pg8::Sched2 S; S.init(p0, p1, DM, G, cbx);
        pg8::EpiResid E{p.out_(), (float*)(p.ws_() + WS_TAIL)};
        pg8::gemm_phase<pg8::EpiResid, pg8::Sched2>(p, lds, S, E);
        if (l == 0) {
            pg8::SchedSplit S2{XA, (const bf16_t*)(p.ws_() + WS_WOUT), DM / 256, 8, 256, DM, G, cbx};
            pg8::EpiResidAtomic E2{(float*)(p.ws_() + WS_TAIL)};
            DP p2 = p; asm volatile("" : "+v"(p2.tid));
            pg8::gemm_phase<pg8::EpiResidAtomic, pg8::SchedSplit>(p2, lds, S2, E2);
        }
    } break;
#endif
#if (PHMASK >> 4) & 1
    case 4: norm_rows(p, 1, p.in_(19) + (size_t)l * DM); break;
#endif
#if (PHMASK >> 5) & 1
    case 5: {
        pg8::Prob p0{XA, (const bf16_t*)(p.ws_() + WS_WGU), l == 0 ? TP / 256 : TREAL / 256, 2 * DFF / 256};
        pg8::Prob p1{XA, XA, 0, 0};
        pg8::Sched2 S; S.init(p0, p1, DM, G, cbx);
        pg8::EpiSwiGLU E{(bf16_t*)(p.ws_() + WS_HID)};
        pg8::gemm_phase<pg8::EpiSwiGLU, pg8::Sched2>(p, lds, S, E);
    } break;
#endif
#if (PHMASK >> 6) & 1
    case 6: {
        pg8::Prob p0{(const bf16_t*)(p.ws_() + WS_HID), (const bf16_t*)(p.ws_() + WS_WDN), TREAL / 256, DM / 256};
        pg8::Prob p1{XA, XA, 0, 0};
        pg8::Sched2 S; S.init(p0, p1, DFF, G, cbx);
        pg8::EpiResid E{p.out_(), (float*)(p.ws_() + WS_TAIL)};
        pg8::gemm_phase<pg8::EpiResid, pg8::Sched2>(p, lds, S, E);
        if (l == 0) {
            pg8::SchedSplit S2{(const bf16_t*)(p.ws_() + WS_HID), (const bf16_t*)(p.ws_() + WS_WDN), DM / 256, 11, 512, DFF, G, cbx};
            pg8::EpiResidAtomic E2{(float*)(p.ws_() + WS_TAIL)};
            DP p2 = p; asm volatile("" : "+v"(p2.tid));
            pg8::gemm_phase<pg8::EpiResidAtomic, pg8::SchedSplit>(p2, lds, S2, E2);
        }
    } break;
#endif
#if (PHMASK >> 7) & 1
    case 7: {
        if (l == 0) { norm_rows(p, 1, p.in_(3) + DM); prep_weights(p, lds, 1); }
        else norm_rows(p, 2, p.in_(23));
    } break;
#endif
    }
}

__global__ void __launch_bounds__(NTHREADS, 2) mega_fwd(Params pk, int ph_lo, int ph_hi) {
    DP p;
    extern __shared__ __attribute__((aligned(16))) unsigned char lds_raw[];
    LAS unsigned char* lds = (LAS unsigned char*)lds_raw;
    cg::grid_group grid = cg::this_grid();
    volatile LAS unsigned* xst = (volatile LAS unsigned*)(lds + (LDS_BYTES - 16));
    if (threadIdx.x == 0) { xst[0] = 0u; xst[1] = 0u; }
    __syncthreads();
    unsigned* xbar = (unsigned*)(pk.ws + WS_BAR);
    const unsigned xcc = xb_xcc_id();
    if (threadIdx.x == 0) (void)xb_add(&xbar[XB_XCNT(xcc)], 1u);
    const int wave_s = __builtin_amdgcn_readfirstlane(threadIdx.x >> 6);
    for (int ph = ph_lo; ph < ph_hi; ++ph) {
        { kseg_t ks = (kseg_t)__builtin_amdgcn_kernarg_segment_ptr(); unsigned z0 = 0u; asm volatile("" : "+s"(z0));
          int t = wave_s * 64 + (int)__builtin_amdgcn_mbcnt_hi(~0u, __builtin_amdgcn_mbcnt_lo(~0u, z0)), b = blockIdx.x, n = gridDim.x;
          asm volatile("" : "+s"(ks), "+v"(t), "+s"(b), "+s"(n));
          p.ks = ks; p.tid = t; p.bid = b; p.nb = n; }
        run_phase(p, lds, ph);
#if REPMASK
        { const int j2 = (ph - 1) % 8, kk = (ph == 0) ? 0 : (j2 < 2 ? j2 + 1 : (j2 == 2 ? 8 : j2));
          if (((REPMASK >> kk) & 1) && ph != 16) { grid.sync(); run_phase(p, lds, ph); } }
#endif
        if (ph + 1 < ph_hi) {
            if (ph == ph_lo) grid.sync();
            else xcd_barrier(xbar, xcc, xst, gridDim.x, p.tid);
        }
    }
}

extern "C" void kernel_launch(void* const* d_in, const int* in_sizes, int n_in, void* d_out, int out_size, void* d_ws, size_t ws_size, hipStream_t stream) {
    static int grid = 0;
    if (grid == 0) {
        if (n_in != 24 || ws_size < WS_END) { fprintf(stderr, "kernel_launch: need 24 inputs and %zu bytes of workspace (got %d, %zu)\n", (size_t)WS_END, n_in, ws_size); grid = -1; return; }
        int dev = 0, cus = 0, per_cu = 0;
        hipGetDevice(&dev);
        hipDeviceGetAttribute(&cus, hipDeviceAttributeMultiprocessorCount, dev);
        if (hipFuncSetAttribute((const void*)mega_fwd, hipFuncAttributeMaxDynamicSharedMemorySize, LDS_BYTES) != hipSuccess) { fprintf(stderr, "hipFuncSetAttribute failed\n"); grid = -1; return; }
        hipOccupancyMaxActiveBlocksPerMultiprocessor(&per_cu, (const void*)mega_fwd, NTHREADS, LDS_BYTES);
        if (per_cu < 1) per_cu = 1;
        (void)hipGetLastError();
        grid = cus;
    }
    if (grid < 0) return;
    Params p{};
    for (int i = 0; i < 24; ++i) p.in[i] = (const float*)d_in[i];
    p.out = (float*)d_out; p.ws = (unsigned char*)d_ws;
#if MEGA
    (void)hipMemsetAsync((char*)d_ws + WS_BAR, 0, 16384, stream);
    int lo = 0, hi = NPHASES;
    void* args[] = {&p, &lo, &hi};
    hipError_t e = hipLaunchCooperativeKernel((const void*)mega_fwd, dim3(grid), dim3(NTHREADS), args, LDS_BYTES, stream);
    if (e != hipSuccess) fprintf(stderr, "cooperative launch failed: %s (grid %d)\n", hipGetErrorString(e), grid);
#else
    for (int ph = 0; ph < NPHASES; ++ph) hipLaunchKernelGGL(mega_fwd, dim3(grid), dim3(NTHREADS), LDS_BYTES, stream, p, ph, ph + 1);
#endif
}
```

```cpp
#include <hip/hip_runtime.h>
#include <hip/hip_cooperative_groups.h>
#include <cstdio>
namespace cg = cooperative_groups;

#ifndef PHMASK
#define PHMASK 511
#endif
#ifndef SUB
#define SUB 7
#endif
#ifndef REPMASK
#define REPMASK 0
#endif
#ifndef HYREP
#define HYREP 1
#endif
#ifndef MEGA
#define MEGA 1
#endif

#define LAS __attribute__((address_space(3)))
typedef unsigned short bf16_t;
typedef short bf16x8 __attribute__((ext_vector_type(8)));
typedef float f32x4 __attribute__((ext_vector_type(4)));
typedef float f32x16 __attribute__((ext_vector_type(16)));
typedef unsigned u32x4 __attribute__((ext_vector_type(4)));
typedef unsigned u32x2 __attribute__((ext_vector_type(2)));

constexpr int DM = 2048, TREAL = 32768, TTOK = 32864, TP = 33024, DFF = 5632;
constexpr int NTHREADS = 512;
constexpr int LDS_BYTES = 147456;
constexpr float EPSN = 1e-6f;

constexpr size_t WS_TAIL = 0;
constexpr size_t WS_XA   = WS_TAIL + (size_t)256 * DM * 4;
constexpr size_t WS_WIN  = WS_XA + (size_t)TP * DM * 2;
constexpr size_t WS_WOUT = WS_WIN + (size_t)4096 * DM * 2;
constexpr size_t WS_WGU  = WS_WOUT + (size_t)DM * DM * 2;
constexpr size_t WS_WDN  = WS_WGU + (size_t)2 * DFF * DM * 2;
constexpr size_t WS_H3   = WS_WDN + (size_t)DM * DFF * 2;
constexpr size_t WS_W4T  = WS_H3 + (size_t)2 * (8208 + 4112) * 64 * 4;
constexpr size_t WS_BIG  = WS_W4T + (size_t)4096 * 64 * 4;
constexpr size_t WS_P    = WS_BIG;
constexpr size_t WS_UT   = WS_P + (size_t)TP * 1024 * 2;
constexpr size_t WS_GFS  = WS_UT + (size_t)3072 * TP * 2;
constexpr size_t WS_GFP  = WS_GFS + (size_t)2048 * 16416 * 2;
constexpr size_t WS_HID  = WS_BIG;
constexpr size_t WS_BAR  = WS_BIG + (size_t)TP * DFF * 2;
constexpr size_t WS_END  = WS_BAR + 16384;
static_assert(WS_GFP + (size_t)2048 * 8224 * 2 <= WS_BAR, "big region");

struct Params {
    const float* in[24];
    float* out;
    unsigned char* ws;
};
typedef const __attribute__((address_space(4))) unsigned long long* kseg_t;
struct DP {
    kseg_t ks; int tid, bid, nb;
    __device__ __forceinline__ const float* in_(int k) const { return (const float*)ks[k]; }
    __device__ __forceinline__ float* out_() const { return (float*)ks[24]; }
    __device__ __forceinline__ unsigned char* ws_() const { return (unsigned char*)ks[25]; }
};

__device__ __forceinline__ unsigned cvt_pk_bf16(float lo, float hi) { unsigned r; asm volatile("v_cvt_pk_bf16_f32 %0, %1, %2" : "=v"(r) : "v"(lo), "v"(hi)); return r; }
__device__ __forceinline__ bf16_t f2bf(float f) { return (bf16_t)(cvt_pk_bf16(f, 0.f) & 0xffffu); }
__device__ __forceinline__ float bf2f(unsigned v) { return __uint_as_float(v << 16); }
__device__ __forceinline__ float bflo(unsigned w) { return __uint_as_float(w << 16); }
__device__ __forceinline__ float bfhi(unsigned w) { return __uint_as_float(w & 0xffff0000u); }
__device__ __forceinline__ float wave_sum(float v) {
#pragma unroll
    for (int o = 32; o >= 1; o >>= 1) v += __shfl_xor(v, o);
    return v;
}
__device__ __forceinline__ int seq_rbase(int sq) { return sq < 4 ? sq * 4096 : 16384 + (sq - 4) * 8192; }
__device__ __forceinline__ int seq_row(int sq, int p) { return p < 16 ? TREAL + 16 * sq + p : seq_rbase(sq) + p - 16; }

namespace pg8 {
constexpr int BM = 256, BK = 64, HALF = 128, HTB = HALF * BK * 2, STAGE_BYTES = 8 * HTB, NXCD = 8, WGM = 8;
__device__ __forceinline__ int lds_byte(int r, int c) { const int st = (r >> 4) * 2 + (c >> 5), rr = r & 15, cc = c & 31, ob = rr * 64 + cc * 2; return st * 1024 + (ob ^ (((ob >> 9) & 1) << 5)); }
__device__ __forceinline__ void stage_rc(int b, int& R, int& C) { const int st = b / 1024, sb = b % 1024, swz = sb ^ (((sb >> 9) & 1) << 5); R = (st >> 1) * 16 + swz / 64; C = (st & 1) * 32 + (swz % 64) / 2; }
__device__ __forceinline__ int perm32(int rho) { const int n = rho >> 4, i = rho & 15; return 8 * (i >> 2) + 4 * n + (i & 3); }

struct Unit { const char* a; const char* b; int pm, pn, prob; };
struct Prob { const bf16_t* A; const bf16_t* Bt; int nM, nN; };
struct Sched2 {
    const bf16_t* A0; const bf16_t* B0; const bf16_t* A1; const bf16_t* B1; int nM0, nN0, nM1, nN1, nwg0, nwg1; int K, ld, G, c;
    __device__ __forceinline__ void init(const Prob& p0, const Prob& p1, int K_, int G_, int c_) { A0 = p0.A; B0 = p0.Bt; A1 = p1.A; B1 = p1.Bt; nM0 = p0.nM; nN0 = p0.nN; nM1 = p1.nM; nN1 = p1.nN;
        nwg0 = nM0 * nN0; nwg1 = nM1 * nN1; K = K_; ld = K_; G = G_; c = c_; }
    __device__ __forceinline__ bool next(int i, Unit& u) const {
        long L = (long)i * G + c; int q = 0;
        if (L >= nwg0) { L -= nwg0; q = 1; if (L >= nwg1) return false; }
        const int nM = q ? nM1 : nM0, nN = q ? nN1 : nN0, nw = q ? nwg1 : nwg0;
        int wgid = (int)L; { const int qq = nw / NXCD, r = nw % NXCD, xcd = wgid % NXCD, off = wgid / NXCD; wgid = (xcd < r ? xcd * (qq + 1) : r * (qq + 1) + (xcd - r) * qq) + off; }
        const int nig = WGM * nN, gid = wgid / nig, fm = gid * WGM, gsz = (nM - fm) < WGM ? (nM - fm) : WGM;
        u.pm = fm + ((wgid % nig) % gsz); u.pn = (wgid % nig) / gsz; u.prob = q;
        const size_t tstep = (size_t)BM * K * 2;
        u.a = (const char*)(q ? A1 : A0) + (size_t)u.pm * tstep; u.b = (const char*)(q ? B1 : B0) + (size_t)u.pn * tstep;
        return true;
    }
};

struct EpiStore {
    static constexpr bool PERM = true;
    bf16_t* O[2]; int ldc[2];
    __device__ __forceinline__ void operator()(const f32x4 (&acc)[2][2][4][2], const Unit& u, int wr, int wc, int fr, int fq) const {
        bf16_t* base = u.prob ? O[1] : O[0]; const int ld = u.prob ? ldc[1] : ldc[0];
        const int row0 = u.pm * BM + wr * 64 + fr, col0 = u.pn * BM + wc * 32 + 8 * fq;
#pragma unroll
        for (int ai = 0; ai < 2; ++ai)
#pragma unroll
            for (int m = 0; m < 4; ++m) { bf16_t* rowp = base + (size_t)(row0 + ai * HALF + m * 16) * ld + col0;
#pragma unroll
                for (int bj = 0; bj < 2; ++bj) { const f32x4 v0 = acc[ai][bj][m][0], v1 = acc[ai][bj][m][1];
                    u32x4 w; w.x = cvt_pk_bf16(v0[0], v0[1]); w.y = cvt_pk_bf16(v0[2], v0[3]); w.z = cvt_pk_bf16(v1[0], v1[1]); w.w = cvt_pk_bf16(v1[2], v1[3]);
                    *(u32x4*)(rowp + bj * HALF) = w; } }
    }
};
struct EpiResid {
    static constexpr bool PERM = false;
    float* hmain; float* htail; const float* x0; const float* x1;
    __device__ __forceinline__ void operator()(const f32x4 (&acc)[2][2][4][2], const Unit& u, int wr, int wc, int fr, int fq) const {
        float* base = (u.pm < TREAL / BM) ? hmain + (size_t)u.pm * BM * DM : htail;
        const float* rbase = (x0 && u.pm < TREAL / BM) ? ((u.pm < 64) ? x0 + (size_t)u.pm * BM * DM : x1 + (size_t)(u.pm - 64) * BM * DM) : base;
        const int row0 = wr * 64 + fr, col0 = u.pn * BM + wc * 32 + 4 * fq;
#pragma unroll
        for (int ai = 0; ai < 2; ++ai)
#pragma unroll
            for (int m = 0; m < 4; ++m) { const size_t ro = (size_t)(row0 + ai * HALF + m * 16) * DM + col0; float* rowp = base + ro; const float* rrow = rbase + ro;
#pragma unroll
                for (int bj = 0; bj < 2; ++bj)
#pragma unroll
                    for (int n = 0; n < 2; ++n) *(f32x4*)(rowp + bj * HALF + n * 16) = *(const f32x4*)(rrow + bj * HALF + n * 16) + acc[ai][bj][m][n];
                asm volatile("" ::: "memory"); }
    }
};
struct EpiSwiGLU {
    static constexpr bool PERM = true;
    bf16_t* O;
    __device__ __forceinline__ void operator()(const f32x4 (&acc)[2][2][4][2], const Unit& u, int wr, int wc, int fr, int fq) const {
        const int row0 = u.pm * BM + wr * 64 + fr, col0 = u.pn * HALF + wc * 32 + 8 * fq;
#pragma unroll
        for (int ai = 0; ai < 2; ++ai)
#pragma unroll
            for (int m = 0; m < 4; ++m) { bf16_t* rowp = O + (size_t)(row0 + ai * HALF + m * 16) * DFF + col0;
                float r[8];
#pragma unroll
                for (int n = 0; n < 2; ++n)
#pragma unroll
                    for (int e = 0; e < 4; ++e) { const float g = acc[ai][0][m][n][e], up = acc[ai][1][m][n][e];
                        r[n * 4 + e] = g * __builtin_amdgcn_rcpf(1.0f + __expf(-g)) * up; }
                u32x4 w; w.x = cvt_pk_bf16(r[0], r[1]); w.y = cvt_pk_bf16(r[2], r[3]); w.z = cvt_pk_bf16(r[4], r[5]); w.w = cvt_pk_bf16(r[6], r[7]);
                *(u32x4*)rowp = w; }
    }
};

struct SchedSplit {
    const bf16_t* A; const bf16_t* Bt; int nN, nK, K, ld, G, c;
    __device__ __forceinline__ bool next(int i, Unit& u) const {
        const long L = (long)i * G + c; if (L >= nN * nK) return false;
        const int pn = (int)L % nN, kc = (int)L / nN;
        u.pm = TREAL / BM; u.pn = pn; u.prob = 0;
        u.a = (const char*)(A + (size_t)u.pm * BM * ld + (size_t)kc * K); u.b = (const char*)(Bt + (size_t)pn * BM * ld + (size_t)kc * K);
        return true;
    }
};
struct EpiResidAtomic {
    static constexpr bool PERM = false;
    float* htail;
    __device__ __forceinline__ void operator()(const f32x4 (&acc)[2][2][4][2], const Unit& u, int wr, int wc, int fr, int fq) const {
        const int col0 = u.pn * BM + wc * 32 + 4 * fq;
#pragma unroll
        for (int m = 0; m < 4; ++m) { const int row = wr * 64 + m * 16 + fr;
            if (row < 96) { float* rowp = htail + (size_t)row * DM + col0;
#pragma unroll
                for (int bj = 0; bj < 2; ++bj)
#pragma unroll
                    for (int n = 0; n < 2; ++n)
#pragma unroll
                        for (int e = 0; e < 4; ++e) atomicAdd(rowp + bj * HALF + n * 16 + e, acc[0][bj][m][n][e]); } }
    }
};
template <class Epi, class Sched>
__device__ __forceinline__ void gemm_phase(const DP& p, LAS unsigned char* lds, const Sched& S, const Epi& E) {
    const int tid = p.tid, wid = __builtin_amdgcn_readfirstlane(tid >> 6), lane = tid & 63, wr = wid >> 2, wc = wid & 3, fr = lane & 15, fq = lane >> 4;
    const int K = S.ld, nt = S.K / BK;
    unsigned voffA[2], voffB[2];
#pragma unroll
    for (int i = 0; i < 2; ++i) { int R, C; stage_rc(tid * 16 + i * 8192, R, C); const int Rb = Epi::PERM ? ((R & ~31) + perm32(R & 31)) : R;
        voffA[i] = (unsigned)(R * K + C) * 2u; voffB[i] = (unsigned)(Rb * K + C) * 2u; }
    const size_t kstep = (size_t)(BK * 2);
    const size_t hstep = (size_t)HALF * K * 2;
    const unsigned ldsw = (unsigned)wid * 1024u;
    const int aoff = lds_byte(wr * 64 + fr, fq * 8), boff = lds_byte(wc * 32 + fr, fq * 8);
#define PG8_SA(b, h) (((b) * 2 + (h)) * HTB)
#define PG8_SB(b, h) ((4 + (b) * 2 + (h)) * HTB)
#define PG8_STAGE(bufoff, gbase, voff) do { _Pragma("unroll") for (int _i = 0; _i < 2; ++_i) \
        __builtin_amdgcn_global_load_lds((const unsigned*)((const char*)(gbase) + (voff)[_i]), (LAS unsigned*)(lds + (bufoff) + ldsw + _i * 8192), 16, 0, 0); } while (0)
#define PG8_LDA(dst, b, h) do { _Pragma("unroll") for (int m = 0; m < 4; ++m) _Pragma("unroll") for (int k = 0; k < 2; ++k) dst[m][k] = *(const LAS bf16x8*)(lds + PG8_SA(b, h) + aoff + m * 2048 + k * 1024); } while (0)
#define PG8_LDB(dst, b, h) do { _Pragma("unroll") for (int n = 0; n < 2; ++n) _Pragma("unroll") for (int k = 0; k < 2; ++k) dst[n][k] = *(const LAS bf16x8*)(lds + PG8_SB(b, h) + boff + n * 2048 + k * 1024); } while (0)
#define PG8_MMA(ai, bj, At, Bt) do { __builtin_amdgcn_s_setprio(1); _Pragma("unroll") for (int m = 0; m < 4; ++m) _Pragma("unroll") for (int n = 0; n < 2; ++n) _Pragma("unroll") for (int k = 0; k < 2; ++k) \
        acc[ai][bj][m][n] = __builtin_amdgcn_mfma_f32_16x16x32_bf16(Bt[n][k], At[m][k], acc[ai][bj][m][n], 0, 0, 0); __builtin_amdgcn_s_setprio(0); } while (0)
#define PG8_WAIT_V(n) asm volatile("s_waitcnt vmcnt(" #n ")" ::: "memory")
#define PG8_WAIT_L(n) asm volatile("s_waitcnt lgkmcnt(" #n ")" ::: "memory")
#define PG8_BAR __builtin_amdgcn_s_barrier()
#define PG8_SCHED __builtin_amdgcn_sched_barrier(0)
    Unit cur, nxt; int ui = 0;
    if (!S.next(0, cur)) return;
    f32x4 acc[2][2][4][2];
#pragma unroll
    for (int a = 0; a < 2; ++a)
#pragma unroll
        for (int b = 0; b < 2; ++b)
#pragma unroll
            for (int m = 0; m < 4; ++m)
#pragma unroll
                for (int n = 0; n < 2; ++n) acc[a][b][m][n] = (f32x4){0.f, 0.f, 0.f, 0.f};
    bf16x8 At[4][2], B0[2][2], B1[2][2];
    const char* cA = cur.a; const char* cB = cur.b;
    PG8_STAGE(PG8_SB(0, 0), cB, voffB); PG8_STAGE(PG8_SA(0, 0), cA, voffA); PG8_STAGE(PG8_SB(0, 1), cB + hstep, voffB); PG8_STAGE(PG8_SA(0, 1), cA + hstep, voffA);
    if (wr == 1) PG8_BAR;
    PG8_WAIT_V(4); PG8_BAR;
    PG8_STAGE(PG8_SB(1, 0), cB + kstep, voffB); PG8_STAGE(PG8_SA(1, 0), cA + kstep, voffA); PG8_STAGE(PG8_SB(1, 1), cB + hstep + kstep, voffB);
    PG8_WAIT_V(6); PG8_BAR;
    for (;;) {
        const bool has_next = S.next(ui + 1, nxt);
        const char* nA = has_next ? nxt.a : cA; const char* nB = has_next ? nxt.b : cB;
        for (int t = 0; t < nt; t += 2) {
            const bool last = (t == nt - 2);
            const char* a1 = cA + (size_t)(t + 1) * kstep;
            const char* a2 = last ? nA : cA + (size_t)(t + 2) * kstep; const char* b2 = last ? nB : cB + (size_t)(t + 2) * kstep;
            const char* a3 = a2 + kstep; const char* b3 = b2 + kstep;
            PG8_LDB(B0, 0, 0); PG8_SCHED; PG8_LDA(At, 0, 0); PG8_STAGE(PG8_SA(1, 1), a1 + hstep, voffA);
            PG8_WAIT_L(8); PG8_BAR; PG8_WAIT_L(0); PG8_MMA(0, 0, At, B0); PG8_BAR; PG8_SCHED;
            PG8_LDB(B1, 0, 1); PG8_STAGE(PG8_SB(0, 0), b2, voffB);
            PG8_BAR; PG8_WAIT_L(0); PG8_MMA(0, 1, At, B1); PG8_BAR;
            PG8_LDA(At, 0, 1); PG8_STAGE(PG8_SA(0, 0), a2, voffA);
            PG8_BAR; PG8_WAIT_L(0); PG8_MMA(1, 0, At, B0); PG8_BAR; PG8_SCHED;
            PG8_STAGE(PG8_SB(0, 1), b2 + hstep, voffB);
            PG8_WAIT_V(6); PG8_BAR; PG8_MMA(1, 1, At, B1); PG8_BAR;
            PG8_LDB(B0, 1, 0); PG8_SCHED; PG8_LDA(At, 1, 0); PG8_STAGE(PG8_SA(0, 1), a2 + hstep, voffA);
            PG8_WAIT_L(8); PG8_BAR; PG8_WAIT_L(0); PG8_MMA(0, 0, At, B0); PG8_BAR; PG8_SCHED;
            PG8_LDB(B1, 1, 1); PG8_STAGE(PG8_SB(1, 0), b3, voffB);
            PG8_BAR; PG8_WAIT_L(0); PG8_MMA(0, 1, At, B1); PG8_BAR;
            PG8_LDA(At, 1, 1); PG8_STAGE(PG8_SA(1, 0), a3, voffA);
            PG8_BAR; PG8_WAIT_L(0); PG8_MMA(1, 0, At, B0); PG8_BAR; PG8_SCHED;
            PG8_STAGE(PG8_SB(1, 1), b3 + hstep, voffB);
            PG8_WAIT_V(6); PG8_BAR; PG8_MMA(1, 1, At, B1); PG8_BAR;
        }
        E(acc, cur, wr, wc, fr, fq);
        if (!has_next) break;
#pragma unroll
        for (int a = 0; a < 2; ++a)
#pragma unroll
            for (int b = 0; b < 2; ++b)
#pragma unroll
                for (int m = 0; m < 4; ++m)
#pragma unroll
                    for (int n = 0; n < 2; ++n) acc[a][b][m][n] = (f32x4){0.f, 0.f, 0.f, 0.f};
        cur = nxt; cA = nA; cB = nB; ++ui;
    }
    PG8_WAIT_V(0);
    if (wr == 0) PG8_BAR;
    PG8_BAR;
#undef PG8_SA
#undef PG8_SB
#undef PG8_STAGE
#undef PG8_LDA
#undef PG8_LDB
#undef PG8_MMA
#undef PG8_WAIT_V
#undef PG8_WAIT_L
#undef PG8_BAR
#undef PG8_SCHED
}
}

__device__ __forceinline__ void norm_rows(const DP& p, int mode, const float* gain) {
    const int lane = p.tid & 63, gw = p.bid * 8 + (p.tid >> 6), nw = p.nb * 8;
    float* tail = (float*)(p.ws_() + WS_TAIL); bf16_t* hn = (bf16_t*)(p.ws_() + WS_XA);
    const int nrows = (mode == 2 || mode == 4) ? TREAL : TP;
    f32x4 g[8];
#pragma unroll
    for (int j = 0; j < 8; ++j) g[j] = *(const f32x4*)(gain + 4 * (lane + 64 * j));
#define NR_SRC(rr) ((mode == 0) ? (((rr) < 16384) ? p.in_(0) + (size_t)(rr) * DM : ((rr) < TREAL) ? p.in_(1) + (size_t)((rr) - 16384) * DM : p.in_(2) + (size_t)(((rr) - TREAL) & 15) * DM) \
                                : (((rr) < TREAL) ? p.out_() + (size_t)(rr) * DM : tail + (size_t)((rr) - TREAL) * DM))
    f32x4 v[8], vn[8];
    if (gw < nrows && gw < TTOK) { const float* src = NR_SRC(gw);
#pragma unroll
        for (int j = 0; j < 8; ++j) v[j] = *(const f32x4*)(src + 4 * (lane + 64 * j)); }
    for (int r = gw; r < nrows; r += nw) {
        const int rn = r + nw;
        if (rn < nrows && rn < TTOK) { const float* srcn = NR_SRC(rn);
#pragma unroll
            for (int j = 0; j < 8; ++j) vn[j] = *(const f32x4*)(srcn + 4 * (lane + 64 * j)); }
        if (r >= TTOK) {
#pragma unroll
            for (int j = 0; j < 8; ++j) { *(u32x2*)(hn + (size_t)r * DM + 4 * (lane + 64 * j)) = (u32x2){0u, 0u};
                if (mode == 0) *(f32x4*)(tail + (size_t)(r - TREAL) * DM + 4 * (lane + 64 * j)) = (f32x4){0.f, 0.f, 0.f, 0.f}; }
        } else {
            float* hrow = (r < TREAL) ? p.out_() + (size_t)r * DM : tail + (size_t)(r - TREAL) * DM;
            float ss = 0.f;
#pragma unroll
            for (int j = 0; j < 8; ++j) ss += v[j][0] * v[j][0] + v[j][1] * v[j][1] + v[j][2] * v[j][2] + v[j][3] * v[j][3];
            ss = wave_sum(ss);
            const float rstd = 1.0f / sqrtf(ss * (1.0f / DM) + EPSN);
#pragma unroll
            for (int j = 0; j < 8; ++j) {
                const f32x4 o = v[j] * rstd * g[j];
                if (mode == 0 && r >= TREAL) *(f32x4*)(hrow + 4 * (lane + 64 * j)) = v[j];
                if (mode == 2) *(f32x4*)(hrow + 4 * (lane + 64 * j)) = o;
                else { u32x2 w; w.x = cvt_pk_bf16(o[0], o[1]); w.y = cvt_pk_bf16(o[2], o[3]); *(u32x2*)(hn + (size_t)r * DM + 4 * (lane + 64 * j)) = w; }
            }
        }
#pragma unroll
        for (int j = 0; j < 8; ++j) v[j] = vn[j];
    }
#undef NR_SRC
}

__device__ __forceinline__ void transpose_cvt(const DP& p, LAS unsigned char* lds, const float* src, int K, int N, bf16_t* dst, int ldd, int koff, int mode) {
    LAS float* tile = (LAS float*)lds;
    const int tid = p.tid, nkt = K / 64, nnt = N / 64, ntile = nkt * nnt;
    for (int t0 = p.bid * 4; t0 < ntile; t0 += p.nb * 4) {
        f32x4 v[4][2];
#pragma unroll
        for (int u = 0; u < 4; ++u) { const int t = (t0 + u < ntile) ? t0 + u : ntile - 1; const int k0 = (t / nnt) * 64, n0 = (t % nnt) * 64;
#pragma unroll
            for (int it = 0; it < 2; ++it) { const int e = tid + it * 512, kk = e >> 4, n4 = e & 15; v[u][it] = *(const f32x4*)(src + (size_t)(k0 + kk) * N + n0 + 4 * n4); } }
#pragma unroll
        for (int u = 0; u < 4; ++u)
#pragma unroll
            for (int it = 0; it < 2; ++it) { const int e = tid + it * 512, kk = e >> 4, n4 = e & 15; LAS float* tp = tile + u * 4160 + kk * 65 + 4 * n4;
                tp[0] = v[u][it][0]; tp[1] = v[u][it][1]; tp[2] = v[u][it][2]; tp[3] = v[u][it][3]; }
        __syncthreads();
#pragma unroll
        for (int u = 0; u < 4; ++u) if (t0 + u < ntile) { const int t = t0 + u, k0 = (t / nnt) * 64, n0 = (t % nnt) * 64;
            const int nn = tid >> 3, k8 = tid & 7; float f[8];
#pragma unroll
            for (int j = 0; j < 8; ++j) f[j] = tile[u * 4160 + (8 * k8 + j) * 65 + nn];
            const int n = n0 + nn; const int drow = (mode == 0) ? n : ((n >> 7) * 256 + (n & 127) + (mode == 2 ? 128 : 0));
            u32x4 w; w.x = cvt_pk_bf16(f[0], f[1]); w.y = cvt_pk_bf16(f[2], f[3]); w.z = cvt_pk_bf16(f[4], f[5]); w.w = cvt_pk_bf16(f[6], f[7]);
            *(u32x4*)(dst + (size_t)drow * ldd + koff + k0 + 8 * k8) = w; }
        __syncthreads();
    }
}
__device__ __forceinline__ void fold_pool(const DP& p, const float* pw, const float* sc, const float* wo, bf16_t* dst) {
    const int tid = p.tid;
    for (int it = p.bid; it < 512; it += p.nb) {
        const int g = it >> 7, c8 = (it >> 2) & 31, n = (it & 3) * 512 + tid;
        float acc[8];
#pragma unroll
        for (int e = 0; e < 8; ++e) acc[e] = 0.f;
        const float* pwr = pw + (size_t)(g * 256 + c8 * 8) * 256;
        for (int d = 0; d < 256; ++d) {
            const float wv = wo[(size_t)(g * 256 + d) * DM + n] * sc[g * 256 + d];
#pragma unroll
            for (int e = 0; e < 8; ++e) acc[e] += pwr[e * 256 + d] * wv;
        }
        u32x4 w; w.x = cvt_pk_bf16(acc[0], acc[1]); w.y = cvt_pk_bf16(acc[2], acc[3]); w.z = cvt_pk_bf16(acc[4], acc[5]); w.w = cvt_pk_bf16(acc[6], acc[7]);
        *(u32x4*)(dst + (size_t)n * DM + g * 256 + c8 * 8) = w;
    }
}
__device__ __forceinline__ void prep_weights(const DP& p, LAS unsigned char* lds, int l) {
    transpose_cvt(p, lds, p.in_(4) + (size_t)l * DM * 4096, DM, 4096, (bf16_t*)(p.ws_() + WS_WIN), DM, 0, 0);
    transpose_cvt(p, lds, p.in_(18) + (size_t)l * DM * DM + (size_t)1024 * DM, 1024, DM, (bf16_t*)(p.ws_() + WS_WOUT), DM, 1024, 0);
    transpose_cvt(p, lds, p.in_(20) + (size_t)l * DM * DFF, DM, DFF, (bf16_t*)(p.ws_() + WS_WGU), DM, 0, 1);
    transpose_cvt(p, lds, p.in_(21) + (size_t)l * DM * DFF, DM, DFF, (bf16_t*)(p.ws_() + WS_WGU), DM, 0, 2);
    transpose_cvt(p, lds, p.in_(22) + (size_t)l * DFF * DM, DFF, DM, (bf16_t*)(p.ws_() + WS_WDN), DFF, 0, 0);
    fold_pool(p, p.in_(5) + (size_t)l * 4 * 256 * 256, p.in_(6) + (size_t)l * 1024, p.in_(18) + (size_t)l * DM * DM, (bf16_t*)(p.ws_() + WS_WOUT));
    { const float* w4 = p.in_(16) + (size_t)l * 64 * 4096; float* w4t = (float*)(p.ws_() + WS_W4T);
      for (int i = p.bid * NTHREADS + p.tid; i < 4096 * 64; i += p.nb * NTHREADS) w4t[i] = w4[(size_t)(i & 63) * 4096 + (i >> 6)]; }
}

__device__ __forceinline__ void mlp_layer(LAS float* hl, int lane, int nin, const float* w, const float* b, const float* fr) {
    float acc[64];
#pragma unroll
    for (int j = 0; j < 64; ++j) acc[j] = b[j];
#pragma unroll 1
    for (int i = 0; i < nin; ++i) {
        const float hv = hl[i * 64 + lane];
#pragma unroll
        for (int j = 0; j < 64; ++j) acc[j] += hv * w[i * 64 + j];
    }
#pragma unroll
    for (int j = 0; j < 64; ++j) hl[j * 64 + lane] = __sinf(fr[j] * acc[j]);
}
__device__ __forceinline__ void filter_h3(const DP& p, LAS unsigned char* lds, int l) {
    const int lane = p.tid & 63, wv = __builtin_amdgcn_readfirstlane(p.tid >> 6), gw = __builtin_amdgcn_readfirstlane(p.bid * 8 + (p.tid >> 6)), nw = p.nb * 8;
    const float* w1 = p.in_(9) + (size_t)l * 33 * 64; const float* b1 = p.in_(10) + l * 64;
    const float* w2 = p.in_(11) + (size_t)l * 64 * 64; const float* b2 = p.in_(12) + l * 64;
    const float* w3 = p.in_(13) + (size_t)l * 64 * 64; const float* b3 = p.in_(14) + l * 64;
    const float* fr = p.in_(15) + l * 64;
    float* h3 = (float*)(p.ws_() + WS_H3) + (size_t)l * (8208 + 4112) * 64;
    LAS float* hl = (LAS float*)lds + wv * 4096;
    int item0 = gw - l * (nw / 2); if (item0 < 0) item0 += nw;
    for (int item = item0; item < 129 + 65; item += nw) {
        const int tr = item < 129 ? 1 : 0, tile = tr ? item : item - 129, L = tr ? 8208 : 4112;
        const int n = tile * 64 + lane; const bool valid = n < L;
        const float nf = (float)n, t = nf / (float)(L - 1);
        hl[lane] = t;
#pragma unroll
        for (int b = 0; b < 16; ++b) { const float band = 1e-4f + (float)b * ((15.0f - 1e-4f) / 15.0f);
            const float ang = (6.283185307179586f / (float)L) * nf * band; hl[(1 + b) * 64 + lane] = __cosf(ang); hl[(17 + b) * 64 + lane] = -__sinf(ang); }
        mlp_layer(hl, lane, 33, w1, b1, fr);
        mlp_layer(hl, lane, 64, w2, b2, fr);
        mlp_layer(hl, lane, 64, w3, b3, fr);
        if (valid) { float* o = h3 + (size_t)((tr ? 0 : 8208) + n) * 64;
#pragma unroll
            for (int j = 0; j < 16; ++j) *(f32x4*)(o + 4 * j) = (f32x4){hl[(4 * j) * 64 + lane], hl[(4 * j + 1) * 64 + lane], hl[(4 * j + 2) * 64 + lane], hl[(4 * j + 3) * 64 + lane]}; }
    }
}
__device__ __forceinline__ bf16x8 cvt8(const f32x4 a, const f32x4 b) { u32x4 o; o.x = cvt_pk_bf16(a[0], a[1]); o.y = cvt_pk_bf16(a[2], a[3]); o.z = cvt_pk_bf16(b[0], b[1]); o.w = cvt_pk_bf16(b[2], b[3]); return __builtin_bit_cast(bf16x8, o); }
__device__ __forceinline__ void filter_gen(const DP& p, LAS unsigned char* lds, int l) {
    const int skipb = (p.nb == 256) ? 16 : 0;
    if (p.bid < skipb) return;
    const int lane = p.tid & 63, wv = __builtin_amdgcn_readfirstlane(p.tid >> 6), gw = __builtin_amdgcn_readfirstlane((p.bid - skipb) * 8 + (p.tid >> 6)), nw = (p.nb - skipb) * 8;
    const float* w4t = (const float*)(p.ws_() + WS_W4T); const float* h3 = (const float*)(p.ws_() + WS_H3) + (size_t)l * (8208 + 4112) * 64;
    const float* skip = p.in_(17) + (size_t)l * 2 * 1024;
    LAS bf16_t* S = (LAS bf16_t*)(lds + wv * 8448);
    const int col = lane & 31, hh = lane >> 5;
    constexpr int NS = 2 * 65 * 8, NPI = 2 * 33 * 8;
    for (int item = gw; item < NS + NPI; item += nw) {
        const int tr = item < NS ? 1 : 0, it2 = tr ? item : item - NS;
        const int L = tr ? 8208 : 4112, GL = 2 * L;
        const int part = it2 & 7, bd = it2 >> 3, dir = bd & 1, b = bd >> 1, o = part >> 2, ct0 = (part & 3) * 8;
        const int nbase = 128 * b + dir;
        const float invL1 = 1.0f / (float)(L - 1);
        bf16x8 A[4][4];
#pragma unroll
        for (int r = 0; r < 4; ++r) {
            int n = nbase + 32 * r + col; n = n < L ? n : L - 1;
            const float* hr = h3 + (size_t)((tr ? 0 : 8208) + n) * 64 + 8 * hh;
#pragma unroll
            for (int s4 = 0; s4 < 4; ++s4) A[r][s4] = cvt8(*(const f32x4*)(hr + 16 * s4), *(const f32x4*)(hr + 16 * s4 + 4));
        }
        bf16_t* gbase = (bf16_t*)(p.ws_() + (tr ? WS_GFS : WS_GFP)) + (size_t)o * 1024 * GL;
        const int ebase = dir ? L + 128 * b : L - 128 * b - 128;
#pragma unroll 1
        for (int ct = 0; ct < 8; ++ct) {
            const int c = (ct0 + ct) * 32 + col;
            const float* wr = w4t + (size_t)(o * 2048 + dir * 1024 + c) * 64 + 8 * hh;
            bf16x8 Bf[4];
#pragma unroll
            for (int s4 = 0; s4 < 4; ++s4) Bf[s4] = cvt8(*(const f32x4*)(wr + 16 * s4), *(const f32x4*)(wr + 16 * s4 + 4));
            const float d0 = -3.0701134573253946f, d1 = -15.350567286626973f;
            const float kc = -fabsf(d0 + (float)c * ((d1 - d0) / 1023.0f)) * 1.4426950408889634f;
            const float sk = skip[o * 1024 + c];
#pragma unroll
            for (int r = 0; r < 4; ++r) {
                f32x16 acc;
#pragma unroll
                for (int i = 0; i < 16; ++i) acc[i] = 0.f;
#pragma unroll
                for (int s4 = 0; s4 < 4; ++s4) acc = __builtin_amdgcn_mfma_f32_32x32x16_bf16(A[r][s4], Bf[s4], acc, 0, 0, 0);
#pragma unroll
                for (int q = 0; q < 4; ++q) {
                    const int nl0 = 32 * r + 8 * q + 4 * hh;
                    float v[4];
#pragma unroll
                    for (int e = 0; e < 4; ++e) { const int n = nbase + nl0 + e; const float t = (float)n * invL1;
                        v[e] = acc[4 * q + e] * __builtin_amdgcn_exp2f(t * kc); }
                    if (r == 0 && q == 0) v[0] += (nbase + nl0 == 0 && dir == 0) ? sk : 0.f;
                    u32x2 w;
                    if (dir) { w.x = cvt_pk_bf16(v[0], v[1]); w.y = cvt_pk_bf16(v[2], v[3]); *(LAS u32x2*)(S + col * 132 + nl0) = w; }
                    else     { w.x = cvt_pk_bf16(v[3], v[2]); w.y = cvt_pk_bf16(v[1], v[0]); *(LAS u32x2*)(S + col * 132 + 124 - nl0) = w; }
                }
            }
#pragma unroll
            for (int u = 0; u < 8; ++u) {
                const int id = u * 64 + lane, colr = id >> 4, k = id & 15;
                const u32x2 lo = *(const LAS u32x2*)(S + colr * 132 + 8 * k), hi = *(const LAS u32x2*)(S + colr * 132 + 8 * k + 4);
                const int e0 = ebase + 8 * k;
                if ((unsigned)e0 <= (unsigned)(GL - 8)) *(u32x4*)(gbase + (size_t)((ct0 + ct) * 32 + colr) * GL + e0) = (u32x4){lo.x, lo.y, hi.x, hi.y};
            }
        }
    }
}

__device__ __forceinline__ void pool_acc(float (&s)[8], const u32x4 v, float sg) {
    s[0] += sg * bflo(v.x); s[1] += sg * bfhi(v.x); s[2] += sg * bflo(v.y); s[3] += sg * bfhi(v.y); s[4] += sg * bflo(v.z); s[5] += sg * bfhi(v.z); s[6] += sg * bflo(v.w); s[7] += sg * bfhi(v.w);
}
__device__ __forceinline__ void pool_window(const DP& p, LAS unsigned char* lds) {
    const bf16_t* P = (const bf16_t*)(p.ws_() + WS_P); bf16_t* mix = (bf16_t*)(p.ws_() + WS_XA);
    LAS bf16_t* T = (LAS bf16_t*)lds;
    const int tid = p.tid;
    const int nitem = (4 * 65 + 2 * 129) * 4;
    for (int item = p.bid; item < nitem; item += p.nb) {
        const int g = item & 3, ch = item >> 2;
        int sq, r, L;
        if (ch < 4 * 65) { sq = ch / 65; r = ch - sq * 65; L = 4112; } else { const int c2 = ch - 4 * 65; sq = 4 + c2 / 129; r = c2 - (sq - 4) * 129; L = 8208; }
        const int hw = 1 << g, p0 = 64 * r, nrow = 64 + 2 * hw;
        for (int idx = tid; idx < nrow * 32; idx += NTHREADS) {
            const int j = idx >> 5, c8 = idx & 31, q = p0 - hw + j;
            u32x4 v = (u32x4){0u, 0u, 0u, 0u};
            if (q >= 0 && q < L) v = *(const u32x4*)(P + (size_t)seq_row(sq, q) * 1024 + g * 256 + 8 * c8);
            *(LAS u32x4*)(T + j * 264 + 8 * c8) = v;
        }
        __syncthreads();
        {
            const int c8 = tid & 31, run = tid >> 5, pb = p0 + 4 * run;
            if (pb < L) {
                float s[8];
#pragma unroll
                for (int e = 0; e < 8; ++e) s[e] = 0.f;
                for (int t = 0; t < 2 * hw; ++t) pool_acc(s, *(const LAS u32x4*)(T + (4 * run + t) * 264 + 8 * c8), 1.0f);
#pragma unroll
                for (int i = 0; i < 4; ++i) {
                    const int pp = pb + i;
                    const int lo = pp - hw < 0 ? 0 : pp - hw, hi = pp + hw > L ? L : pp + hw;
                    const float inv = 1.0f / (float)(hi - lo);
                    const u32x4 v = *(const LAS u32x4*)(T + (4 * run + i + hw) * 264 + 8 * c8);
                    u32x4 w;
                    w.x = cvt_pk_bf16(s[0] * inv - bflo(v.x), s[1] * inv - bfhi(v.x)); w.y = cvt_pk_bf16(s[2] * inv - bflo(v.y), s[3] * inv - bfhi(v.y));
                    w.z = cvt_pk_bf16(s[4] * inv - bflo(v.z), s[5] * inv - bfhi(v.z)); w.w = cvt_pk_bf16(s[6] * inv - bflo(v.w), s[7] * inv - bfhi(v.w));
                    if (pp < L) *(u32x4*)(mix + (size_t)seq_row(sq, pp) * DM + g * 256 + 8 * c8) = w;
                    if (i < 3) { pool_acc(s, *(const LAS u32x4*)(T + (4 * run + i + 2 * hw) * 264 + 8 * c8), 1.0f); pool_acc(s, *(const LAS u32x4*)(T + (4 * run + i) * 264 + 8 * c8), -1.0f); }
                }
            }
        }
        __syncthreads();
    }
}

constexpr int HYH_U = 0, HYH_FB = 35840, HYH_ZB = HYH_FB + 33280, HYH_RED = HYH_ZB + 512, HYH_SIZE = HYH_RED + 1024;
static_assert(2 * HYH_SIZE <= LDS_BYTES, "hyena LDS");
constexpr int FPAD = 176;
template <int TR> struct HG;
template <> struct HG<1> { static constexpr int L = 8208, B = 2, NSB = 16, BSE = 8720, NIN = 513, SQ0 = 4; };
template <> struct HG<0> { static constexpr int L = 4112, B = 4, NSB = 8,  BSE = 4416, NIN = 257, SQ0 = 0; };
__device__ __forceinline__ int uphys(int q) { return q + 8 * (q >> 7); }

struct ARaw { u32x2 w01, w23, w45; };
__device__ __forceinline__ ARaw hy_raw_a(const LAS unsigned char* p8) { ARaw r; r.w01 = *(const LAS u32x2*)p8; r.w23 = *(const LAS u32x2*)(p8 + 8); r.w45 = *(const LAS u32x2*)(p8 + 16); return r; }
__device__ __forceinline__ bf16x8 hy_fin_a(const ARaw& r, bool dsel, unsigned bsh) {
    const unsigned s0 = dsel ? r.w01.y : r.w01.x, s1 = dsel ? r.w23.x : r.w01.y, s2 = dsel ? r.w23.y : r.w23.x, s3 = dsel ? r.w45.x : r.w23.y, s4 = dsel ? r.w45.y : r.w45.x;
    u32x4 o; o.x = __builtin_amdgcn_alignbit(s1, s0, bsh); o.y = __builtin_amdgcn_alignbit(s2, s1, bsh); o.z = __builtin_amdgcn_alignbit(s3, s2, bsh); o.w = __builtin_amdgcn_alignbit(s4, s3, bsh);
    return __builtin_bit_cast(bf16x8, o);
}
template <int TR>
__device__ __forceinline__ void hy_conv(LAS unsigned char* hl, int wq, int lane, f32x16 (&acc)[4]) {
    typedef HG<TR> G;
    const LAS unsigned char* Ub = hl + HYH_U; const LAS unsigned char* FBb = hl + HYH_FB;
    asm volatile("" : "+v"(lane));
    const int n = lane & 31, h = lane >> 5;
    const int sbi = n % G::NSB, beta = n / G::NSB, sb0 = wq * G::NSB;
    const int abase = FPAD + (G::L - 1) - n + 8 * h;
    const int ab2 = 2 * abase, ab8 = ab2 & ~7; const bool dsel = (ab2 & 4) != 0; const unsigned bsh = (ab2 & 2) ? 16u : 0u;
    constexpr int KS = (G::L - 16) / 16 + 8 * (G::NSB - 1) + 1, NIT = (KS + 1) / 2, NOUT = (NIT + 3) / 4;
    const int dlo = 128 * sb0 - (G::L - 16);
    constexpr int MMAX = (G::L - 16) / 128;
#pragma unroll
    for (int r = 0; r < 4; ++r)
#pragma unroll
        for (int i = 0; i < 16; ++i) acc[r][i] = 0.f;
    bf16x8 qe[4], qo[4];
#pragma unroll
    for (int r = 0; r < 4; ++r) { qe[r] = hy_fin_a(hy_raw_a(FBb + (ab8 - 2 * (dlo + 32 * r))), dsel, bsh); qo[r] = hy_fin_a(hy_raw_a(FBb + (ab8 - 2 * (dlo + 16 + 32 * r))), dsel, bsh); }
    const int ub2 = 2 * (beta * G::BSE + 8 * h);
    int M = sbi + MMAX;
    const LAS unsigned char* zb = hl + HYH_ZB + 256;
#define HY_PB(MM, first) ({ const bool v_ = (first) ? ((unsigned)(MM) <= (unsigned)MMAX) : ((unsigned)((MM) - 1) < (unsigned)MMAX); v_ ? (Ub + ub2 + 272 * (MM)) : zb; })
    const LAS unsigned char* pb0 = HY_PB(M, true); const LAS unsigned char* pb1 = HY_PB(M, false);
    bf16x8 be = *(const LAS bf16x8*)pb0, bo = *(const LAS bf16x8*)(pb1 - 2 * (16 + 8));
    unsigned pa = (unsigned)(size_t)(FBb + (ab8 - 2 * (dlo + 128))) - 320u;
#define HY_DSR64(dst, addr, off)  asm volatile("ds_read_b64 %0, %1 offset:%2"  : "=v"(dst) : "v"(addr), "n"(off))
#define HY_DSR128(dst, addr, off) asm volatile("ds_read_b128 %0, %1 offset:%2" : "=v"(dst) : "v"(addr), "n"(off))
#pragma unroll 1
    for (int I = 0; I < NOUT; ++I) {
        const LAS unsigned char* pn0 = HY_PB(M - 1, true); const LAS unsigned char* pn1 = HY_PB(M - 1, false);
        const unsigned b1a = (unsigned)(size_t)pb1 - 256u, n0a = (unsigned)(size_t)pn0, n1a = (unsigned)(size_t)pn1 - 256u;
#pragma unroll
        for (int j = 0; j < 4; ++j) {
            ARaw ra, rb; bf16x8 nbe, nbo;
            HY_DSR64(ra.w01, pa, 320 - 64 * j);      HY_DSR64(ra.w23, pa, 320 - 64 * j + 8);      HY_DSR64(ra.w45, pa, 320 - 64 * j + 16);
            HY_DSR64(rb.w01, pa, 320 - 64 * j - 32); HY_DSR64(rb.w23, pa, 320 - 64 * j - 32 + 8); HY_DSR64(rb.w45, pa, 320 - 64 * j - 32 + 16);
            if (j < 3) { HY_DSR128(nbe, b1a, 256 - 2 * (32 * (j + 1) + 8)); HY_DSR128(nbo, b1a, 256 - 2 * (32 * (j + 1) + 16 + 8)); }
            else       { HY_DSR128(nbe, n0a, 0);                            HY_DSR128(nbo, n1a, 256 - 2 * (16 + 8)); }
#pragma unroll
            for (int r = 0; r < 4; ++r) acc[r] = __builtin_amdgcn_mfma_f32_32x32x16_bf16(qe[(j + r) & 3], be, acc[r], 0, 0, 0);
#pragma unroll
            for (int r = 0; r < 4; ++r) acc[r] = __builtin_amdgcn_mfma_f32_32x32x16_bf16(qo[(j + r) & 3], bo, acc[r], 0, 0, 0);
            asm volatile("s_waitcnt lgkmcnt(0)" : "+v"(ra.w01), "+v"(ra.w23), "+v"(ra.w45), "+v"(rb.w01), "+v"(rb.w23), "+v"(rb.w45), "+v"(nbe), "+v"(nbo), "+v"(acc[0]), "+v"(acc[1]), "+v"(acc[2]), "+v"(acc[3]));
            qe[j] = hy_fin_a(ra, dsel, bsh); qo[j] = hy_fin_a(rb, dsel, bsh);
            be = nbe; bo = nbo;
        }
        pa -= 256u; pb0 = pn0; pb1 = pn1; --M;
    }
#undef HY_DSR64
#undef HY_DSR128
#undef HY_PB
    {
        f32x16 at;
#pragma unroll
        for (int i = 0; i < 16; ++i) at[i] = 0.f;
        constexpr int MS = (G::NIN + 3) / 4;
        const int m0 = wq * MS, m1 = (m0 + MS < G::NIN) ? m0 + MS : G::NIN;
        const bool colv = n < G::B;
        const int ut2 = 2 * ((colv ? n : 0) * G::BSE + 8 * h);
#pragma unroll 4
        for (int m = m0; m < m1; ++m) {
            const int d = (G::L - 16) - 16 * m;
            const bf16x8 a = hy_fin_a(hy_raw_a(FBb + (ab8 - 2 * d)), dsel, bsh);
            const bf16x8 b = *(const LAS bf16x8*)(colv ? Ub + ut2 + 2 * (16 * m + 8 * ((16 * m) >> 7)) : zb);
            at = __builtin_amdgcn_mfma_f32_32x32x16_bf16(a, b, at, 0, 0, 0);
        }
        LAS float* RED = (LAS float*)(hl + HYH_RED);
        if (colv) {
#pragma unroll
            for (int i = 0; i < 8; ++i) { const int arow = (i & 3) + 8 * (i >> 2) + 4 * h; RED[(wq * 16 + arow) * 4 + n] = at[i]; }
        }
    }
}
template <int TR>
__device__ __forceinline__ void hy_load_stream(const DP& p, LAS unsigned char* hl, int lt, int l, int k, int c, bool toU) {
    typedef HG<TR> G;
    asm volatile("" : "+v"(lt));
    const int ch = k * 1024 + c;
    const float* cw = p.in_(7) + (size_t)l * 3 * 3072; const float* cb = p.in_(8) + (size_t)l * 3072;
    const float w0 = cw[ch], w1 = cw[3072 + ch], w2 = cw[2 * 3072 + ch], bb = cb[ch];
    const bf16_t* src = (const bf16_t*)(p.ws_() + WS_UT) + (size_t)ch * TP;
    LAS bf16_t* U = (LAS bf16_t*)(hl + HYH_U); LAS bf16_t* X = (LAS bf16_t*)(hl + HYH_FB);
    constexpr int nch = G::L / 8, NCH = G::B * nch, NI = (NCH + 255) / 256;
    constexpr int GB = 3;
#pragma unroll
    for (int g0 = 0; g0 < NI; g0 += GB) {
        u32x4 v[GB]; unsigned short xl[GB], xr[GB];
#pragma unroll
        for (int i = 0; i < GB; ++i) {
            int idx = lt + 256 * (g0 + i); idx = idx < NCH ? idx : NCH - 1;
            const int b = idx / nch, q = idx - b * nch, p0 = 8 * q, sq = G::SQ0 + b;
            const int moff = TREAL + 16 * sq, roff = seq_rbase(sq);
            const int off = p0 < 16 ? moff + p0 : roff + p0 - 16;
            v[i] = *(const u32x4*)(src + off);
            xl[i] = src[p0 == 0 ? off : (p0 == 16 ? moff + 15 : off - 1)];
            xr[i] = src[p0 + 8 >= G::L ? off : (p0 + 8 == 16 ? roff : off + 8)];
        }
#pragma unroll
        for (int i = 0; i < GB; ++i) {
            const int idx = lt + 256 * (g0 + i);
            if (g0 + i < NI && idx < NCH) {
                const int b = idx / nch, q = idx - b * nch, p0 = 8 * q;
                float x[10];
                x[0] = (p0 == 0) ? 0.f : bf2f(xl[i]);
                x[9] = (p0 + 8 >= G::L) ? 0.f : bf2f(xr[i]);
                x[1] = bflo(v[i].x); x[2] = bfhi(v[i].x); x[3] = bflo(v[i].y); x[4] = bfhi(v[i].y); x[5] = bflo(v[i].z); x[6] = bfhi(v[i].z); x[7] = bflo(v[i].w); x[8] = bfhi(v[i].w);
                float y[8];
#pragma unroll
                for (int j = 0; j < 8; ++j) y[j] = w0 * x[j] + w1 * x[j + 1] + w2 * x[j + 2] + bb;
                u32x4 w; w.x = cvt_pk_bf16(y[0], y[1]); w.y = cvt_pk_bf16(y[2], y[3]); w.z = cvt_pk_bf16(y[4], y[5]); w.w = cvt_pk_bf16(y[6], y[7]);
                LAS bf16_t* dst = toU ? U + b * G::BSE + uphys(p0) : X + b * G::L + p0;
                *(LAS u32x4*)dst = w;
            }
        }
    }
}
template <int TR>
__device__ __forceinline__ void hy_load_filter(const DP& p, LAS unsigned char* hl, int lt, int o, int c) {
    typedef HG<TR> G;
    constexpr int GL = 2 * G::L, NCH = GL / 8, NI = (NCH + 255) / 256;
    asm volatile("" : "+v"(lt));
    const bf16_t* gf = (const bf16_t*)(p.ws_() + (TR ? WS_GFS : WS_GFP)) + ((size_t)o * 1024 + c) * GL;
    LAS bf16_t* FB = (LAS bf16_t*)(hl + HYH_FB);
    u32x4 v[NI];
#pragma unroll
    for (int i = 0; i < NI; ++i) { int idx = lt + 256 * i; idx = idx < NCH ? idx : NCH - 1; v[i] = *(const u32x4*)(gf + 8 * idx); }
    if (lt < FPAD / 8) *(LAS u32x4*)(FB + 8 * lt) = (u32x4){0u, 0u, 0u, 0u};
#pragma unroll
    for (int i = 0; i < NI; ++i) { const int idx = lt + 256 * i; if (idx < NCH) *(LAS u32x4*)(FB + FPAD + 8 * idx) = v[i]; }
}
template <int TR>
__device__ __forceinline__ void hy_items(const DP& p, LAS unsigned char* lds, int l, int vcu) {
    typedef HG<TR> G;
    const int tid = p.tid, lane = tid & 63, wave = __builtin_amdgcn_readfirstlane(tid >> 6), hf = wave >> 2, wq = wave & 3, lt = tid & 255;
    LAS unsigned char* hl = lds + hf * HYH_SIZE;
    LAS bf16_t* U = (LAS bf16_t*)(hl + HYH_U); const LAS bf16_t* X = (const LAS bf16_t*)(hl + HYH_FB); const LAS float* RED = (const LAS float*)(hl + HYH_RED);
    bf16_t* UT = (bf16_t*)(p.ws_() + WS_UT);
    for (int pit = vcu; pit < 512; pit += p.nb) {
        const int c = 2 * pit + hf;
        if (lt < 32) *(LAS u32x4*)(hl + HYH_ZB + 16 * lt) = (u32x4){0u, 0u, 0u, 0u};
        hy_load_stream<TR>(p, hl, lt, l, 0, c, true);
        hy_load_filter<TR>(p, hl, lt, 0, c);
        __syncthreads();
        f32x16 acc[4];
#pragma unroll 1
        for (int rep = 0; rep < HYREP; ++rep) { hy_conv<TR>(hl, wq, lane, acc); asm volatile("" ::: "memory"); }
        __syncthreads();
        hy_load_stream<TR>(p, hl, lt, l, 1, c, false);
        __syncthreads();
        { int ln = lane; asm volatile("" : "+v"(ln)); const int n = ln & 31, hh = ln >> 5, sbi = n % G::NSB, beta = n / G::NSB, sb = wq * G::NSB + sbi;
#pragma unroll
        for (int r = 0; r < 4; ++r)
#pragma unroll
            for (int qd = 0; qd < 4; ++qd) {
                const int t0 = 128 * sb + 32 * r + 8 * qd + 4 * hh;
                const u32x2 xv = *(const LAS u32x2*)(X + beta * G::L + t0);
                u32x2 w; w.x = cvt_pk_bf16(bflo(xv.x) * acc[r][4 * qd], bfhi(xv.x) * acc[r][4 * qd + 1]); w.y = cvt_pk_bf16(bflo(xv.y) * acc[r][4 * qd + 2], bfhi(xv.y) * acc[r][4 * qd + 3]);
                *(LAS u32x2*)(U + beta * G::BSE + uphys(t0)) = w;
            }
        }
        if (lt < 16 * G::B) { const int a = lt & 15, b = lt >> 4; float y = 0.f;
#pragma unroll
            for (int w = 0; w < 4; ++w) y += RED[(w * 16 + a) * 4 + b];
            const int t = (G::L - 16) + a;
            U[b * G::BSE + uphys(t)] = f2bf(bf2f(X[b * G::L + t]) * y); }
        __syncthreads();
        hy_load_filter<TR>(p, hl, lt, 1, c);
        __syncthreads();
        hy_conv<TR>(hl, wq, lane, acc);
        __syncthreads();
        hy_load_stream<TR>(p, hl, lt, l, 2, c, false);
        __syncthreads();
        bf16_t* orow = UT + (size_t)c * TP;
        { int ln = lane; asm volatile("" : "+v"(ln)); const int n = ln & 31, hh = ln >> 5, sbi = n % G::NSB, beta = n / G::NSB, sb = wq * G::NSB + sbi;
#pragma unroll
        for (int r = 0; r < 4; ++r)
#pragma unroll
            for (int qd = 0; qd < 4; ++qd) {
                const int t0 = 128 * sb + 32 * r + 8 * qd + 4 * hh;
                const u32x2 xv = *(const LAS u32x2*)(X + beta * G::L + t0);
                u32x2 w; w.x = cvt_pk_bf16(bflo(xv.x) * acc[r][4 * qd], bfhi(xv.x) * acc[r][4 * qd + 1]); w.y = cvt_pk_bf16(bflo(xv.y) * acc[r][4 * qd + 2], bfhi(xv.y) * acc[r][4 * qd + 3]);
                *(u32x2*)(orow + seq_row(G::SQ0 + beta, t0)) = w;
            }
        }
        if (lt < 16 * G::B) { const int a = lt & 15, b = lt >> 4; float y = 0.f;
#pragma unroll
            for (int w = 0; w < 4; ++w) y += RED[(w * 16 + a) * 4 + b];
            const int t = (G::L - 16) + a;
            orow[seq_row(G::SQ0 + b, t)] = f2bf(bf2f(X[b * G::L + t]) * y); }
        __syncthreads();
    }
}
__device__ __forceinline__ void hyena_phase(const DP& p, LAS unsigned char* lds, int l) {
    const int Gd = p.nb, bx = p.bid;
    const int vcu = (Gd % 8 == 0) ? (bx % 8) * (Gd / 8) + bx / 8 : bx;
    hy_items<1>(p, lds, l, vcu);
    hy_items<0>(p, lds, l, vcu);
}
__device__ __forceinline__ void hyena_transpose(const DP& p, LAS unsigned char* lds) {
    const bf16_t* UT = (const bf16_t*)(p.ws_() + WS_UT); bf16_t* mix = (bf16_t*)(p.ws_() + WS_XA);
    LAS bf16_t* tile = (LAS bf16_t*)lds;
    const int tid = p.tid, ntile = 16 * (TP / 64);
    for (int t0 = p.bid * 4; t0 < ntile; t0 += p.nb * 4) {
        u32x4 v[4];
#pragma unroll
        for (int u = 0; u < 4; ++u) { const int t = (t0 + u < ntile) ? t0 + u : ntile - 1; const int c0 = (t & 15) * 64, tk0 = (t >> 4) * 64, cc = tid >> 3, t8 = tid & 7;
            v[u] = *(const u32x4*)(UT + (size_t)(c0 + cc) * TP + tk0 + 8 * t8); }
#pragma unroll
        for (int u = 0; u < 4; ++u) { const int cc = tid >> 3, t8 = tid & 7; *(LAS u32x4*)(tile + u * 4608 + cc * 72 + 8 * t8) = v[u]; }
        __syncthreads();
#pragma unroll
        for (int u = 0; u < 4; ++u) if (t0 + u < ntile) { const int t = t0 + u, c0 = (t & 15) * 64, tk0 = (t >> 4) * 64;
            const int tt = tid >> 3, c8 = tid & 7; unsigned w[4];
#pragma unroll
            for (int j = 0; j < 4; ++j) w[j] = (unsigned)tile[u * 4608 + (8 * c8 + 2 * j) * 72 + tt] | ((unsigned)tile[u * 4608 + (8 * c8 + 2 * j + 1) * 72 + tt] << 16);
            *(u32x4*)(mix + (size_t)(tk0 + tt) * DM + 1024 + c0 + 8 * c8) = (u32x4){w[0], w[1], w[2], w[3]}; }
        __syncthreads();
    }
}

#define XB_TMO      128
#define XB_XCNT(j)  (256  + 64 * (j))
#define XB_XSUB(j)  (1280 + 64 * (j))
#define XB_XGEN(j)  (2304 + 64 * (j))
#define XB_TOP      3328
#define XB_TOPGEN   3392
#define XCD_BAR_WORDS 3456
#define XB_SPIN_CAP (1u << 18)
__device__ __forceinline__ unsigned xb_ld(unsigned* p)              { return __hip_atomic_load(p, __ATOMIC_RELAXED, __HIP_MEMORY_SCOPE_AGENT); }
__device__ __forceinline__ unsigned xb_add(unsigned* p, unsigned v) { return __hip_atomic_fetch_add(p, v, __ATOMIC_RELAXED, __HIP_MEMORY_SCOPE_AGENT); }
__device__ __forceinline__ unsigned xb_xcc_id() { return (unsigned)__builtin_amdgcn_s_getreg((3 << 11) | 20) & 0xFu; }
#define XB_SPIN(cond, bar) do { unsigned _sp = 0; while (cond) { __builtin_amdgcn_s_sleep(1); \
    if ((++_sp & 255u) == 0u) { if (xb_ld(&(bar)[XB_TMO])) break; if (_sp > XB_SPIN_CAP) { atomicAdd(&(bar)[XB_TMO], 1u); break; } } } } while (0)
__device__ __forceinline__ void xcd_barrier_complete(unsigned* bar, unsigned x, unsigned G, unsigned& nloc, unsigned& nx) {
    unsigned sum, cnt, mine, sp = 0u;
    for (;;) {
        sum = 0u; cnt = 0u; mine = 0u;
#pragma unroll
        for (unsigned j = 0; j < 16; ++j) { const unsigned c = xb_ld(&bar[XB_XCNT(j)]); sum += c; cnt += (c > 0u) ? 1u : 0u; mine = (j == x) ? c : mine; }
        if (sum == G) break;
        __builtin_amdgcn_s_sleep(1);
        if ((++sp & 255u) == 0u) { if (xb_ld(&bar[XB_TMO])) break; if (sp > XB_SPIN_CAP) { atomicAdd(&bar[XB_TMO], 1u); break; } }
    }
    nloc = mine > 0u ? mine : 1u; nx = cnt > 0u ? cnt : 1u;
}
__device__ __forceinline__ void xcd_barrier(unsigned* bar, unsigned x, volatile LAS unsigned* st, unsigned G, int tid) {
    asm volatile("s_waitcnt vmcnt(0)" ::: "memory");
    __syncthreads();
    if (tid == 0) {
        __builtin_amdgcn_s_waitcnt(0);
        unsigned nloc = st[0], nx = st[1];
        if (nloc == 0u) { xcd_barrier_complete(bar, x, G, nloc, nx); st[0] = nloc; st[1] = nx; }
        const unsigned old = xb_add(&bar[XB_XSUB(x)], 1u);
        const unsigned gen = old / nloc;
        if (old + 1u == (gen + 1u) * nloc) {
            __builtin_amdgcn_fence(__ATOMIC_RELEASE, "agent");
            asm volatile("s_waitcnt vmcnt(0)" ::: "memory");
            const unsigned og = xb_add(&bar[XB_TOP], 1u);
            const unsigned tg = og / nx;
            if (og + 1u == (tg + 1u) * nx) xb_add(&bar[XB_TOPGEN], 1u);
            else XB_SPIN(xb_ld(&bar[XB_TOPGEN]) == tg, bar);
            __builtin_amdgcn_fence(__ATOMIC_ACQUIRE, "agent");
            xb_add(&bar[XB_XGEN(x)], 1u);
            asm volatile("s_waitcnt vmcnt(0)" ::: "memory");
        } else {
            XB_SPIN(xb_ld(&bar[XB_XGEN(x)]) == gen, bar);
            __builtin_amdgcn_fence(__ATOMIC_ACQUIRE, "agent");
            asm volatile("s_waitcnt vmcnt(0)" ::: "memory");
        }
    }
    __syncthreads();
}

constexpr int NPHASES = 17;
__device__ __forceinline__ void run_phase(const DP& p, LAS unsigned char* lds, int ph) {
    const int l = (ph == 0) ? 0 : (ph - 1) / 8, jj = (ph - 1) % 8, k = (ph == 0) ? 0 : (jj < 2 ? jj + 1 : (jj == 2 ? 8 : jj));
    const int G = p.nb, cbx = p.bid;
    bf16_t* XA = (bf16_t*)(p.ws_() + WS_XA);
    switch (k) {
#if (PHMASK >> 0) & 1
    case 0: {
#if SUB & 1
        norm_rows(p, 0, p.in_(3));
#endif
#if SUB & 2
        prep_weights(p, lds, 0);
#endif
#if SUB & 4
        __syncthreads(); filter_h3(p, lds, 0); filter_h3(p, lds, 1);
#endif
    } break;
#endif
#if (PHMASK >> 1) & 1
    case 1: {
        pg8::Prob p0{XA, (const bf16_t*)(p.ws_() + WS_WIN), TP / 256, 4};
        pg8::Prob p1{(const bf16_t*)(p.ws_() + WS_WIN) + (size_t)1024 * DM, XA, 12, TP / 256};
        pg8::Sched2 S; S.init(p0, p1, DM, G, cbx);
        pg8::EpiStore E{{(bf16_t*)(p.ws_() + WS_P), (bf16_t*)(p.ws_() + WS_UT)}, {1024, TP}};
#ifndef NOG1
        pg8::gemm_phase<pg8::EpiStore, pg8::Sched2>(p, lds, S, E);
#endif
#ifndef NOFG
        { DP p2 = p; asm volatile("" : "+v"(p2.tid));
          __syncthreads(); filter_gen(p2, lds, l); }
#endif
    } break;
#endif
#if (PHMASK >> 2) & 1
    case 2: {
#ifndef NOHY
        hyena_phase(p, lds, l);
#endif
#ifndef NOPOOL
        __syncthreads(); pool_window(p, lds);
#endif
    } break;
#endif
#if (PHMASK >> 8) & 1
    case 8: hyena_transpose(p, lds); break;
#endif
#if (PHMASK >> 3) & 1
    case 3: {
        pg8::Prob p0{XA, (const bf16_t*)(p.ws_() + WS_WOUT), TREAL / 256, DM / 256};
        pg8::Prob p1{XA, XA, 0, 0};
        pg8::Sched2 S; S.init(p0, p1, DM, G, cbx);
        pg8::EpiResid E{p.out_(), (float*)(p.ws_() + WS_TAIL), l == 0 ? p.in_(0) : nullptr, p.in_(1)};
        pg8::gemm_phase<pg8::EpiResid, pg8::Sched2>(p, lds, S, E);
        if (l == 0) {
            pg8::SchedSplit S2{XA, (const bf16_t*)(p.ws_() + WS_WOUT), DM / 256, 8, 256, DM, G, cbx};
            pg8::EpiResidAtomic E2{(float*)(p.ws_() + WS_TAIL)};
            DP p2 = p; asm volatile("" : "+v"(p2.tid));
            pg8::gemm_phase<pg8::EpiResidAtomic, pg8::SchedSplit>(p2, lds, S2, E2);
        }
    } break;
#endif
#if (PHMASK >> 4) & 1
    case 4: norm_rows(p, l == 0 ? 1 : 4, p.in_(19) + (size_t)l * DM); break;
#endif
#if (PHMASK >> 5) & 1
    case 5: {
        pg8::Prob p0{XA, (const bf16_t*)(p.ws_() + WS_WGU), l == 0 ? TP / 256 : TREAL / 256, 2 * DFF / 256};
        pg8::Prob p1{XA, XA, 0, 0};
        pg8::Sched2 S; S.init(p0, p1, DM, G, cbx);
        pg8::EpiSwiGLU E{(bf16_t*)(p.ws_() + WS_HID)};
        pg8::gemm_phase<pg8::EpiSwiGLU, pg8::Sched2>(p, lds, S, E);
    } break;
#endif
#if (PHMASK >> 6) & 1
    case 6: {
        pg8::Prob p0{(const bf16_t*)(p.ws_() + WS_HID), (const bf16_t*)(p.ws_() + WS_WDN), TREAL / 256, DM / 256};
        pg8::Prob p1{XA, XA, 0, 0};
        pg8::Sched2 S; S.init(p0, p1, DFF, G, cbx);
        pg8::EpiResid E{p.out_(), (float*)(p.ws_() + WS_TAIL), nullptr, nullptr};
        pg8::gemm_phase<pg8::EpiResid, pg8::Sched2>(p, lds, S, E);
        if (l == 0) {
            pg8::SchedSplit S2{(const bf16_t*)(p.ws_() + WS_HID), (const bf16_t*)(p.ws_() + WS_WDN), DM / 256, 11, 512, DFF, G, cbx};
            pg8::EpiResidAtomic E2{(float*)(p.ws_() + WS_TAIL)};
            DP p2 = p; asm volatile("" : "+v"(p2.tid));
            pg8::gemm_phase<pg8::EpiResidAtomic, pg8::SchedSplit>(p2, lds, S2, E2);
        }
    } break;
#endif
#if (PHMASK >> 7) & 1
    case 7: {
        if (l == 0) { norm_rows(p, 1, p.in_(3) + DM); prep_weights(p, lds, 1); }
        else norm_rows(p, 2, p.in_(23));
    } break;
#endif
    }
}

__global__ void __launch_bounds__(NTHREADS, 2) mega_fwd(Params pk, int ph_lo, int ph_hi) {
    DP p;
    extern __shared__ __attribute__((aligned(16))) unsigned char lds_raw[];
    LAS unsigned char* lds = (LAS unsigned char*)lds_raw;
    cg::grid_group grid = cg::this_grid();
    volatile LAS unsigned* xst = (volatile LAS unsigned*)(lds + (LDS_BYTES - 16));
    if (threadIdx.x == 0) { xst[0] = 0u; xst[1] = 0u; }
    __syncthreads();
    unsigned* xbar = (unsigned*)(pk.ws + WS_BAR);
    const unsigned xcc = xb_xcc_id();
    if (threadIdx.x == 0) (void)xb_add(&xbar[XB_XCNT(xcc)], 1u);
    const int wave_s = __builtin_amdgcn_readfirstlane(threadIdx.x >> 6);
    for (int ph = ph_lo; ph < ph_hi; ++ph) {
        { kseg_t ks = (kseg_t)__builtin_amdgcn_kernarg_segment_ptr(); unsigned z0 = 0u; asm volatile("" : "+s"(z0));
          int t = wave_s * 64 + (int)__builtin_amdgcn_mbcnt_hi(~0u, __builtin_amdgcn_mbcnt_lo(~0u, z0)), b = blockIdx.x, n = gridDim.x;
          asm volatile("" : "+s"(ks), "+v"(t), "+s"(b), "+s"(n));
          p.ks = ks; p.tid = t; p.bid = b; p.nb = n; }
        run_phase(p, lds, ph);
#if REPMASK
        { const int j2 = (ph - 1) % 8, kk = (ph == 0) ? 0 : (j2 < 2 ? j2 + 1 : (j2 == 2 ? 8 : j2));
          if (((REPMASK >> kk) & 1) && ph != 16) { grid.sync(); run_phase(p, lds, ph); } }
#endif
        if (ph + 1 < ph_hi) {
            if (ph == ph_lo) grid.sync();
            else xcd_barrier(xbar, xcc, xst, gridDim.x, p.tid);
        }
    }
}

extern "C" void kernel_launch(void* const* d_in, const int* in_sizes, int n_in, void* d_out, int out_size, void* d_ws, size_t ws_size, hipStream_t stream) {
    static int grid = 0;
    if (grid == 0) {
        if (n_in != 24 || ws_size < WS_END) { fprintf(stderr, "kernel_launch: need 24 inputs and %zu bytes of workspace (got %d, %zu)\n", (size_t)WS_END, n_in, ws_size); grid = -1; return; }
        int dev = 0, cus = 0, per_cu = 0;
        hipGetDevice(&dev);
        hipDeviceGetAttribute(&cus, hipDeviceAttributeMultiprocessorCount, dev);
        if (hipFuncSetAttribute((const void*)mega_fwd, hipFuncAttributeMaxDynamicSharedMemorySize, LDS_BYTES) != hipSuccess) { fprintf(stderr, "hipFuncSetAttribute failed\n"); grid = -1; return; }
        hipOccupancyMaxActiveBlocksPerMultiprocessor(&per_cu, (const void*)mega_fwd, NTHREADS, LDS_BYTES);
        if (per_cu < 1) per_cu = 1;
        (void)hipGetLastError();
        grid = cus;
    }
    if (grid < 0) return;
    Params p{};
    for (int i = 0; i < 24; ++i) p.in[i] = (const float*)d_in[i];
    p.out = (float*)d_out; p.ws = (unsigned char*)d_ws;
#if MEGA
    (void)hipMemsetAsync((char*)d_ws + WS_BAR, 0, 16384, stream);
    int lo = 0, hi = NPHASES;
    void* args[] = {&p, &lo, &hi};
    hipError_t e = hipLaunchCooperativeKernel((const void*)mega_fwd, dim3(grid), dim3(NTHREADS), args, LDS_BYTES, stream);
    if (e != hipSuccess) fprintf(stderr, "cooperative launch failed: %s (grid %d)\n", hipGetErrorString(e), grid);
#else
    for (int ph = 0; ph < NPHASES; ++ph) hipLaunchKernelGGL(mega_fwd, dim3(grid), dim3(NTHREADS), LDS_BYTES, stream, p, ph, ph + 1);
#endif
}
```

```cpp
#include <hip/hip_runtime.h>
#include <hip/hip_cooperative_groups.h>
#include <cstdio>
namespace cg = cooperative_groups;

#ifndef PHMASK
#define PHMASK 511
#endif
#ifndef SUB
#define SUB 7
#endif
#ifndef REPMASK
#define REPMASK 0
#endif
#ifndef HYREP
#define HYREP 1
#endif
#ifndef MEGA
#define MEGA 1
#endif

#define LAS __attribute__((address_space(3)))
typedef unsigned short bf16_t;
typedef short bf16x8 __attribute__((ext_vector_type(8)));
typedef float f32x4 __attribute__((ext_vector_type(4)));
typedef float f32x16 __attribute__((ext_vector_type(16)));
typedef unsigned u32x4 __attribute__((ext_vector_type(4)));
typedef unsigned u32x2 __attribute__((ext_vector_type(2)));

constexpr int DM = 2048, TREAL = 32768, TTOK = 32864, TP = 33024, DFF = 5632;
constexpr int NTHREADS = 512;
constexpr int LDS_BYTES = 147456;
constexpr float EPSN = 1e-6f;

constexpr size_t WS_TAIL = 0;
constexpr size_t WS_XA   = WS_TAIL + (size_t)256 * DM * 4;
constexpr size_t WS_WIN  = WS_XA + (size_t)TP * DM * 2;
constexpr size_t WS_WOUT = WS_WIN + (size_t)4096 * DM * 2;
constexpr size_t WS_WGU  = WS_WOUT + (size_t)DM * DM * 2;
constexpr size_t WS_WDN  = WS_WGU + (size_t)2 * DFF * DM * 2;
constexpr size_t WS_H3   = WS_WDN + (size_t)DM * DFF * 2;
constexpr size_t WS_W4T  = WS_H3 + (size_t)2 * (8208 + 4112) * 64 * 4;
constexpr size_t WS_BIG  = WS_W4T + (size_t)4096 * 64 * 4;
constexpr size_t WS_P    = WS_BIG;
constexpr size_t WS_UT   = WS_P + (size_t)TP * 1024 * 2;
constexpr size_t WS_GFS  = WS_UT + (size_t)3072 * TP * 2;
constexpr size_t WS_GFP  = WS_GFS + (size_t)2048 * 16416 * 2;
constexpr size_t WS_HID  = WS_BIG;
constexpr size_t WS_BAR  = WS_BIG + (size_t)TP * DFF * 2;
constexpr size_t WS_END  = WS_BAR + 16384;
static_assert(WS_GFP + (size_t)2048 * 8224 * 2 <= WS_BAR, "big region");

struct Params {
    const float* in[24];
    float* out;
    unsigned char* ws;
};
typedef const __attribute__((address_space(4))) unsigned long long* kseg_t;
struct DP {
    kseg_t ks; int tid, bid, nb;
    __device__ __forceinline__ const float* in_(int k) const { return (const float*)ks[k]; }
    __device__ __forceinline__ float* out_() const { return (float*)ks[24]; }
    __device__ __forceinline__ unsigned char* ws_() const { return (unsigned char*)ks[25]; }
};

__device__ __forceinline__ unsigned cvt_pk_bf16(float lo, float hi) { unsigned r; asm volatile("v_cvt_pk_bf16_f32 %0, %1, %2" : "=v"(r) : "v"(lo), "v"(hi)); return r; }
__device__ __forceinline__ bf16_t f2bf(float f) { return (bf16_t)(cvt_pk_bf16(f, 0.f) & 0xffffu); }
__device__ __forceinline__ float bf2f(unsigned v) { return __uint_as_float(v << 16); }
__device__ __forceinline__ float bflo(unsigned w) { return __uint_as_float(w << 16); }
__device__ __forceinline__ float bfhi(unsigned w) { return __uint_as_float(w & 0xffff0000u); }
__device__ __forceinline__ float wave_sum(float v) {
#pragma unroll
    for (int o = 32; o >= 1; o >>= 1) v += __shfl_xor(v, o);
    return v;
}
__device__ __forceinline__ int seq_rbase(int sq) { return sq < 4 ? sq * 4096 : 16384 + (sq - 4) * 8192; }
__device__ __forceinline__ int seq_row(int sq, int p) { return p < 16 ? TREAL + 16 * sq + p : seq_rbase(sq) + p - 16; }

namespace pg8 {
constexpr int BM = 256, BK = 64, HALF = 128, HTB = HALF * BK * 2, STAGE_BYTES = 8 * HTB, NXCD = 8, WGM = 8;
__device__ __forceinline__ int lds_byte(int r, int c) { const int st = (r >> 4) * 2 + (c >> 5), rr = r & 15, cc = c & 31, ob = rr * 64 + cc * 2; return st * 1024 + (ob ^ (((ob >> 9) & 1) << 5)); }
__device__ __forceinline__ void stage_rc(int b, int& R, int& C) { const int st = b / 1024, sb = b % 1024, swz = sb ^ (((sb >> 9) & 1) << 5); R = (st >> 1) * 16 + swz / 64; C = (st & 1) * 32 + (swz % 64) / 2; }
__device__ __forceinline__ int perm32(int rho) { const int n = rho >> 4, i = rho & 15; return 8 * (i >> 2) + 4 * n + (i & 3); }

struct Unit { const char* a; const char* b; int pm, pn, prob; };
struct Prob { const bf16_t* A; const bf16_t* Bt; int nM, nN; };
struct Sched2 {
    const bf16_t* A0; const bf16_t* B0; const bf16_t* A1; const bf16_t* B1; int nM0, nN0, nM1, nN1, nwg0, nwg1; int K, ld, G, c;
    __device__ __forceinline__ void init(const Prob& p0, const Prob& p1, int K_, int G_, int c_) { A0 = p0.A; B0 = p0.Bt; A1 = p1.A; B1 = p1.Bt; nM0 = p0.nM; nN0 = p0.nN; nM1 = p1.nM; nN1 = p1.nN;
        nwg0 = nM0 * nN0; nwg1 = nM1 * nN1; K = K_; ld = K_; G = G_; c = c_; }
    __device__ __forceinline__ bool next(int i, Unit& u) const {
        long L = (long)i * G + c; int q = 0;
        if (L >= nwg0) { L -= nwg0; q = 1; if (L >= nwg1) return false; }
        const int nM = q ? nM1 : nM0, nN = q ? nN1 : nN0, nw = q ? nwg1 : nwg0;
        int wgid = (int)L; { const int qq = nw / NXCD, r = nw % NXCD, xcd = wgid % NXCD, off = wgid / NXCD; wgid = (xcd < r ? xcd * (qq + 1) : r * (qq + 1) + (xcd - r) * qq) + off; }
        const int nig = WGM * nN, gid = wgid / nig, fm = gid * WGM, gsz = (nM - fm) < WGM ? (nM - fm) : WGM;
        u.pm = fm + ((wgid % nig) % gsz); u.pn = (wgid % nig) / gsz; u.prob = q;
        const size_t tstep = (size_t)BM * K * 2;
        u.a = (const char*)(q ? A1 : A0) + (size_t)u.pm * tstep; u.b = (const char*)(q ? B1 : B0) + (size_t)u.pn * tstep;
        return true;
    }
};

struct EpiStore {
    static constexpr bool PERM = true;
    bf16_t* O[2]; int ldc[2];
    __device__ __forceinline__ void operator()(const f32x4 (&acc)[2][2][4][2], const Unit& u, int wr, int wc, int fr, int fq) const {
        bf16_t* base = u.prob ? O[1] : O[0]; const int ld = u.prob ? ldc[1] : ldc[0];
        const int row0 = u.pm * BM + wr * 64 + fr, col0 = u.pn * BM + wc * 32 + 8 * fq;
#pragma unroll
        for (int ai = 0; ai < 2; ++ai)
#pragma unroll
            for (int m = 0; m < 4; ++m) { bf16_t* rowp = base + (size_t)(row0 + ai * HALF + m * 16) * ld + col0;
#pragma unroll
                for (int bj = 0; bj < 2; ++bj) { const f32x4 v0 = acc[ai][bj][m][0], v1 = acc[ai][bj][m][1];
                    u32x4 w; w.x = cvt_pk_bf16(v0[0], v0[1]); w.y = cvt_pk_bf16(v0[2], v0[3]); w.z = cvt_pk_bf16(v1[0], v1[1]); w.w = cvt_pk_bf16(v1[2], v1[3]);
                    *(u32x4*)(rowp + bj * HALF) = w; } }
    }
};
struct EpiResid {
    static constexpr bool PERM = false;
    float* hmain; float* htail; const float* x0; const float* x1;
    __device__ __forceinline__ void operator()(const f32x4 (&acc)[2][2][4][2], const Unit& u, int wr, int wc, int fr, int fq) const {
        float* base = (u.pm < TREAL / BM) ? hmain + (size_t)u.pm * BM * DM : htail;
        const float* rbase = (x0 && u.pm < TREAL / BM) ? ((u.pm < 64) ? x0 + (size_t)u.pm * BM * DM : x1 + (size_t)(u.pm - 64) * BM * DM) : base;
        const int row0 = wr * 64 + fr, col0 = u.pn * BM + wc * 32 + 4 * fq;
#pragma unroll
        for (int ai = 0; ai < 2; ++ai)
#pragma unroll
            for (int m = 0; m < 4; ++m) { const size_t ro = (size_t)(row0 + ai * HALF + m * 16) * DM + col0; float* rowp = base + ro; const float* rrow = rbase + ro;
#pragma unroll
                for (int bj = 0; bj < 2; ++bj)
#pragma unroll
                    for (int n = 0; n < 2; ++n) *(f32x4*)(rowp + bj * HALF + n * 16) = *(const f32x4*)(rrow + bj * HALF + n * 16) + acc[ai][bj][m][n];
                asm volatile("" ::: "memory"); }
    }
};
struct EpiSwiGLU {
    static constexpr bool PERM = true;
    bf16_t* O;
    __device__ __forceinline__ void operator()(const f32x4 (&acc)[2][2][4][2], const Unit& u, int wr, int wc, int fr, int fq) const {
        const int row0 = u.pm * BM + wr * 64 + fr, col0 = u.pn * HALF + wc * 32 + 8 * fq;
#pragma unroll
        for (int ai = 0; ai < 2; ++ai)
#pragma unroll
            for (int m = 0; m < 4; ++m) { bf16_t* rowp = O + (size_t)(row0 + ai * HALF + m * 16) * DFF + col0;
                float r[8];
#pragma unroll
                for (int n = 0; n < 2; ++n)
#pragma unroll
                    for (int e = 0; e < 4; ++e) { const float g = acc[ai][0][m][n][e], up = acc[ai][1][m][n][e];
                        r[n * 4 + e] = g * __builtin_amdgcn_rcpf(1.0f + __expf(-g)) * up; }
                u32x4 w; w.x = cvt_pk_bf16(r[0], r[1]); w.y = cvt_pk_bf16(r[2], r[3]); w.z = cvt_pk_bf16(r[4], r[5]); w.w = cvt_pk_bf16(r[6], r[7]);
                *(u32x4*)rowp = w; }
    }
};

struct SchedSplit {
    const bf16_t* A; const bf16_t* Bt; int nN, nK, K, ld, G, c;
    __device__ __forceinline__ bool next(int i, Unit& u) const {
        const long L = (long)i * G + c; if (L >= nN * nK) return false;
        const int pn = (int)L % nN, kc = (int)L / nN;
        u.pm = TREAL / BM; u.pn = pn; u.prob = 0;
        u.a = (const char*)(A + (size_t)u.pm * BM * ld + (size_t)kc * K); u.b = (const char*)(Bt + (size_t)pn * BM * ld + (size_t)kc * K);
        return true;
    }
};
struct EpiResidAtomic {
    static constexpr bool PERM = false;
    float* htail;
    __device__ __forceinline__ void operator()(const f32x4 (&acc)[2][2][4][2], const Unit& u, int wr, int wc, int fr, int fq) const {
        const int col0 = u.pn * BM + wc * 32 + 4 * fq;
#pragma unroll
        for (int m = 0; m < 4; ++m) { const int row = wr * 64 + m * 16 + fr;
            if (row < 96) { float* rowp = htail + (size_t)row * DM + col0;
#pragma unroll
                for (int bj = 0; bj < 2; ++bj)
#pragma unroll
                    for (int n = 0; n < 2; ++n)
#pragma unroll
                        for (int e = 0; e < 4; ++e) atomicAdd(rowp + bj * HALF + n * 16 + e, acc[0][bj][m][n][e]); } }
    }
};
template <class Epi, class Sched>
__device__ __forceinline__ void gemm_phase(const DP& p, LAS unsigned char* lds, const Sched& S, const Epi& E) {
    const int tid = p.tid, wid = __builtin_amdgcn_readfirstlane(tid >> 6), lane = tid & 63, wr = wid >> 2, wc = wid & 3, fr = lane & 15, fq = lane >> 4;
    const int K = S.ld, nt = S.K / BK;
    unsigned voffA[2], voffB[2];
#pragma unroll
    for (int i = 0; i < 2; ++i) { int R, C; stage_rc(tid * 16 + i * 8192, R, C); const int Rb = Epi::PERM ? ((R & ~31) + perm32(R & 31)) : R;
        voffA[i] = (unsigned)(R * K + C) * 2u; voffB[i] = (unsigned)(Rb * K + C) * 2u; }
    const size_t kstep = (size_t)(BK * 2);
    const size_t hstep = (size_t)HALF * K * 2;
    const unsigned ldsw = (unsigned)wid * 1024u;
    const int aoff = lds_byte(wr * 64 + fr, fq * 8), boff = lds_byte(wc * 32 + fr, fq * 8);
#define PG8_SA(b, h) (((b) * 2 + (h)) * HTB)
#define PG8_SB(b, h) ((4 + (b) * 2 + (h)) * HTB)
#define PG8_STAGE(bufoff, gbase, voff) do { _Pragma("unroll") for (int _i = 0; _i < 2; ++_i) \
        __builtin_amdgcn_global_load_lds((const unsigned*)((const char*)(gbase) + (voff)[_i]), (LAS unsigned*)(lds + (bufoff) + ldsw + _i * 8192), 16, 0, 0); } while (0)
#define PG8_LDA(dst, b, h) do { _Pragma("unroll") for (int m = 0; m < 4; ++m) _Pragma("unroll") for (int k = 0; k < 2; ++k) dst[m][k] = *(const LAS bf16x8*)(lds + PG8_SA(b, h) + aoff + m * 2048 + k * 1024); } while (0)
#define PG8_LDB(dst, b, h) do { _Pragma("unroll") for (int n = 0; n < 2; ++n) _Pragma("unroll") for (int k = 0; k < 2; ++k) dst[n][k] = *(const LAS bf16x8*)(lds + PG8_SB(b, h) + boff + n * 2048 + k * 1024); } while (0)
#define PG8_MMA(ai, bj, At, Bt) do { __builtin_amdgcn_s_setprio(1); _Pragma("unroll") for (int m = 0; m < 4; ++m) _Pragma("unroll") for (int n = 0; n < 2; ++n) _Pragma("unroll") for (int k = 0; k < 2; ++k) \
        acc[ai][bj][m][n] = __builtin_amdgcn_mfma_f32_16x16x32_bf16(Bt[n][k], At[m][k], acc[ai][bj][m][n], 0, 0, 0); __builtin_amdgcn_s_setprio(0); } while (0)
#define PG8_WAIT_V(n) asm volatile("s_waitcnt vmcnt(" #n ")" ::: "memory")
#define PG8_WAIT_L(n) asm volatile("s_waitcnt lgkmcnt(" #n ")" ::: "memory")
#define PG8_BAR __builtin_amdgcn_s_barrier()
#define PG8_SCHED __builtin_amdgcn_sched_barrier(0)
    Unit cur, nxt; int ui = 0;
    if (!S.next(0, cur)) return;
    f32x4 acc[2][2][4][2];
#pragma unroll
    for (int a = 0; a < 2; ++a)
#pragma unroll
        for (int b = 0; b < 2; ++b)
#pragma unroll
            for (int m = 0; m < 4; ++m)
#pragma unroll
                for (int n = 0; n < 2; ++n) acc[a][b][m][n] = (f32x4){0.f, 0.f, 0.f, 0.f};
    bf16x8 At[4][2], B0[2][2], B1[2][2];
    const char* cA = cur.a; const char* cB = cur.b;
    PG8_STAGE(PG8_SB(0, 0), cB, voffB); PG8_STAGE(PG8_SA(0, 0), cA, voffA); PG8_STAGE(PG8_SB(0, 1), cB + hstep, voffB); PG8_STAGE(PG8_SA(0, 1), cA + hstep, voffA);
    if (wr == 1) PG8_BAR;
    PG8_WAIT_V(4); PG8_BAR;
    PG8_STAGE(PG8_SB(1, 0), cB + kstep, voffB); PG8_STAGE(PG8_SA(1, 0), cA + kstep, voffA); PG8_STAGE(PG8_SB(1, 1), cB + hstep + kstep, voffB);
    PG8_WAIT_V(6); PG8_BAR;
    for (;;) {
        const bool has_next = S.next(ui + 1, nxt);
        const char* nA = has_next ? nxt.a : cA; const char* nB = has_next ? nxt.b : cB;
        for (int t = 0; t < nt; t += 2) {
            const bool last = (t == nt - 2);
            const char* a1 = cA + (size_t)(t + 1) * kstep;
            const char* a2 = last ? nA : cA + (size_t)(t + 2) * kstep; const char* b2 = last ? nB : cB + (size_t)(t + 2) * kstep;
            const char* a3 = a2 + kstep; const char* b3 = b2 + kstep;
            PG8_LDB(B0, 0, 0); PG8_SCHED; PG8_LDA(At, 0, 0); PG8_STAGE(PG8_SA(1, 1), a1 + hstep, voffA);
            PG8_WAIT_L(8); PG8_BAR; PG8_WAIT_L(0); PG8_MMA(0, 0, At, B0); PG8_BAR; PG8_SCHED;
            PG8_LDB(B1, 0, 1); PG8_STAGE(PG8_SB(0, 0), b2, voffB);
            PG8_BAR; PG8_WAIT_L(0); PG8_MMA(0, 1, At, B1); PG8_BAR;
            PG8_LDA(At, 0, 1); PG8_STAGE(PG8_SA(0, 0), a2, voffA);
            PG8_BAR; PG8_WAIT_L(0); PG8_MMA(1, 0, At, B0); PG8_BAR; PG8_SCHED;
            PG8_STAGE(PG8_SB(0, 1), b2 + hstep, voffB);
            PG8_WAIT_V(6); PG8_BAR; PG8_MMA(1, 1, At, B1); PG8_BAR;
            PG8_LDB(B0, 1, 0); PG8_SCHED; PG8_LDA(At, 1, 0); PG8_STAGE(PG8_SA(0, 1), a2 + hstep, voffA);
            PG8_WAIT_L(8); PG8_BAR; PG8_WAIT_L(0); PG8_MMA(0, 0, At, B0); PG8_BAR; PG8_SCHED;
            PG8_LDB(B1, 1, 1); PG8_STAGE(PG8_SB(1, 0), b3, voffB);
            PG8_BAR; PG8_WAIT_L(0); PG8_MMA(0, 1, At, B1); PG8_BAR;
            PG8_LDA(At, 1, 1); PG8_STAGE(PG8_SA(1, 0), a3, voffA);
            PG8_BAR; PG8_WAIT_L(0); PG8_MMA(1, 0, At, B0); PG8_BAR; PG8_SCHED;
            PG8_STAGE(PG8_SB(1, 1), b3 + hstep, voffB);
            PG8_WAIT_V(6); PG8_BAR; PG8_MMA(1, 1, At, B1); PG8_BAR;
        }
        E(acc, cur, wr, wc, fr, fq);
        if (!has_next) break;
#pragma unroll
        for (int a = 0; a < 2; ++a)
#pragma unroll
            for (int b = 0; b < 2; ++b)
#pragma unroll
                for (int m = 0; m < 4; ++m)
#pragma unroll
                    for (int n = 0; n < 2; ++n) acc[a][b][m][n] = (f32x4){0.f, 0.f, 0.f, 0.f};
        cur = nxt; cA = nA; cB = nB; ++ui;
    }
    PG8_WAIT_V(0);
    if (wr == 0) PG8_BAR;
    PG8_BAR;
#undef PG8_SA
#undef PG8_SB
#undef PG8_STAGE
#undef PG8_LDA
#undef PG8_LDB
#undef PG8_MMA
#undef PG8_WAIT_V
#undef PG8_WAIT_L
#undef PG8_BAR
#undef PG8_SCHED
}
}

__device__ __forceinline__ void norm_rows(const DP& p, int mode, const float* gain) {
    const int lane = p.tid & 63, gw = p.bid * 8 + (p.tid >> 6), nw = p.nb * 8;
    float* tail = (float*)(p.ws_() + WS_TAIL); bf16_t* hn = (bf16_t*)(p.ws_() + WS_XA);
    const int nrows = (mode == 2 || mode == 4) ? TREAL : TP;
    f32x4 g[8];
#pragma unroll
    for (int j = 0; j < 8; ++j) g[j] = *(const f32x4*)(gain + 4 * (lane + 64 * j));
#define NR_SRC(rr) ((mode == 0) ? (((rr) < 16384) ? p.in_(0) + (size_t)(rr) * DM : ((rr) < TREAL) ? p.in_(1) + (size_t)((rr) - 16384) * DM : p.in_(2) + (size_t)(((rr) - TREAL) & 15) * DM) \
                                : (((rr) < TREAL) ? p.out_() + (size_t)(rr) * DM : tail + (size_t)((rr) - TREAL) * DM))
    f32x4 v[8], vn[8];
    if (gw < nrows && gw < TTOK) { const float* src = NR_SRC(gw);
#pragma unroll
        for (int j = 0; j < 8; ++j) v[j] = *(const f32x4*)(src + 4 * (lane + 64 * j)); }
    for (int r = gw; r < nrows; r += nw) {
        const int rn = r + nw;
        if (rn < nrows && rn < TTOK) { const float* srcn = NR_SRC(rn);
#pragma unroll
            for (int j = 0; j < 8; ++j) vn[j] = *(const f32x4*)(srcn + 4 * (lane + 64 * j)); }
        if (r >= TTOK) {
#pragma unroll
            for (int j = 0; j < 8; ++j) { *(u32x2*)(hn + (size_t)r * DM + 4 * (lane + 64 * j)) = (u32x2){0u, 0u};
                if (mode == 0) *(f32x4*)(tail + (size_t)(r - TREAL) * DM + 4 * (lane + 64 * j)) = (f32x4){0.f, 0.f, 0.f, 0.f}; }
        } else {
            float* hrow = (r < TREAL) ? p.out_() + (size_t)r * DM : tail + (size_t)(r - TREAL) * DM;
            float ss = 0.f;
#pragma unroll
            for (int j = 0; j < 8; ++j) ss += v[j][0] * v[j][0] + v[j][1] * v[j][1] + v[j][2] * v[j][2] + v[j][3] * v[j][3];
            ss = wave_sum(ss);
            const float rstd = 1.0f / sqrtf(ss * (1.0f / DM) + EPSN);
#pragma unroll
            for (int j = 0; j < 8; ++j) {
                const f32x4 o = v[j] * rstd * g[j];
                if (mode == 0 && r >= TREAL) *(f32x4*)(hrow + 4 * (lane + 64 * j)) = v[j];
                if (mode == 2) *(f32x4*)(hrow + 4 * (lane + 64 * j)) = o;
                else { u32x2 w; w.x = cvt_pk_bf16(o[0], o[1]); w.y = cvt_pk_bf16(o[2], o[3]); *(u32x2*)(hn + (size_t)r * DM + 4 * (lane + 64 * j)) = w; }
            }
        }
#pragma unroll
        for (int j = 0; j < 8; ++j) v[j] = vn[j];
    }
#undef NR_SRC
}

__device__ __forceinline__ void transpose_cvt(const DP& p, LAS unsigned char* lds, const float* src, int K, int N, bf16_t* dst, int ldd, int koff, int mode) {
    LAS float* tile = (LAS float*)lds;
    const int tid = p.tid, nkt = K / 64, nnt = N / 64, ntile = nkt * nnt;
    for (int t0 = p.bid * 4; t0 < ntile; t0 += p.nb * 4) {
        f32x4 v[4][2];
#pragma unroll
        for (int u = 0; u < 4; ++u) { const int t = (t0 + u < ntile) ? t0 + u : ntile - 1; const int k0 = (t / nnt) * 64, n0 = (t % nnt) * 64;
#pragma unroll
            for (int it = 0; it < 2; ++it) { const int e = tid + it * 512, kk = e >> 4, n4 = e & 15; v[u][it] = *(const f32x4*)(src + (size_t)(k0 + kk) * N + n0 + 4 * n4); } }
#pragma unroll
        for (int u = 0; u < 4; ++u)
#pragma unroll
            for (int it = 0; it < 2; ++it) { const int e = tid + it * 512, kk = e >> 4, n4 = e & 15; LAS float* tp = tile + u * 4160 + kk * 65 + 4 * n4;
                tp[0] = v[u][it][0]; tp[1] = v[u][it][1]; tp[2] = v[u][it][2]; tp[3] = v[u][it][3]; }
        __syncthreads();
#pragma unroll
        for (int u = 0; u < 4; ++u) if (t0 + u < ntile) { const int t = t0 + u, k0 = (t / nnt) * 64, n0 = (t % nnt) * 64;
            const int nn = tid >> 3, k8 = tid & 7; float f[8];
#pragma unroll
            for (int j = 0; j < 8; ++j) f[j] = tile[u * 4160 + (8 * k8 + j) * 65 + nn];
            const int n = n0 + nn; const int drow = (mode == 0) ? n : ((n >> 7) * 256 + (n & 127) + (mode == 2 ? 128 : 0));
            u32x4 w; w.x = cvt_pk_bf16(f[0], f[1]); w.y = cvt_pk_bf16(f[2], f[3]); w.z = cvt_pk_bf16(f[4], f[5]); w.w = cvt_pk_bf16(f[6], f[7]);
            *(u32x4*)(dst + (size_t)drow * ldd + koff + k0 + 8 * k8) = w; }
        __syncthreads();
    }
}
__device__ __forceinline__ void fold_pool(const DP& p, const float* pw, const float* sc, const float* wo, bf16_t* dst) {
    const int tid = p.tid;
    for (int it = p.bid; it < 512; it += p.nb) {
        const int g = it >> 7, c8 = (it >> 2) & 31, n = (it & 3) * 512 + tid;
        float acc[8];
#pragma unroll
        for (int e = 0; e < 8; ++e) acc[e] = 0.f;
        const float* pwr = pw + (size_t)(g * 256 + c8 * 8) * 256;
#pragma unroll 1
        for (int d0 = 0; d0 < 256; d0 += 16) {
            float wv[16];
#pragma unroll
            for (int dd = 0; dd < 16; ++dd) wv[dd] = wo[(size_t)(g * 256 + d0 + dd) * DM + n];
#pragma unroll
            for (int dd = 0; dd < 16; ++dd) { const float w = wv[dd] * sc[g * 256 + d0 + dd];
#pragma unroll
                for (int e = 0; e < 8; ++e) acc[e] += pwr[e * 256 + d0 + dd] * w; }
        }
        u32x4 w; w.x = cvt_pk_bf16(acc[0], acc[1]); w.y = cvt_pk_bf16(acc[2], acc[3]); w.z = cvt_pk_bf16(acc[4], acc[5]); w.w = cvt_pk_bf16(acc[6], acc[7]);
        *(u32x4*)(dst + (size_t)n * DM + g * 256 + c8 * 8) = w;
    }
}
__device__ __forceinline__ void prep_early(const DP& p, LAS unsigned char* lds, int l) {
    transpose_cvt(p, lds, p.in_(4) + (size_t)l * DM * 4096, DM, 4096, (bf16_t*)(p.ws_() + WS_WIN), DM, 0, 0);
    transpose_cvt(p, lds, p.in_(18) + (size_t)l * DM * DM + (size_t)1024 * DM, 1024, DM, (bf16_t*)(p.ws_() + WS_WOUT), DM, 1024, 0);
    fold_pool(p, p.in_(5) + (size_t)l * 4 * 256 * 256, p.in_(6) + (size_t)l * 1024, p.in_(18) + (size_t)l * DM * DM, (bf16_t*)(p.ws_() + WS_WOUT));
}
__device__ __forceinline__ void prep_late(const DP& p, LAS unsigned char* lds, int l) {
    transpose_cvt(p, lds, p.in_(20) + (size_t)l * DM * DFF, DM, DFF, (bf16_t*)(p.ws_() + WS_WGU), DM, 0, 1);
    transpose_cvt(p, lds, p.in_(21) + (size_t)l * DM * DFF, DM, DFF, (bf16_t*)(p.ws_() + WS_WGU), DM, 0, 2);
    transpose_cvt(p, lds, p.in_(22) + (size_t)l * DFF * DM, DFF, DM, (bf16_t*)(p.ws_() + WS_WDN), DFF, 0, 0);
    { const float* w4 = p.in_(16) + (size_t)l * 64 * 4096; float* w4t = (float*)(p.ws_() + WS_W4T);
      for (int i = p.bid * NTHREADS + p.tid; i < 4096 * 64; i += p.nb * NTHREADS) w4t[i] = w4[(size_t)(i & 63) * 4096 + (i >> 6)]; }
}

__device__ __forceinline__ void mlp_layer(LAS float* hl, int lane, int nin, const float* w, const float* b, const float* fr) {
    float acc[64];
#pragma unroll
    for (int j = 0; j < 64; ++j) acc[j] = b[j];
#pragma unroll 1
    for (int i = 0; i < nin; ++i) {
        const float hv = hl[i * 64 + lane];
#pragma unroll
        for (int j = 0; j < 64; ++j) acc[j] += hv * w[i * 64 + j];
    }
#pragma unroll
    for (int j = 0; j < 64; ++j) hl[j * 64 + lane] = __sinf(fr[j] * acc[j]);
}
__device__ __forceinline__ void filter_h3(const DP& p, LAS unsigned char* lds, int l) {
    const int lane = p.tid & 63, wv = __builtin_amdgcn_readfirstlane(p.tid >> 6), gw = __builtin_amdgcn_readfirstlane(p.bid * 8 + (p.tid >> 6)), nw = p.nb * 8;
    const float* w1 = p.in_(9) + (size_t)l * 33 * 64; const float* b1 = p.in_(10) + l * 64;
    const float* w2 = p.in_(11) + (size_t)l * 64 * 64; const float* b2 = p.in_(12) + l * 64;
    const float* w3 = p.in_(13) + (size_t)l * 64 * 64; const float* b3 = p.in_(14) + l * 64;
    const float* fr = p.in_(15) + l * 64;
    float* h3 = (float*)(p.ws_() + WS_H3) + (size_t)l * (8208 + 4112) * 64;
    LAS float* hl = (LAS float*)lds + wv * 4096;
    int item0 = gw - l * (nw / 2); if (item0 < 0) item0 += nw;
    for (int item = item0; item < 129 + 65; item += nw) {
        const int tr = item < 129 ? 1 : 0, tile = tr ? item : item - 129, L = tr ? 8208 : 4112;
        const int n = tile * 64 + lane; const bool valid = n < L;
        const float nf = (float)n, t = nf / (float)(L - 1);
        hl[lane] = t;
#pragma unroll
        for (int b = 0; b < 16; ++b) { const float band = 1e-4f + (float)b * ((15.0f - 1e-4f) / 15.0f);
            const float ang = (6.283185307179586f / (float)L) * nf * band; hl[(1 + b) * 64 + lane] = __cosf(ang); hl[(17 + b) * 64 + lane] = -__sinf(ang); }
        mlp_layer(hl, lane, 33, w1, b1, fr);
        mlp_layer(hl, lane, 64, w2, b2, fr);
        mlp_layer(hl, lane, 64, w3, b3, fr);
        if (valid) { float* o = h3 + (size_t)((tr ? 0 : 8208) + n) * 64;
#pragma unroll
            for (int j = 0; j < 16; ++j) *(f32x4*)(o + 4 * j) = (f32x4){hl[(4 * j) * 64 + lane], hl[(4 * j + 1) * 64 + lane], hl[(4 * j + 2) * 64 + lane], hl[(4 * j + 3) * 64 + lane]}; }
    }
}
__device__ __forceinline__ bf16x8 cvt8(const f32x4 a, const f32x4 b) { u32x4 o; o.x = cvt_pk_bf16(a[0], a[1]); o.y = cvt_pk_bf16(a[2], a[3]); o.z = cvt_pk_bf16(b[0], b[1]); o.w = cvt_pk_bf16(b[2], b[3]); return __builtin_bit_cast(bf16x8, o); }
__device__ __forceinline__ void filter_gen(const DP& p, LAS unsigned char* lds, int l) {
    const int skipb = (p.nb == 256) ? 16 : 0;
    if (p.bid < skipb) return;
    const int lane = p.tid & 63, wv = __builtin_amdgcn_readfirstlane(p.tid >> 6), gw = __builtin_amdgcn_readfirstlane((p.bid - skipb) * 8 + (p.tid >> 6)), nw = (p.nb - skipb) * 8;
    const float* w4t = (const float*)(p.ws_() + WS_W4T); const float* h3 = (const float*)(p.ws_() + WS_H3) + (size_t)l * (8208 + 4112) * 64;
    const float* skip = p.in_(17) + (size_t)l * 2 * 1024;
    LAS bf16_t* S = (LAS bf16_t*)(lds + wv * 8448);
    const int col = lane & 31, hh = lane >> 5;
    constexpr int NS = 2 * 65 * 8, NPI = 2 * 33 * 8;
    for (int item = gw; item < NS + NPI; item += nw) {
        const int tr = item < NS ? 1 : 0, it2 = tr ? item : item - NS;
        const int L = tr ? 8208 : 4112, GL = 2 * L;
        const int part = it2 & 7, bd = it2 >> 3, dir = bd & 1, b = bd >> 1, o = part >> 2, ct0 = (part & 3) * 8;
        const int nbase = 128 * b + dir;
        const float invL1 = 1.0f / (float)(L - 1);
        bf16x8 A[4][4];
#pragma unroll
        for (int r = 0; r < 4; ++r) {
            int n = nbase + 32 * r + col; n = n < L ? n : L - 1;
            const float* hr = h3 + (size_t)((tr ? 0 : 8208) + n) * 64 + 8 * hh;
#pragma unroll
            for (int s4 = 0; s4 < 4; ++s4) A[r][s4] = cvt8(*(const f32x4*)(hr + 16 * s4), *(const f32x4*)(hr + 16 * s4 + 4));
        }
        bf16_t* gbase = (bf16_t*)(p.ws_() + (tr ? WS_GFS : WS_GFP)) + (size_t)o * 1024 * GL;
        const int ebase = dir ? L + 128 * b : L - 128 * b - 128;
#pragma unroll 1
        for (int ct = 0; ct < 8; ++ct) {
            const int c = (ct0 + ct) * 32 + col;
            const float* wr = w4t + (size_t)(o * 2048 + dir * 1024 + c) * 64 + 8 * hh;
            bf16x8 Bf[4];
#pragma unroll
            for (int s4 = 0; s4 < 4; ++s4) Bf[s4] = cvt8(*(const f32x4*)(wr + 16 * s4), *(const f32x4*)(wr + 16 * s4 + 4));
            const float d0 = -3.0701134573253946f, d1 = -15.350567286626973f;
            const float kc = -fabsf(d0 + (float)c * ((d1 - d0) / 1023.0f)) * 1.4426950408889634f;
            const float sk = skip[o * 1024 + c];
#pragma unroll
            for (int r = 0; r < 4; ++r) {
                f32x16 acc;
#pragma unroll
                for (int i = 0; i < 16; ++i) acc[i] = 0.f;
#pragma unroll
                for (int s4 = 0; s4 < 4; ++s4) acc = __builtin_amdgcn_mfma_f32_32x32x16_bf16(A[r][s4], Bf[s4], acc, 0, 0, 0);
#pragma unroll
                for (int q = 0; q < 4; ++q) {
                    const int nl0 = 32 * r + 8 * q + 4 * hh;
                    float v[4];
#pragma unroll
                    for (int e = 0; e < 4; ++e) { const int n = nbase + nl0 + e; const float t = (float)n * invL1;
                        v[e] = acc[4 * q + e] * __builtin_amdgcn_exp2f(t * kc); }
                    if (r == 0 && q == 0) v[0] += (nbase + nl0 == 0 && dir == 0) ? sk : 0.f;
                    u32x2 w;
                    if (dir) { w.x = cvt_pk_bf16(v[0], v[1]); w.y = cvt_pk_bf16(v[2], v[3]); *(LAS u32x2*)(S + col * 132 + nl0) = w; }
                    else     { w.x = cvt_pk_bf16(v[3], v[2]); w.y = cvt_pk_bf16(v[1], v[0]); *(LAS u32x2*)(S + col * 132 + 124 - nl0) = w; }
                }
            }
#pragma unroll
            for (int u = 0; u < 8; ++u) {
                const int id = u * 64 + lane, colr = id >> 4, k = id & 15;
                const u32x2 lo = *(const LAS u32x2*)(S + colr * 132 + 8 * k), hi = *(const LAS u32x2*)(S + colr * 132 + 8 * k + 4);
                const int e0 = ebase + 8 * k;
                if ((unsigned)e0 <= (unsigned)(GL - 8)) *(u32x4*)(gbase + (size_t)((ct0 + ct) * 32 + colr) * GL + e0) = (u32x4){lo.x, lo.y, hi.x, hi.y};
            }
        }
    }
}

__device__ __forceinline__ void pool_acc(float (&s)[8], const u32x4 v, float sg) {
    s[0] += sg * bflo(v.x); s[1] += sg * bfhi(v.x); s[2] += sg * bflo(v.y); s[3] += sg * bfhi(v.y); s[4] += sg * bflo(v.z); s[5] += sg * bfhi(v.z); s[6] += sg * bflo(v.w); s[7] += sg * bfhi(v.w);
}
__device__ __forceinline__ void pool_window(const DP& p, LAS unsigned char* lds) {
    const bf16_t* P = (const bf16_t*)(p.ws_() + WS_P); bf16_t* mix = (bf16_t*)(p.ws_() + WS_XA);
    LAS bf16_t* T = (LAS bf16_t*)lds;
    const int tid = p.tid;
    const int nitem = (4 * 65 + 2 * 129) * 4;
    for (int item = p.bid; item < nitem; item += p.nb) {
        const int g = item & 3, ch = item >> 2;
        int sq, r, L;
        if (ch < 4 * 65) { sq = ch / 65; r = ch - sq * 65; L = 4112; } else { const int c2 = ch - 4 * 65; sq = 4 + c2 / 129; r = c2 - (sq - 4) * 129; L = 8208; }
        const int hw = 1 << g, p0 = 64 * r, nrow = 64 + 2 * hw;
        for (int idx = tid; idx < nrow * 32; idx += NTHREADS) {
            const int j = idx >> 5, c8 = idx & 31, q = p0 - hw + j;
            u32x4 v = (u32x4){0u, 0u, 0u, 0u};
            if (q >= 0 && q < L) v = *(const u32x4*)(P + (size_t)seq_row(sq, q) * 1024 + g * 256 + 8 * c8);
            *(LAS u32x4*)(T + j * 264 + 8 * c8) = v;
        }
        __syncthreads();
        {
            const int c8 = tid & 31, run = tid >> 5, pb = p0 + 4 * run;
            if (pb < L) {
                float s[8];
#pragma unroll
                for (int e = 0; e < 8; ++e) s[e] = 0.f;
                for (int t = 0; t < 2 * hw; ++t) pool_acc(s, *(const LAS u32x4*)(T + (4 * run + t) * 264 + 8 * c8), 1.0f);
#pragma unroll
                for (int i = 0; i < 4; ++i) {
                    const int pp = pb + i;
                    const int lo = pp - hw < 0 ? 0 : pp - hw, hi = pp + hw > L ? L : pp + hw;
                    const float inv = 1.0f / (float)(hi - lo);
                    const u32x4 v = *(const LAS u32x4*)(T + (4 * run + i + hw) * 264 + 8 * c8);
                    u32x4 w;
                    w.x = cvt_pk_bf16(s[0] * inv - bflo(v.x), s[1] * inv - bfhi(v.x)); w.y = cvt_pk_bf16(s[2] * inv - bflo(v.y), s[3] * inv - bfhi(v.y));
                    w.z = cvt_pk_bf16(s[4] * inv - bflo(v.z), s[5] * inv - bfhi(v.z)); w.w = cvt_pk_bf16(s[6] * inv - bflo(v.w), s[7] * inv - bfhi(v.w));
                    if (pp < L) *(u32x4*)(mix + (size_t)seq_row(sq, pp) * DM + g * 256 + 8 * c8) = w;
                    if (i < 3) { pool_acc(s, *(const LAS u32x4*)(T + (4 * run + i + 2 * hw) * 264 + 8 * c8), 1.0f); pool_acc(s, *(const LAS u32x4*)(T + (4 * run + i) * 264 + 8 * c8), -1.0f); }
                }
            }
        }
        __syncthreads();
    }
}

constexpr int HYH_U = 0, HYH_FB = 35840, HYH_ZB = HYH_FB + 33280, HYH_RED = HYH_ZB + 512, HYH_SIZE = HYH_RED + 1024;
static_assert(2 * HYH_SIZE <= LDS_BYTES, "hyena LDS");
constexpr int FPAD = 176;
template <int TR> struct HG;
template <> struct HG<1> { static constexpr int L = 8208, B = 2, NSB = 16, BSE = 8720, NIN = 513, SQ0 = 4; };
template <> struct HG<0> { static constexpr int L = 4112, B = 4, NSB = 8,  BSE = 4416, NIN = 257, SQ0 = 0; };
__device__ __forceinline__ int uphys(int q) { return q + 8 * (q >> 7); }

struct ARaw { u32x2 w01, w23, w45; };
__device__ __forceinline__ ARaw hy_raw_a(const LAS unsigned char* p8) { ARaw r; r.w01 = *(const LAS u32x2*)p8; r.w23 = *(const LAS u32x2*)(p8 + 8); r.w45 = *(const LAS u32x2*)(p8 + 16); return r; }
__device__ __forceinline__ bf16x8 hy_fin_a(const ARaw& r, bool dsel, unsigned bsh) {
    const unsigned s0 = dsel ? r.w01.y : r.w01.x, s1 = dsel ? r.w23.x : r.w01.y, s2 = dsel ? r.w23.y : r.w23.x, s3 = dsel ? r.w45.x : r.w23.y, s4 = dsel ? r.w45.y : r.w45.x;
    u32x4 o; o.x = __builtin_amdgcn_alignbit(s1, s0, bsh); o.y = __builtin_amdgcn_alignbit(s2, s1, bsh); o.z = __builtin_amdgcn_alignbit(s3, s2, bsh); o.w = __builtin_amdgcn_alignbit(s4, s3, bsh);
    return __builtin_bit_cast(bf16x8, o);
}
template <int TR>
__device__ __forceinline__ void hy_conv(LAS unsigned char* hl, int wq, int lane, f32x16 (&acc)[4]) {
    typedef HG<TR> G;
    const LAS unsigned char* Ub = hl + HYH_U; const LAS unsigned char* FBb = hl + HYH_FB;
    asm volatile("" : "+v"(lane));
    const int n = lane & 31, h = lane >> 5;
    const int sbi = n % G::NSB, beta = n / G::NSB, sb0 = wq * G::NSB;
    const int abase = FPAD + (G::L - 1) - n + 8 * h;
    const int ab2 = 2 * abase, ab8 = ab2 & ~7; const bool dsel = (ab2 & 4) != 0; const unsigned bsh = (ab2 & 2) ? 16u : 0u;
    constexpr int KS = (G::L - 16) / 16 + 8 * (G::NSB - 1) + 1, NIT = (KS + 1) / 2, NOUT = (NIT + 3) / 4;
    const int dlo = 128 * sb0 - (G::L - 16);
    constexpr int MMAX = (G::L - 16) / 128;
#pragma unroll
    for (int r = 0; r < 4; ++r)
#pragma unroll
        for (int i = 0; i < 16; ++i) acc[r][i] = 0.f;
    bf16x8 qe[4], qo[4];
#pragma unroll
    for (int r = 0; r < 4; ++r) { qe[r] = hy_fin_a(hy_raw_a(FBb + (ab8 - 2 * (dlo + 32 * r))), dsel, bsh); qo[r] = hy_fin_a(hy_raw_a(FBb + (ab8 - 2 * (dlo + 16 + 32 * r))), dsel, bsh); }
    const int ub2 = 2 * (beta * G::BSE + 8 * h);
    int M = sbi + MMAX;
    const LAS unsigned char* zb = hl + HYH_ZB + 256;
#define HY_PB(MM, first) ({ const bool v_ = (first) ? ((unsigned)(MM) <= (unsigned)MMAX) : ((unsigned)((MM) - 1) < (unsigned)MMAX); v_ ? (Ub + ub2 + 272 * (MM)) : zb; })
    const LAS unsigned char* pb0 = HY_PB(M, true); const LAS unsigned char* pb1 = HY_PB(M, false);
    bf16x8 be = *(const LAS bf16x8*)pb0, bo = *(const LAS bf16x8*)(pb1 - 2 * (16 + 8));
    unsigned pa = (unsigned)(size_t)(FBb + (ab8 - 2 * (dlo + 128))) - 320u;
#define HY_DSR64(dst, addr, off)  asm volatile("ds_read_b64 %0, %1 offset:%2"  : "=v"(dst) : "v"(addr), "n"(off))
#define HY_DSR128(dst, addr, off) asm volatile("ds_read_b128 %0, %1 offset:%2" : "=v"(dst) : "v"(addr), "n"(off))
#pragma unroll 1
    for (int I = 0; I < NOUT; ++I) {
        const LAS unsigned char* pn0 = HY_PB(M - 1, true); const LAS unsigned char* pn1 = HY_PB(M - 1, false);
        const unsigned b1a = (unsigned)(size_t)pb1 - 256u, n0a = (unsigned)(size_t)pn0, n1a = (unsigned)(size_t)pn1 - 256u;
#pragma unroll
        for (int j = 0; j < 4; ++j) {
            ARaw ra, rb; bf16x8 nbe, nbo;
            HY_DSR64(ra.w01, pa, 320 - 64 * j);      HY_DSR64(ra.w23, pa, 320 - 64 * j + 8);      HY_DSR64(ra.w45, pa, 320 - 64 * j + 16);
            HY_DSR64(rb.w01, pa, 320 - 64 * j - 32); HY_DSR64(rb.w23, pa, 320 - 64 * j - 32 + 8); HY_DSR64(rb.w45, pa, 320 - 64 * j - 32 + 16);
            if (j < 3) { HY_DSR128(nbe, b1a, 256 - 2 * (32 * (j + 1) + 8)); HY_DSR128(nbo, b1a, 256 - 2 * (32 * (j + 1) + 16 + 8)); }
            else       { HY_DSR128(nbe, n0a, 0);                            HY_DSR128(nbo, n1a, 256 - 2 * (16 + 8)); }
#pragma unroll
            for (int r = 0; r < 4; ++r) acc[r] = __builtin_amdgcn_mfma_f32_32x32x16_bf16(qe[(j + r) & 3], be, acc[r], 0, 0, 0);
#pragma unroll
            for (int r = 0; r < 4; ++r) acc[r] = __builtin_amdgcn_mfma_f32_32x32x16_bf16(qo[(j + r) & 3], bo, acc[r], 0, 0, 0);
            asm volatile("s_waitcnt lgkmcnt(0)" : "+v"(ra.w01), "+v"(ra.w23), "+v"(ra.w45), "+v"(rb.w01), "+v"(rb.w23), "+v"(rb.w45), "+v"(nbe), "+v"(nbo), "+v"(acc[0]), "+v"(acc[1]), "+v"(acc[2]), "+v"(acc[3]));
            qe[j] = hy_fin_a(ra, dsel, bsh); qo[j] = hy_fin_a(rb, dsel, bsh);
            be = nbe; bo = nbo;
        }
        pa -= 256u; pb0 = pn0; pb1 = pn1; --M;
    }
#undef HY_DSR64
#undef HY_DSR128
#undef HY_PB
    {
        f32x16 at;
#pragma unroll
        for (int i = 0; i < 16; ++i) at[i] = 0.f;
        constexpr int MS = (G::NIN + 3) / 4;
        const int m0 = wq * MS, m1 = (m0 + MS < G::NIN) ? m0 + MS : G::NIN;
        const bool colv = n < G::B;
        const int ut2 = 2 * ((colv ? n : 0) * G::BSE + 8 * h);
#pragma unroll 4
        for (int m = m0; m < m1; ++m) {
            const int d = (G::L - 16) - 16 * m;
            const bf16x8 a = hy_fin_a(hy_raw_a(FBb + (ab8 - 2 * d)), dsel, bsh);
            const bf16x8 b = *(const LAS bf16x8*)(colv ? Ub + ut2 + 2 * (16 * m + 8 * ((16 * m) >> 7)) : zb);
            at = __builtin_amdgcn_mfma_f32_32x32x16_bf16(a, b, at, 0, 0, 0);
        }
        LAS float* RED = (LAS float*)(hl + HYH_RED);
        if (colv) {
#pragma unroll
            for (int i = 0; i < 8; ++i) { const int arow = (i & 3) + 8 * (i >> 2) + 4 * h; RED[(wq * 16 + arow) * 4 + n] = at[i]; }
        }
    }
}
template <int TR>
__device__ __forceinline__ void hy_load_stream(const DP& p, LAS unsigned char* hl, int lt, int l, int k, int c, bool toU) {
    typedef HG<TR> G;
    asm volatile("" : "+v"(lt));
    const int ch = k * 1024 + c;
    const float* cw = p.in_(7) + (size_t)l * 3 * 3072; const float* cb = p.in_(8) + (size_t)l * 3072;
    const float w0 = cw[ch], w1 = cw[3072 + ch], w2 = cw[2 * 3072 + ch], bb = cb[ch];
    const bf16_t* src = (const bf16_t*)(p.ws_() + WS_UT) + (size_t)ch * TP;
    LAS bf16_t* U = (LAS bf16_t*)(hl + HYH_U); LAS bf16_t* X = (LAS bf16_t*)(hl + HYH_FB);
    constexpr int nch = G::L / 8, NCH = G::B * nch, NI = (NCH + 255) / 256;
    constexpr int GB = 3;
#pragma unroll
    for (int g0 = 0; g0 < NI; g0 += GB) {
        u32x4 v[GB]; unsigned short xl[GB], xr[GB];
#pragma unroll
        for (int i = 0; i < GB; ++i) {
            int idx = lt + 256 * (g0 + i); idx = idx < NCH ? idx : NCH - 1;
            const int b = idx / nch, q = idx - b * nch, p0 = 8 * q, sq = G::SQ0 + b;
            const int moff = TREAL + 16 * sq, roff = seq_rbase(sq);
            const int off = p0 < 16 ? moff + p0 : roff + p0 - 16;
            v[i] = *(const u32x4*)(src + off);
            xl[i] = src[p0 == 0 ? off : (p0 == 16 ? moff + 15 : off - 1)];
            xr[i] = src[p0 + 8 >= G::L ? off : (p0 + 8 == 16 ? roff : off + 8)];
        }
#pragma unroll
        for (int i = 0; i < GB; ++i) {
            const int idx = lt + 256 * (g0 + i);
            if (g0 + i < NI && idx < NCH) {
                const int b = idx / nch, q = idx - b * nch, p0 = 8 * q;
                float x[10];
                x[0] = (p0 == 0) ? 0.f : bf2f(xl[i]);
                x[9] = (p0 + 8 >= G::L) ? 0.f : bf2f(xr[i]);
                x[1] = bflo(v[i].x); x[2] = bfhi(v[i].x); x[3] = bflo(v[i].y); x[4] = bfhi(v[i].y); x[5] = bflo(v[i].z); x[6] = bfhi(v[i].z); x[7] = bflo(v[i].w); x[8] = bfhi(v[i].w);
                float y[8];
#pragma unroll
                for (int j = 0; j < 8; ++j) y[j] = w0 * x[j] + w1 * x[j + 1] + w2 * x[j + 2] + bb;
                u32x4 w; w.x = cvt_pk_bf16(y[0], y[1]); w.y = cvt_pk_bf16(y[2], y[3]); w.z = cvt_pk_bf16(y[4], y[5]); w.w = cvt_pk_bf16(y[6], y[7]);
                LAS bf16_t* dst = toU ? U + b * G::BSE + uphys(p0) : X + b * G::L + p0;
                *(LAS u32x4*)dst = w;
            }
        }
    }
}
template <int TR>
__device__ __forceinline__ void hy_load_filter(const DP& p, LAS unsigned char* hl, int lt, int o, int c) {
    typedef HG<TR> G;
    constexpr int GL = 2 * G::L, NCH = GL / 8, NI = (NCH + 255) / 256;
    asm volatile("" : "+v"(lt));
    const bf16_t* gf = (const bf16_t*)(p.ws_() + (TR ? WS_GFS : WS_GFP)) + ((size_t)o * 1024 + c) * GL;
    LAS bf16_t* FB = (LAS bf16_t*)(hl + HYH_FB);
    u32x4 v[NI];
#pragma unroll
    for (int i = 0; i < NI; ++i) { int idx = lt + 256 * i; idx = idx < NCH ? idx : NCH - 1; v[i] = *(const u32x4*)(gf + 8 * idx); }
    if (lt < FPAD / 8) *(LAS u32x4*)(FB + 8 * lt) = (u32x4){0u, 0u, 0u, 0u};
#pragma unroll
    for (int i = 0; i < NI; ++i) { const int idx = lt + 256 * i; if (idx < NCH) *(LAS u32x4*)(FB + FPAD + 8 * idx) = v[i]; }
}
template <int TR>
__device__ __forceinline__ void hy_items(const DP& p, LAS unsigned char* lds, int l, int vcu) {
    typedef HG<TR> G;
    const int tid = p.tid, lane = tid & 63, wave = __builtin_amdgcn_readfirstlane(tid >> 6), hf = wave >> 2, wq = wave & 3, lt = tid & 255;
    LAS unsigned char* hl = lds + hf * HYH_SIZE;
    LAS bf16_t* U = (LAS bf16_t*)(hl + HYH_U); const LAS bf16_t* X = (const LAS bf16_t*)(hl + HYH_FB); const LAS float* RED = (const LAS float*)(hl + HYH_RED);
    bf16_t* UT = (bf16_t*)(p.ws_() + WS_UT);
    for (int pit = vcu; pit < 512; pit += p.nb) {
        const int c = 2 * pit + hf;
        if (lt < 32) *(LAS u32x4*)(hl + HYH_ZB + 16 * lt) = (u32x4){0u, 0u, 0u, 0u};
        hy_load_stream<TR>(p, hl, lt, l, 0, c, true);
        hy_load_filter<TR>(p, hl, lt, 0, c);
        __syncthreads();
        f32x16 acc[4];
#pragma unroll 1
        for (int rep = 0; rep < HYREP; ++rep) { hy_conv<TR>(hl, wq, lane, acc); asm volatile("" ::: "memory"); }
        __syncthreads();
        hy_load_stream<TR>(p, hl, lt, l, 1, c, false);
        __syncthreads();
        { int ln = lane; asm volatile("" : "+v"(ln)); const int n = ln & 31, hh = ln >> 5, sbi = n % G::NSB, beta = n / G::NSB, sb = wq * G::NSB + sbi;
#pragma unroll
        for (int r = 0; r < 4; ++r)
#pragma unroll
            for (int qd = 0; qd < 4; ++qd) {
                const int t0 = 128 * sb + 32 * r + 8 * qd + 4 * hh;
                const u32x2 xv = *(const LAS u32x2*)(X + beta * G::L + t0);
                u32x2 w; w.x = cvt_pk_bf16(bflo(xv.x) * acc[r][4 * qd], bfhi(xv.x) * acc[r][4 * qd + 1]); w.y = cvt_pk_bf16(bflo(xv.y) * acc[r][4 * qd + 2], bfhi(xv.y) * acc[r][4 * qd + 3]);
                *(LAS u32x2*)(U + beta * G::BSE + uphys(t0)) = w;
            }
        }
        if (lt < 16 * G::B) { const int a = lt & 15, b = lt >> 4; float y = 0.f;
#pragma unroll
            for (int w = 0; w < 4; ++w) y += RED[(w * 16 + a) * 4 + b];
            const int t = (G::L - 16) + a;
            U[b * G::BSE + uphys(t)] = f2bf(bf2f(X[b * G::L + t]) * y); }
        __syncthreads();
        hy_load_filter<TR>(p, hl, lt, 1, c);
        __syncthreads();
        hy_conv<TR>(hl, wq, lane, acc);
        __syncthreads();
        hy_load_stream<TR>(p, hl, lt, l, 2, c, false);
        __syncthreads();
        bf16_t* orow = UT + (size_t)c * TP;
        { int ln = lane; asm volatile("" : "+v"(ln)); const int n = ln & 31, hh = ln >> 5, sbi = n % G::NSB, beta = n / G::NSB, sb = wq * G::NSB + sbi;
#pragma unroll
        for (int r = 0; r < 4; ++r)
#pragma unroll
            for (int qd = 0; qd < 4; ++qd) {
                const int t0 = 128 * sb + 32 * r + 8 * qd + 4 * hh;
                const u32x2 xv = *(const LAS u32x2*)(X + beta * G::L + t0);
                u32x2 w; w.x = cvt_pk_bf16(bflo(xv.x) * acc[r][4 * qd], bfhi(xv.x) * acc[r][4 * qd + 1]); w.y = cvt_pk_bf16(bflo(xv.y) * acc[r][4 * qd + 2], bfhi(xv.y) * acc[r][4 * qd + 3]);
                *(u32x2*)(orow + seq_row(G::SQ0 + beta, t0)) = w;
            }
        }
        if (lt < 16 * G::B) { const int a = lt & 15, b = lt >> 4; float y = 0.f;
#pragma unroll
            for (int w = 0; w < 4; ++w) y += RED[(w * 16 + a) * 4 + b];
            const int t = (G::L - 16) + a;
            orow[seq_row(G::SQ0 + b, t)] = f2bf(bf2f(X[b * G::L + t]) * y); }
        __syncthreads();
    }
}
__device__ __forceinline__ void hyena_phase(const DP& p, LAS unsigned char* lds, int l) {
    const int Gd = p.nb, bx = p.bid;
    const int vcu = (Gd % 8 == 0) ? (bx % 8) * (Gd / 8) + bx / 8 : bx;
    hy_items<1>(p, lds, l, vcu);
    hy_items<0>(p, lds, l, vcu);
}
__device__ __forceinline__ void hyena_transpose(const DP& p, LAS unsigned char* lds) {
    const bf16_t* UT = (const bf16_t*)(p.ws_() + WS_UT); bf16_t* mix = (bf16_t*)(p.ws_() + WS_XA);
    LAS bf16_t* tile = (LAS bf16_t*)lds;
    const int tid = p.tid, ntile = 16 * (TP / 64);
    for (int t0 = p.bid * 4; t0 < ntile; t0 += p.nb * 4) {
        u32x4 v[4];
#pragma unroll
        for (int u = 0; u < 4; ++u) { const int t = (t0 + u < ntile) ? t0 + u : ntile - 1; const int c0 = (t & 15) * 64, tk0 = (t >> 4) * 64, cc = tid >> 3, t8 = tid & 7;
            v[u] = *(const u32x4*)(UT + (size_t)(c0 + cc) * TP + tk0 + 8 * t8); }
#pragma unroll
        for (int u = 0; u < 4; ++u) { const int cc = tid >> 3, t8 = tid & 7; *(LAS u32x4*)(tile + u * 4608 + cc * 72 + 8 * t8) = v[u]; }
        __syncthreads();
#pragma unroll
        for (int u = 0; u < 4; ++u) if (t0 + u < ntile) { const int t = t0 + u, c0 = (t & 15) * 64, tk0 = (t >> 4) * 64;
            const int tt = tid >> 3, c8 = tid & 7; unsigned w[4];
#pragma unroll
            for (int j = 0; j < 4; ++j) w[j] = (unsigned)tile[u * 4608 + (8 * c8 + 2 * j) * 72 + tt] | ((unsigned)tile[u * 4608 + (8 * c8 + 2 * j + 1) * 72 + tt] << 16);
            *(u32x4*)(mix + (size_t)(tk0 + tt) * DM + 1024 + c0 + 8 * c8) = (u32x4){w[0], w[1], w[2], w[3]}; }
        __syncthreads();
    }
}

#define XB_TMO      128
#define XB_XCNT(j)  (256  + 64 * (j))
#define XB_XSUB(j)  (1280 + 64 * (j))
#define XB_XGEN(j)  (2304 + 64 * (j))
#define XB_TOP      3328
#define XB_TOPGEN   3392
#define XCD_BAR_WORDS 3456
#define XB_SPIN_CAP (1u << 18)
__device__ __forceinline__ unsigned xb_ld(unsigned* p)              { return __hip_atomic_load(p, __ATOMIC_RELAXED, __HIP_MEMORY_SCOPE_AGENT); }
__device__ __forceinline__ unsigned xb_add(unsigned* p, unsigned v) { return __hip_atomic_fetch_add(p, v, __ATOMIC_RELAXED, __HIP_MEMORY_SCOPE_AGENT); }
__device__ __forceinline__ unsigned xb_xcc_id() { return (unsigned)__builtin_amdgcn_s_getreg((3 << 11) | 20) & 0xFu; }
#define XB_SPIN(cond, bar) do { unsigned _sp = 0; while (cond) { __builtin_amdgcn_s_sleep(1); \
    if ((++_sp & 255u) == 0u) { if (xb_ld(&(bar)[XB_TMO])) break; if (_sp > XB_SPIN_CAP) { atomicAdd(&(bar)[XB_TMO], 1u); break; } } } } while (0)
__device__ __forceinline__ void xcd_barrier_complete(unsigned* bar, unsigned x, unsigned G, unsigned& nloc, unsigned& nx) {
    unsigned sum, cnt, mine, sp = 0u;
    for (;;) {
        sum = 0u; cnt = 0u; mine = 0u;
#pragma unroll
        for (unsigned j = 0; j < 16; ++j) { const unsigned c = xb_ld(&bar[XB_XCNT(j)]); sum += c; cnt += (c > 0u) ? 1u : 0u; mine = (j == x) ? c : mine; }
        if (sum == G) break;
        __builtin_amdgcn_s_sleep(1);
        if ((++sp & 255u) == 0u) { if (xb_ld(&bar[XB_TMO])) break; if (sp > XB_SPIN_CAP) { atomicAdd(&bar[XB_TMO], 1u); break; } }
    }
    nloc = mine > 0u ? mine : 1u; nx = cnt > 0u ? cnt : 1u;
}
__device__ __forceinline__ void xcd_barrier(unsigned* bar, unsigned x, volatile LAS unsigned* st, unsigned G, int tid) {
    asm volatile("s_waitcnt vmcnt(0)" ::: "memory");
    __syncthreads();
    if (tid == 0) {
        __builtin_amdgcn_s_waitcnt(0);
        unsigned nloc = st[0], nx = st[1];
        if (nloc == 0u) { xcd_barrier_complete(bar, x, G, nloc, nx); st[0] = nloc; st[1] = nx; }
        const unsigned old = xb_add(&bar[XB_XSUB(x)], 1u);
        const unsigned gen = old / nloc;
        if (old + 1u == (gen + 1u) * nloc) {
            __builtin_amdgcn_fence(__ATOMIC_RELEASE, "agent");
            asm volatile("s_waitcnt vmcnt(0)" ::: "memory");
            const unsigned og = xb_add(&bar[XB_TOP], 1u);
            const unsigned tg = og / nx;
            if (og + 1u == (tg + 1u) * nx) xb_add(&bar[XB_TOPGEN], 1u);
            else XB_SPIN(xb_ld(&bar[XB_TOPGEN]) == tg, bar);
            __builtin_amdgcn_fence(__ATOMIC_ACQUIRE, "agent");
            xb_add(&bar[XB_XGEN(x)], 1u);
            asm volatile("s_waitcnt vmcnt(0)" ::: "memory");
        } else {
            XB_SPIN(xb_ld(&bar[XB_XGEN(x)]) == gen, bar);
            __builtin_amdgcn_fence(__ATOMIC_ACQUIRE, "agent");
            asm volatile("s_waitcnt vmcnt(0)" ::: "memory");
        }
    }
    __syncthreads();
}

constexpr int NPHASES = 17;
__device__ __forceinline__ void run_phase(const DP& p, LAS unsigned char* lds, int ph) {
    const int l = (ph == 0) ? 0 : (ph - 1) / 8, jj = (ph - 1) % 8, k = (ph == 0) ? 0 : (jj < 2 ? jj + 1 : (jj == 2 ? 8 : jj));
    const int G = p.nb, cbx = p.bid;
    bf16_t* XA = (bf16_t*)(p.ws_() + WS_XA);
    switch (k) {
#if (PHMASK >> 0) & 1
    case 0: {
#if SUB & 1
        norm_rows(p, 0, p.in_(3));
#endif
#if SUB & 2
        prep_early(p, lds, 0); prep_late(p, lds, 0);
#endif
#if SUB & 4
        __syncthreads(); filter_h3(p, lds, 0); filter_h3(p, lds, 1);
#endif
    } break;
#endif
#if (PHMASK >> 1) & 1
    case 1: {
        pg8::Prob p0{XA, (const bf16_t*)(p.ws_() + WS_WIN), TP / 256, 4};
        pg8::Prob p1{(const bf16_t*)(p.ws_() + WS_WIN) + (size_t)1024 * DM, XA, 12, TP / 256};
        pg8::Sched2 S; S.init(p0, p1, DM, G, cbx);
        pg8::EpiStore E{{(bf16_t*)(p.ws_() + WS_P), (bf16_t*)(p.ws_() + WS_UT)}, {1024, TP}};
#ifndef NOG1
        pg8::gemm_phase<pg8::EpiStore, pg8::Sched2>(p, lds, S, E);
#endif
#ifndef NOFG
        { DP p2 = p; asm volatile("" : "+v"(p2.tid));
          __syncthreads(); filter_gen(p2, lds, l); }
#endif
    } break;
#endif
#if (PHMASK >> 2) & 1
    case 2: {
#ifndef NOHY
        hyena_phase(p, lds, l);
#endif
#ifndef NOPOOL
        __syncthreads(); pool_window(p, lds);
#endif
    } break;
#endif
#if (PHMASK >> 8) & 1
    case 8: hyena_transpose(p, lds); break;
#endif
#if (PHMASK >> 3) & 1
    case 3: {
        pg8::Prob p0{XA, (const bf16_t*)(p.ws_() + WS_WOUT), TREAL / 256, DM / 256};
        pg8::Prob p1{XA, XA, 0, 0};
        pg8::Sched2 S; S.init(p0, p1, DM, G, cbx);
        pg8::EpiResid E{p.out_(), (float*)(p.ws_() + WS_TAIL), l == 0 ? p.in_(0) : nullptr, p.in_(1)};
        pg8::gemm_phase<pg8::EpiResid, pg8::Sched2>(p, lds, S, E);
        if (l == 0) {
            pg8::SchedSplit S2{XA, (const bf16_t*)(p.ws_() + WS_WOUT), DM / 256, 8, 256, DM, G, cbx};
            pg8::EpiResidAtomic E2{(float*)(p.ws_() + WS_TAIL)};
            DP p2 = p; asm volatile("" : "+v"(p2.tid));
            pg8::gemm_phase<pg8::EpiResidAtomic, pg8::SchedSplit>(p2, lds, S2, E2);
        }
    } break;
#endif
#if (PHMASK >> 4) & 1
    case 4: norm_rows(p, l == 0 ? 1 : 4, p.in_(19) + (size_t)l * DM); break;
#endif
#if (PHMASK >> 5) & 1
    case 5: {
        pg8::Prob p0{XA, (const bf16_t*)(p.ws_() + WS_WGU), l == 0 ? TP / 256 : TREAL / 256, 2 * DFF / 256};
        pg8::Prob p1{XA, XA, 0, 0};
        pg8::Sched2 S; S.init(p0, p1, DM, G, cbx);
        pg8::EpiSwiGLU E{(bf16_t*)(p.ws_() + WS_HID)};
        pg8::gemm_phase<pg8::EpiSwiGLU, pg8::Sched2>(p, lds, S, E);
        if (l == 0 && p.nb == 256 && p.bid >= 44) {
            DP p2 = p; p2.bid = p.bid - 44; p2.nb = p.nb - 44; asm volatile("" : "+v"(p2.tid));
            __syncthreads(); prep_early(p2, lds, 1);
        }
    } break;
#endif
#if (PHMASK >> 6) & 1
    case 6: {
        pg8::Prob p0{(const bf16_t*)(p.ws_() + WS_HID), (const bf16_t*)(p.ws_() + WS_WDN), TREAL / 256, DM / 256};
        pg8::Prob p1{XA, XA, 0, 0};
        pg8::Sched2 S; S.init(p0, p1, DFF, G, cbx);
        pg8::EpiResid E{p.out_(), (float*)(p.ws_() + WS_TAIL), nullptr, nullptr};
        pg8::gemm_phase<pg8::EpiResid, pg8::Sched2>(p, lds, S, E);
        if (l == 0) {
            pg8::SchedSplit S2{(const bf16_t*)(p.ws_() + WS_HID), (const bf16_t*)(p.ws_() + WS_WDN), DM / 256, 11, 512, DFF, G, cbx};
            pg8::EpiResidAtomic E2{(float*)(p.ws_() + WS_TAIL)};
            DP p2 = p; asm volatile("" : "+v"(p2.tid));
            pg8::gemm_phase<pg8::EpiResidAtomic, pg8::SchedSplit>(p2, lds, S2, E2);
        }
    } break;
#endif
#if (PHMASK >> 7) & 1
    case 7: {
        if (l == 0) { norm_rows(p, 1, p.in_(3) + DM); if (p.nb != 256) prep_early(p, lds, 1); prep_late(p, lds, 1); }
        else norm_rows(p, 2, p.in_(23));
    } break;
#endif
    }
}

__global__ void __launch_bounds__(NTHREADS, 2) mega_fwd(Params pk, int ph_lo, int ph_hi) {
    DP p;
    extern __shared__ __attribute__((aligned(16))) unsigned char lds_raw[];
    LAS unsigned char* lds = (LAS unsigned char*)lds_raw;
    cg::grid_group grid = cg::this_grid();
    volatile LAS unsigned* xst = (volatile LAS unsigned*)(lds + (LDS_BYTES - 16));
    if (threadIdx.x == 0) { xst[0] = 0u; xst[1] = 0u; }
    __syncthreads();
    unsigned* xbar = (unsigned*)(pk.ws + WS_BAR);
    const unsigned xcc = xb_xcc_id();
    if (threadIdx.x == 0) (void)xb_add(&xbar[XB_XCNT(xcc)], 1u);
    const int wave_s = __builtin_amdgcn_readfirstlane(threadIdx.x >> 6);
    for (int ph = ph_lo; ph < ph_hi; ++ph) {
        { kseg_t ks = (kseg_t)__builtin_amdgcn_kernarg_segment_ptr(); unsigned z0 = 0u; asm volatile("" : "+s"(z0));
          int t = wave_s * 64 + (int)__builtin_amdgcn_mbcnt_hi(~0u, __builtin_amdgcn_mbcnt_lo(~0u, z0)), b = blockIdx.x, n = gridDim.x;
          asm volatile("" : "+s"(ks), "+v"(t), "+s"(b), "+s"(n));
          p.ks = ks; p.tid = t; p.bid = b; p.nb = n; }
        run_phase(p, lds, ph);
#if REPMASK
        { const int j2 = (ph - 1) % 8, kk = (ph == 0) ? 0 : (j2 < 2 ? j2 + 1 : (j2 == 2 ? 8 : j2));
          if (((REPMASK >> kk) & 1) && ph != 16) { grid.sync(); run_phase(p, lds, ph); } }
#endif
        if (ph + 1 < ph_hi) {
            if (ph == ph_lo) grid.sync();
            else xcd_barrier(xbar, xcc, xst, gridDim.x, p.tid);
        }
    }
}

extern "C" void kernel_launch(void* const* d_in, const int* in_sizes, int n_in, void* d_out, int out_size, void* d_ws, size_t ws_size, hipStream_t stream) {
    static int grid = 0;
    if (grid == 0) {
        if (n_in != 24 || ws_size < WS_END) { fprintf(stderr, "kernel_launch: need 24 inputs and %zu bytes of workspace (got %d, %zu)\n", (size_t)WS_END, n_in, ws_size); grid = -1; return; }
        int dev = 0, cus = 0, per_cu = 0;
        hipGetDevice(&dev);
        hipDeviceGetAttribute(&cus, hipDeviceAttributeMultiprocessorCount, dev);
        if (hipFuncSetAttribute((const void*)mega_fwd, hipFuncAttributeMaxDynamicSharedMemorySize, LDS_BYTES) != hipSuccess) { fprintf(stderr, "hipFuncSetAttribute failed\n"); grid = -1; return; }
        hipOccupancyMaxActiveBlocksPerMultiprocessor(&per_cu, (const void*)mega_fwd, NTHREADS, LDS_BYTES);
        if (per_cu < 1) per_cu = 1;
        (void)hipGetLastError();
        grid = cus;
    }
    if (grid < 0) return;
    Params p{};
    for (int i = 0; i < 24; ++i) p.in[i] = (const float*)d_in[i];
    p.out = (float*)d_out; p.ws = (unsigned char*)d_ws;
#if MEGA
    (void)hipMemsetAsync((char*)d_ws + WS_BAR, 0, 16384, stream);
    int lo = 0, hi = NPHASES;
    void* args[] = {&p, &lo, &hi};
    hipError_t e = hipLaunchCooperativeKernel((const void*)mega_fwd, dim3(grid), dim3(NTHREADS), args, LDS_BYTES, stream);
    if (e != hipSuccess) fprintf(stderr, "cooperative launch failed: %s (grid %d)\n", hipGetErrorString(e), grid);
#else
    for (int ph = 0; ph < NPHASES; ++ph) hipLaunchKernelGGL(mega_fwd, dim3(grid), dim3(NTHREADS), LDS_BYTES, stream, p, ph, ph + 1);
#endif
}
```

```cpp
#include <hip/hip_runtime.h>
#include <hip/hip_cooperative_groups.h>
#include <cstdio>
namespace cg = cooperative_groups;

#ifndef PHMASK
#define PHMASK 511
#endif
#ifndef SUB
#define SUB 7
#endif
#ifndef REPMASK
#define REPMASK 0
#endif
#ifndef HYREP
#define HYREP 1
#endif
#ifndef MEGA
#define MEGA 1
#endif

#define LAS __attribute__((address_space(3)))
typedef unsigned short bf16_t;
typedef short bf16x8 __attribute__((ext_vector_type(8)));
typedef float f32x4 __attribute__((ext_vector_type(4)));
typedef float f32x16 __attribute__((ext_vector_type(16)));
typedef unsigned u32x4 __attribute__((ext_vector_type(4)));
typedef unsigned u32x2 __attribute__((ext_vector_type(2)));

constexpr int DM = 2048, TREAL = 32768, TTOK = 32864, TP = 33024, DFF = 5632;
constexpr int NTHREADS = 512;
constexpr int LDS_BYTES = 147456;
constexpr float EPSN = 1e-6f;

constexpr size_t WS_TAIL = 0;
constexpr size_t WS_XA   = WS_TAIL + (size_t)256 * DM * 4;
constexpr size_t WS_WIN  = WS_XA + (size_t)TP * DM * 2;
constexpr size_t WS_WOUT = WS_WIN + (size_t)4096 * DM * 2;
constexpr size_t WS_WGU  = WS_WOUT + (size_t)DM * DM * 2;
constexpr size_t WS_WDN  = WS_WGU + (size_t)2 * DFF * DM * 2;
constexpr size_t WS_H3   = WS_WDN + (size_t)DM * DFF * 2;
constexpr size_t WS_W4T  = WS_H3 + (size_t)2 * (8208 + 4112) * 64 * 4;
constexpr size_t WS_BIG  = WS_W4T + (size_t)4096 * 64 * 4;
constexpr size_t WS_P    = WS_BIG;
constexpr size_t WS_UT   = WS_P + (size_t)TP * 1024 * 2;
constexpr size_t WS_GFS  = WS_UT + (size_t)3072 * TP * 2;
constexpr size_t WS_GFP  = WS_GFS + (size_t)2048 * 16416 * 2;
constexpr size_t WS_HID  = WS_BIG;
constexpr size_t WS_BAR  = WS_BIG + (size_t)TP * DFF * 2;
constexpr size_t WS_END  = WS_BAR + 16384;
static_assert(WS_GFP + (size_t)2048 * 8224 * 2 <= WS_BAR, "big region");

struct Params {
    const float* in[24];
    float* out;
    unsigned char* ws;
};
typedef const __attribute__((address_space(4))) unsigned long long* kseg_t;
struct DP {
    kseg_t ks; int tid, bid, nb;
    __device__ __forceinline__ const float* in_(int k) const { return (const float*)ks[k]; }
    __device__ __forceinline__ float* out_() const { return (float*)ks[24]; }
    __device__ __forceinline__ unsigned char* ws_() const { return (unsigned char*)ks[25]; }
};

__device__ __forceinline__ unsigned cvt_pk_bf16(float lo, float hi) { unsigned r; asm volatile("v_cvt_pk_bf16_f32 %0, %1, %2" : "=v"(r) : "v"(lo), "v"(hi)); return r; }
__device__ __forceinline__ bf16_t f2bf(float f) { return (bf16_t)(cvt_pk_bf16(f, 0.f) & 0xffffu); }
__device__ __forceinline__ float bf2f(unsigned v) { return __uint_as_float(v << 16); }
__device__ __forceinline__ float bflo(unsigned w) { return __uint_as_float(w << 16); }
__device__ __forceinline__ float bfhi(unsigned w) { return __uint_as_float(w & 0xffff0000u); }
__device__ __forceinline__ float wave_sum(float v) {
#pragma unroll
    for (int o = 32; o >= 1; o >>= 1) v += __shfl_xor(v, o);
    return v;
}
__device__ __forceinline__ int seq_rbase(int sq) { return sq < 4 ? sq * 4096 : 16384 + (sq - 4) * 8192; }
__device__ __forceinline__ int seq_row(int sq, int p) { return p < 16 ? TREAL + 16 * sq + p : seq_rbase(sq) + p - 16; }

namespace pg8 {
constexpr int BM = 256, BK = 64, HALF = 128, HTB = HALF * BK * 2, STAGE_BYTES = 8 * HTB, NXCD = 8, WGM = 8;
__device__ __forceinline__ int lds_byte(int r, int c) { const int st = (r >> 4) * 2 + (c >> 5), rr = r & 15, cc = c & 31, ob = rr * 64 + cc * 2; return st * 1024 + (ob ^ (((ob >> 9) & 1) << 5)); }
__device__ __forceinline__ void stage_rc(int b, int& R, int& C) { const int st = b / 1024, sb = b % 1024, swz = sb ^ (((sb >> 9) & 1) << 5); R = (st >> 1) * 16 + swz / 64; C = (st & 1) * 32 + (swz % 64) / 2; }
__device__ __forceinline__ int perm32(int rho) { const int n = rho >> 4, i = rho & 15; return 8 * (i >> 2) + 4 * n + (i & 3); }

struct Unit { const char* a; const char* b; int pm, pn, prob; };
struct Prob { const bf16_t* A; const bf16_t* Bt; int nM, nN; };
struct Sched2 {
    const bf16_t* A0; const bf16_t* B0; const bf16_t* A1; const bf16_t* B1; int nM0, nN0, nM1, nN1, nwg0, nwg1; int K, ld, G, c;
    __device__ __forceinline__ void init(const Prob& p0, const Prob& p1, int K_, int G_, int c_) { A0 = p0.A; B0 = p0.Bt; A1 = p1.A; B1 = p1.Bt; nM0 = p0.nM; nN0 = p0.nN; nM1 = p1.nM; nN1 = p1.nN;
        nwg0 = nM0 * nN0; nwg1 = nM1 * nN1; K = K_; ld = K_; G = G_; c = c_; }
    __device__ __forceinline__ bool next(int i, Unit& u) const {
        long L = (long)i * G + c; int q = 0;
        if (L >= nwg0) { L -= nwg0; q = 1; if (L >= nwg1) return false; }
        const int nM = q ? nM1 : nM0, nN = q ? nN1 : nN0, nw = q ? nwg1 : nwg0;
        int wgid = (int)L; { const int qq = nw / NXCD, r = nw % NXCD, xcd = wgid % NXCD, off = wgid / NXCD; wgid = (xcd < r ? xcd * (qq + 1) : r * (qq + 1) + (xcd - r) * qq) + off; }
        const int nig = WGM * nN, gid = wgid / nig, fm = gid * WGM, gsz = (nM - fm) < WGM ? (nM - fm) : WGM;
        u.pm = fm + ((wgid % nig) % gsz); u.pn = (wgid % nig) / gsz; u.prob = q;
        const size_t tstep = (size_t)BM * K * 2;
        u.a = (const char*)(q ? A1 : A0) + (size_t)u.pm * tstep; u.b = (const char*)(q ? B1 : B0) + (size_t)u.pn * tstep;
        return true;
    }
};

struct EpiStore {
    static constexpr bool PERM = true;
    bf16_t* O[2]; int ldc[2];
    __device__ __forceinline__ void operator()(const f32x4 (&acc)[2][2][4][2], const Unit& u, int wr, int wc, int fr, int fq) const {
        bf16_t* base = u.prob ? O[1] : O[0]; const int ld = u.prob ? ldc[1] : ldc[0];
        const int row0 = u.pm * BM + wr * 64 + fr, col0 = u.pn * BM + wc * 32 + 8 * fq;
#pragma unroll
        for (int ai = 0; ai < 2; ++ai)
#pragma unroll
            for (int m = 0; m < 4; ++m) { bf16_t* rowp = base + (size_t)(row0 + ai * HALF + m * 16) * ld + col0;
#pragma unroll
                for (int bj = 0; bj < 2; ++bj) { const f32x4 v0 = acc[ai][bj][m][0], v1 = acc[ai][bj][m][1];
                    u32x4 w; w.x = cvt_pk_bf16(v0[0], v0[1]); w.y = cvt_pk_bf16(v0[2], v0[3]); w.z = cvt_pk_bf16(v1[0], v1[1]); w.w = cvt_pk_bf16(v1[2], v1[3]);
                    *(u32x4*)(rowp + bj * HALF) = w; } }
    }
};
struct EpiResid {
    static constexpr bool PERM = false;
    float* hmain; float* htail; const float* x0; const float* x1;
    __device__ __forceinline__ void operator()(const f32x4 (&acc)[2][2][4][2], const Unit& u, int wr, int wc, int fr, int fq) const {
        float* base = (u.pm < TREAL / BM) ? hmain + (size_t)u.pm * BM * DM : htail;
        const float* rbase = (x0 && u.pm < TREAL / BM) ? ((u.pm < 64) ? x0 + (size_t)u.pm * BM * DM : x1 + (size_t)(u.pm - 64) * BM * DM) : base;
        const int row0 = wr * 64 + fr, col0 = u.pn * BM + wc * 32 + 4 * fq;
#pragma unroll
        for (int ai = 0; ai < 2; ++ai)
#pragma unroll
            for (int m = 0; m < 4; ++m) { const size_t ro = (size_t)(row0 + ai * HALF + m * 16) * DM + col0; float* rowp = base + ro; const float* rrow = rbase + ro;
#pragma unroll
                for (int bj = 0; bj < 2; ++bj)
#pragma unroll
                    for (int n = 0; n < 2; ++n) *(f32x4*)(rowp + bj * HALF + n * 16) = *(const f32x4*)(rrow + bj * HALF + n * 16) + acc[ai][bj][m][n];
                asm volatile("" ::: "memory"); }
    }
};
struct EpiSwiGLU {
    static constexpr bool PERM = true;
    bf16_t* O;
    __device__ __forceinline__ void operator()(const f32x4 (&acc)[2][2][4][2], const Unit& u, int wr, int wc, int fr, int fq) const {
        const int row0 = u.pm * BM + wr * 64 + fr, col0 = u.pn * HALF + wc * 32 + 8 * fq;
#pragma unroll
        for (int ai = 0; ai < 2; ++ai)
#pragma unroll
            for (int m = 0; m < 4; ++m) { bf16_t* rowp = O + (size_t)(row0 + ai * HALF + m * 16) * DFF + col0;
                float r[8];
#pragma unroll
                for (int n = 0; n < 2; ++n)
#pragma unroll
                    for (int e = 0; e < 4; ++e) { const float g = acc[ai][0][m][n][e], up = acc[ai][1][m][n][e];
                        r[n * 4 + e] = g * __builtin_amdgcn_rcpf(1.0f + __expf(-g)) * up; }
                u32x4 w; w.x = cvt_pk_bf16(r[0], r[1]); w.y = cvt_pk_bf16(r[2], r[3]); w.z = cvt_pk_bf16(r[4], r[5]); w.w = cvt_pk_bf16(r[6], r[7]);
                *(u32x4*)rowp = w; }
    }
};

struct SchedSplit {
    const bf16_t* A; const bf16_t* Bt; int nN, nK, K, ld, G, c;
    __device__ __forceinline__ bool next(int i, Unit& u) const {
        const long L = (long)i * G + c; if (L >= nN * nK) return false;
        const int pn = (int)L % nN, kc = (int)L / nN;
        u.pm = TREAL / BM; u.pn = pn; u.prob = 0;
        u.a = (const char*)(A + (size_t)u.pm * BM * ld + (size_t)kc * K); u.b = (const char*)(Bt + (size_t)pn * BM * ld + (size_t)kc * K);
        return true;
    }
};
struct EpiResidAtomic {
    static constexpr bool PERM = false;
    float* htail;
    __device__ __forceinline__ void operator()(const f32x4 (&acc)[2][2][4][2], const Unit& u, int wr, int wc, int fr, int fq) const {
        const int col0 = u.pn * BM + wc * 32 + 4 * fq;
#pragma unroll
        for (int m = 0; m < 4; ++m) { const int row = wr * 64 + m * 16 + fr;
            if (row < 96) { float* rowp = htail + (size_t)row * DM + col0;
#pragma unroll
                for (int bj = 0; bj < 2; ++bj)
#pragma unroll
                    for (int n = 0; n < 2; ++n)
#pragma unroll
                        for (int e = 0; e < 4; ++e) atomicAdd(rowp + bj * HALF + n * 16 + e, acc[0][bj][m][n][e]); } }
    }
};
template <class Epi, class Sched>
__device__ __forceinline__ void gemm_phase(const DP& p, LAS unsigned char* lds, const Sched& S, const Epi& E) {
    const int tid = p.tid, wid = __builtin_amdgcn_readfirstlane(tid >> 6), lane = tid & 63, wr = wid >> 2, wc = wid & 3, fr = lane & 15, fq = lane >> 4;
    const int K = S.ld, nt = S.K / BK;
    unsigned voffA[2], voffB[2];
#pragma unroll
    for (int i = 0; i < 2; ++i) { int R, C; stage_rc(tid * 16 + i * 8192, R, C); const int Rb = Epi::PERM ? ((R & ~31) + perm32(R & 31)) : R;
        voffA[i] = (unsigned)(R * K + C) * 2u; voffB[i] = (unsigned)(Rb * K + C) * 2u; }
    const size_t kstep = (size_t)(BK * 2);
    const size_t hstep = (size_t)HALF * K * 2;
    const unsigned ldsw = (unsigned)wid * 1024u;
    const int aoff = lds_byte(wr * 64 + fr, fq * 8), boff = lds_byte(wc * 32 + fr, fq * 8);
#define PG8_SA(b, h) (((b) * 2 + (h)) * HTB)
#define PG8_SB(b, h) ((4 + (b) * 2 + (h)) * HTB)
#define PG8_STAGE(bufoff, gbase, voff) do { _Pragma("unroll") for (int _i = 0; _i < 2; ++_i) \
        __builtin_amdgcn_global_load_lds((const unsigned*)((const char*)(gbase) + (voff)[_i]), (LAS unsigned*)(lds + (bufoff) + ldsw + _i * 8192), 16, 0, 0); } while (0)
#define PG8_LDA(dst, b, h) do { _Pragma("unroll") for (int m = 0; m < 4; ++m) _Pragma("unroll") for (int k = 0; k < 2; ++k) dst[m][k] = *(const LAS bf16x8*)(lds + PG8_SA(b, h) + aoff + m * 2048 + k * 1024); } while (0)
#define PG8_LDB(dst, b, h) do { _Pragma("unroll") for (int n = 0; n < 2; ++n) _Pragma("unroll") for (int k = 0; k < 2; ++k) dst[n][k] = *(const LAS bf16x8*)(lds + PG8_SB(b, h) + boff + n * 2048 + k * 1024); } while (0)
#define PG8_MMA(ai, bj, At, Bt) do { __builtin_amdgcn_s_setprio(1); _Pragma("unroll") for (int m = 0; m < 4; ++m) _Pragma("unroll") for (int n = 0; n < 2; ++n) _Pragma("unroll") for (int k = 0; k < 2; ++k) \
        acc[ai][bj][m][n] = __builtin_amdgcn_mfma_f32_16x16x32_bf16(Bt[n][k], At[m][k], acc[ai][bj][m][n], 0, 0, 0); __builtin_amdgcn_s_setprio(0); } while (0)
#define PG8_WAIT_V(n) asm volatile("s_waitcnt vmcnt(" #n ")" ::: "memory")
#define PG8_WAIT_L(n) asm volatile("s_waitcnt lgkmcnt(" #n ")" ::: "memory")
#define PG8_BAR __builtin_amdgcn_s_barrier()
#define PG8_SCHED __builtin_amdgcn_sched_barrier(0)
    Unit cur, nxt; int ui = 0;
    if (!S.next(0, cur)) return;
    f32x4 acc[2][2][4][2];
#pragma unroll
    for (int a = 0; a < 2; ++a)
#pragma unroll
        for (int b = 0; b < 2; ++b)
#pragma unroll
            for (int m = 0; m < 4; ++m)
#pragma unroll
                for (int n = 0; n < 2; ++n) acc[a][b][m][n] = (f32x4){0.f, 0.f, 0.f, 0.f};
    bf16x8 At[4][2], B0[2][2], B1[2][2];
    const char* cA = cur.a; const char* cB = cur.b;
    PG8_STAGE(PG8_SB(0, 0), cB, voffB); PG8_STAGE(PG8_SA(0, 0), cA, voffA); PG8_STAGE(PG8_SB(0, 1), cB + hstep, voffB); PG8_STAGE(PG8_SA(0, 1), cA + hstep, voffA);
    if (wr == 1) PG8_BAR;
    PG8_WAIT_V(4); PG8_BAR;
    PG8_STAGE(PG8_SB(1, 0), cB + kstep, voffB); PG8_STAGE(PG8_SA(1, 0), cA + kstep, voffA); PG8_STAGE(PG8_SB(1, 1), cB + hstep + kstep, voffB);
    PG8_WAIT_V(6); PG8_BAR;
    for (;;) {
        const bool has_next = S.next(ui + 1, nxt);
        const char* nA = has_next ? nxt.a : cA; const char* nB = has_next ? nxt.b : cB;
        for (int t = 0; t < nt; t += 2) {
            const bool last = (t == nt - 2);
            const char* a1 = cA + (size_t)(t + 1) * kstep;
            const char* a2 = last ? nA : cA + (size_t)(t + 2) * kstep; const char* b2 = last ? nB : cB + (size_t)(t + 2) * kstep;
            const char* a3 = a2 + kstep; const char* b3 = b2 + kstep;
            PG8_LDB(B0, 0, 0); PG8_SCHED; PG8_LDA(At, 0, 0); PG8_STAGE(PG8_SA(1, 1), a1 + hstep, voffA);
            PG8_WAIT_L(8); PG8_BAR; PG8_WAIT_L(0); PG8_MMA(0, 0, At, B0); PG8_BAR; PG8_SCHED;
            PG8_LDB(B1, 0, 1); PG8_STAGE(PG8_SB(0, 0), b2, voffB);
            PG8_BAR; PG8_WAIT_L(0); PG8_MMA(0, 1, At, B1); PG8_BAR;
            PG8_LDA(At, 0, 1); PG8_STAGE(PG8_SA(0, 0), a2, voffA);
            PG8_BAR; PG8_WAIT_L(0); PG8_MMA(1, 0, At, B0); PG8_BAR; PG8_SCHED;
            PG8_STAGE(PG8_SB(0, 1), b2 + hstep, voffB);
            PG8_WAIT_V(6); PG8_BAR; PG8_MMA(1, 1, At, B1); PG8_BAR;
            PG8_LDB(B0, 1, 0); PG8_SCHED; PG8_LDA(At, 1, 0); PG8_STAGE(PG8_SA(0, 1), a2 + hstep, voffA);
            PG8_WAIT_L(8); PG8_BAR; PG8_WAIT_L(0); PG8_MMA(0, 0, At, B0); PG8_BAR; PG8_SCHED;
            PG8_LDB(B1, 1, 1); PG8_STAGE(PG8_SB(1, 0), b3, voffB);
            PG8_BAR; PG8_WAIT_L(0); PG8_MMA(0, 1, At, B1); PG8_BAR;
            PG8_LDA(At, 1, 1); PG8_STAGE(PG8_SA(1, 0), a3, voffA);
            PG8_BAR; PG8_WAIT_L(0); PG8_MMA(1, 0, At, B0); PG8_BAR; PG8_SCHED;
            PG8_STAGE(PG8_SB(1, 1), b3 + hstep, voffB);
            PG8_WAIT_V(6); PG8_BAR; PG8_MMA(1, 1, At, B1); PG8_BAR;
        }
        E(acc, cur, wr, wc, fr, fq);
        if (!has_next) break;
#pragma unroll
        for (int a = 0; a < 2; ++a)
#pragma unroll
            for (int b = 0; b < 2; ++b)
#pragma unroll
                for (int m = 0; m < 4; ++m)
#pragma unroll
                    for (int n = 0; n < 2; ++n) acc[a][b][m][n] = (f32x4){0.f, 0.f, 0.f, 0.f};
        cur = nxt; cA = nA; cB = nB; ++ui;
    }
    PG8_WAIT_V(0);
    if (wr == 0) PG8_BAR;
    PG8_BAR;
#undef PG8_SA
#undef PG8_SB
#undef PG8_STAGE
#undef PG8_LDA
#undef PG8_LDB
#undef PG8_MMA
#undef PG8_WAIT_V
#undef PG8_WAIT_L
#undef PG8_BAR
#undef PG8_SCHED
}
}

__device__ __forceinline__ void norm_rows(const DP& p, int mode, const float* gain) {
    const int lane = p.tid & 63, gw = p.bid * 8 + (p.tid >> 6), nw = p.nb * 8;
    float* tail = (float*)(p.ws_() + WS_TAIL); bf16_t* hn = (bf16_t*)(p.ws_() + WS_XA);
    const int nrows = (mode == 2 || mode == 4) ? TREAL : TP;
    f32x4 g[8];
#pragma unroll
    for (int j = 0; j < 8; ++j) g[j] = *(const f32x4*)(gain + 4 * (lane + 64 * j));
#define NR_SRC(rr) ((mode == 0) ? (((rr) < 16384) ? p.in_(0) + (size_t)(rr) * DM : ((rr) < TREAL) ? p.in_(1) + (size_t)((rr) - 16384) * DM : p.in_(2) + (size_t)(((rr) - TREAL) & 15) * DM) \
                                : (((rr) < TREAL) ? p.out_() + (size_t)(rr) * DM : tail + (size_t)((rr) - TREAL) * DM))
    f32x4 v[8], vn[8];
    if (gw < nrows && gw < TTOK) { const float* src = NR_SRC(gw);
#pragma unroll
        for (int j = 0; j < 8; ++j) v[j] = *(const f32x4*)(src + 4 * (lane + 64 * j)); }
    for (int r = gw; r < nrows; r += nw) {
        const int rn = r + nw;
        if (rn < nrows && rn < TTOK) { const float* srcn = NR_SRC(rn);
#pragma unroll
            for (int j = 0; j < 8; ++j) vn[j] = *(const f32x4*)(srcn + 4 * (lane + 64 * j)); }
        if (r >= TTOK) {
#pragma unroll
            for (int j = 0; j < 8; ++j) { *(u32x2*)(hn + (size_t)r * DM + 4 * (lane + 64 * j)) = (u32x2){0u, 0u};
                if (mode == 0) *(f32x4*)(tail + (size_t)(r - TREAL) * DM + 4 * (lane + 64 * j)) = (f32x4){0.f, 0.f, 0.f, 0.f}; }
        } else {
            float* hrow = (r < TREAL) ? p.out_() + (size_t)r * DM : tail + (size_t)(r - TREAL) * DM;
            float ss = 0.f;
#pragma unroll
            for (int j = 0; j < 8; ++j) ss += v[j][0] * v[j][0] + v[j][1] * v[j][1] + v[j][2] * v[j][2] + v[j][3] * v[j][3];
            ss = wave_sum(ss);
            const float rstd = 1.0f / sqrtf(ss * (1.0f / DM) + EPSN);
#pragma unroll
            for (int j = 0; j < 8; ++j) {
                const f32x4 o = v[j] * rstd * g[j];
                if (mode == 0 && r >= TREAL) *(f32x4*)(hrow + 4 * (lane + 64 * j)) = v[j];
                if (mode == 2) *(f32x4*)(hrow + 4 * (lane + 64 * j)) = o;
                else { u32x2 w; w.x = cvt_pk_bf16(o[0], o[1]); w.y = cvt_pk_bf16(o[2], o[3]); *(u32x2*)(hn + (size_t)r * DM + 4 * (lane + 64 * j)) = w; }
            }
        }
#pragma unroll
        for (int j = 0; j < 8; ++j) v[j] = vn[j];
    }
#undef NR_SRC
}

__device__ __forceinline__ void transpose_cvt(const DP& p, LAS unsigned char* lds, const float* src, int K, int N, bf16_t* dst, int ldd, int koff, int mode) {
    LAS float* tile = (LAS float*)lds;
    const int tid = p.tid, nkt = K / 64, nnt = N / 64, ntile = nkt * nnt;
    for (int t0 = p.bid * 4; t0 < ntile; t0 += p.nb * 4) {
        f32x4 v[4][2];
#pragma unroll
        for (int u = 0; u < 4; ++u) { const int t = (t0 + u < ntile) ? t0 + u : ntile - 1; const int k0 = (t / nnt) * 64, n0 = (t % nnt) * 64;
#pragma unroll
            for (int it = 0; it < 2; ++it) { const int e = tid + it * 512, kk = e >> 4, n4 = e & 15; v[u][it] = *(const f32x4*)(src + (size_t)(k0 + kk) * N + n0 + 4 * n4); } }
#pragma unroll
        for (int u = 0; u < 4; ++u)
#pragma unroll
            for (int it = 0; it < 2; ++it) { const int e = tid + it * 512, kk = e >> 4, n4 = e & 15; LAS float* tp = tile + u * 4160 + kk * 65 + 4 * n4;
                tp[0] = v[u][it][0]; tp[1] = v[u][it][1]; tp[2] = v[u][it][2]; tp[3] = v[u][it][3]; }
        __syncthreads();
#pragma unroll
        for (int u = 0; u < 4; ++u) if (t0 + u < ntile) { const int t = t0 + u, k0 = (t / nnt) * 64, n0 = (t % nnt) * 64;
            const int nn = tid >> 3, k8 = tid & 7; float f[8];
#pragma unroll
            for (int j = 0; j < 8; ++j) f[j] = tile[u * 4160 + (8 * k8 + j) * 65 + nn];
            const int n = n0 + nn; const int drow = (mode == 0) ? n : ((n >> 7) * 256 + (n & 127) + (mode == 2 ? 128 : 0));
            u32x4 w; w.x = cvt_pk_bf16(f[0], f[1]); w.y = cvt_pk_bf16(f[2], f[3]); w.z = cvt_pk_bf16(f[4], f[5]); w.w = cvt_pk_bf16(f[6], f[7]);
            *(u32x4*)(dst + (size_t)drow * ldd + koff + k0 + 8 * k8) = w; }
        __syncthreads();
    }
}
__device__ __forceinline__ void fold_pool(const DP& p, const float* pw, const float* sc, const float* wo, bf16_t* dst) {
    const int tid = p.tid;
    for (int it = p.bid; it < 512; it += p.nb) {
        const int g = it >> 7, c8 = (it >> 2) & 31, n = (it & 3) * 512 + tid;
        float acc[8];
#pragma unroll
        for (int e = 0; e < 8; ++e) acc[e] = 0.f;
        const float* pwr = pw + (size_t)(g * 256 + c8 * 8) * 256;
#pragma unroll 1
        for (int d0 = 0; d0 < 256; d0 += 16) {
            float wv[16];
#pragma unroll
            for (int dd = 0; dd < 16; ++dd) wv[dd] = wo[(size_t)(g * 256 + d0 + dd) * DM + n];
#pragma unroll
            for (int dd = 0; dd < 16; ++dd) { const float w = wv[dd] * sc[g * 256 + d0 + dd];
#pragma unroll
                for (int e = 0; e < 8; ++e) acc[e] += pwr[e * 256 + d0 + dd] * w; }
        }
        u32x4 w; w.x = cvt_pk_bf16(acc[0], acc[1]); w.y = cvt_pk_bf16(acc[2], acc[3]); w.z = cvt_pk_bf16(acc[4], acc[5]); w.w = cvt_pk_bf16(acc[6], acc[7]);
        *(u32x4*)(dst + (size_t)n * DM + g * 256 + c8 * 8) = w;
    }
}
__device__ __forceinline__ void prep_early(const DP& p, LAS unsigned char* lds, int l) {
    transpose_cvt(p, lds, p.in_(4) + (size_t)l * DM * 4096, DM, 4096, (bf16_t*)(p.ws_() + WS_WIN), DM, 0, 0);
    transpose_cvt(p, lds, p.in_(18) + (size_t)l * DM * DM + (size_t)1024 * DM, 1024, DM, (bf16_t*)(p.ws_() + WS_WOUT), DM, 1024, 0);
    fold_pool(p, p.in_(5) + (size_t)l * 4 * 256 * 256, p.in_(6) + (size_t)l * 1024, p.in_(18) + (size_t)l * DM * DM, (bf16_t*)(p.ws_() + WS_WOUT));
}
__device__ __forceinline__ void prep_late(const DP& p, LAS unsigned char* lds, int l) {
    transpose_cvt(p, lds, p.in_(20) + (size_t)l * DM * DFF, DM, DFF, (bf16_t*)(p.ws_() + WS_WGU), DM, 0, 1);
    transpose_cvt(p, lds, p.in_(21) + (size_t)l * DM * DFF, DM, DFF, (bf16_t*)(p.ws_() + WS_WGU), DM, 0, 2);
    transpose_cvt(p, lds, p.in_(22) + (size_t)l * DFF * DM, DFF, DM, (bf16_t*)(p.ws_() + WS_WDN), DFF, 0, 0);
    { const float* w4 = p.in_(16) + (size_t)l * 64 * 4096; float* w4t = (float*)(p.ws_() + WS_W4T);
      for (int i = p.bid * NTHREADS + p.tid; i < 4096 * 64; i += p.nb * NTHREADS) w4t[i] = w4[(size_t)(i & 63) * 4096 + (i >> 6)]; }
}

__device__ __forceinline__ void mlp_layer(LAS float* hl, int lane, int nin, const float* w, const float* b, const float* fr) {
    float acc[64];
#pragma unroll
    for (int j = 0; j < 64; ++j) acc[j] = b[j];
#pragma unroll 1
    for (int i = 0; i < nin; ++i) {
        const float hv = hl[i * 64 + lane];
#pragma unroll
        for (int j = 0; j < 64; ++j) acc[j] += hv * w[i * 64 + j];
    }
#pragma unroll
    for (int j = 0; j < 64; ++j) hl[j * 64 + lane] = __sinf(fr[j] * acc[j]);
}
__device__ __forceinline__ void filter_h3(const DP& p, LAS unsigned char* lds, int l) {
    const int lane = p.tid & 63, wv = __builtin_amdgcn_readfirstlane(p.tid >> 6), gw = __builtin_amdgcn_readfirstlane(p.bid * 8 + (p.tid >> 6)), nw = p.nb * 8;
    const float* w1 = p.in_(9) + (size_t)l * 33 * 64; const float* b1 = p.in_(10) + l * 64;
    const float* w2 = p.in_(11) + (size_t)l * 64 * 64; const float* b2 = p.in_(12) + l * 64;
    const float* w3 = p.in_(13) + (size_t)l * 64 * 64; const float* b3 = p.in_(14) + l * 64;
    const float* fr = p.in_(15) + l * 64;
    float* h3 = (float*)(p.ws_() + WS_H3) + (size_t)l * (8208 + 4112) * 64;
    LAS float* hl = (LAS float*)lds + wv * 4096;
    int item0 = gw - l * (nw / 2); if (item0 < 0) item0 += nw;
    for (int item = item0; item < 129 + 65; item += nw) {
        const int tr = item < 129 ? 1 : 0, tile = tr ? item : item - 129, L = tr ? 8208 : 4112;
        const int n = tile * 64 + lane; const bool valid = n < L;
        const float nf = (float)n, t = nf / (float)(L - 1);
        hl[lane] = t;
#pragma unroll
        for (int b = 0; b < 16; ++b) { const float band = 1e-4f + (float)b * ((15.0f - 1e-4f) / 15.0f);
            const float ang = (6.283185307179586f / (float)L) * nf * band; hl[(1 + b) * 64 + lane] = __cosf(ang); hl[(17 + b) * 64 + lane] = -__sinf(ang); }
        mlp_layer(hl, lane, 33, w1, b1, fr);
        mlp_layer(hl, lane, 64, w2, b2, fr);
        mlp_layer(hl, lane, 64, w3, b3, fr);
        if (valid) { float* o = h3 + (size_t)((tr ? 0 : 8208) + n) * 64;
#pragma unroll
            for (int j = 0; j < 16; ++j) *(f32x4*)(o + 4 * j) = (f32x4){hl[(4 * j) * 64 + lane], hl[(4 * j + 1) * 64 + lane], hl[(4 * j + 2) * 64 + lane], hl[(4 * j + 3) * 64 + lane]}; }
    }
}
__device__ __forceinline__ bf16x8 cvt8(const f32x4 a, const f32x4 b) { u32x4 o; o.x = cvt_pk_bf16(a[0], a[1]); o.y = cvt_pk_bf16(a[2], a[3]); o.z = cvt_pk_bf16(b[0], b[1]); o.w = cvt_pk_bf16(b[2], b[3]); return __builtin_bit_cast(bf16x8, o); }
__device__ __forceinline__ void filter_gen(const DP& p, LAS unsigned char* lds, int l) {
    const int skipb = (p.nb == 256) ? 16 : 0;
    if (p.bid < skipb) return;
    const int lane = p.tid & 63, wv = __builtin_amdgcn_readfirstlane(p.tid >> 6), gw = __builtin_amdgcn_readfirstlane((p.bid - skipb) * 8 + (p.tid >> 6)), nw = (p.nb - skipb) * 8;
    const float* w4t = (const float*)(p.ws_() + WS_W4T); const float* h3 = (const float*)(p.ws_() + WS_H3) + (size_t)l * (8208 + 4112) * 64;
    const float* skip = p.in_(17) + (size_t)l * 2 * 1024;
    LAS bf16_t* S = (LAS bf16_t*)(lds + wv * 8448);
    const int col = lane & 31, hh = lane >> 5;
    constexpr int NS = 2 * 65 * 8, NPI = 2 * 33 * 8;
    for (int item = gw; item < NS + NPI; item += nw) {
        const int tr = item < NS ? 1 : 0, it2 = tr ? item : item - NS;
        const int L = tr ? 8208 : 4112, GL = 2 * L;
        const int part = it2 & 7, bd = it2 >> 3, dir = bd & 1, b = bd >> 1, o = part >> 2, ct0 = (part & 3) * 8;
        const int nbase = 128 * b + dir;
        const float invL1 = 1.0f / (float)(L - 1);
        bf16x8 A[4][4];
#pragma unroll
        for (int r = 0; r < 4; ++r) {
            int n = nbase + 32 * r + col; n = n < L ? n : L - 1;
            const float* hr = h3 + (size_t)((tr ? 0 : 8208) + n) * 64 + 8 * hh;
#pragma unroll
            for (int s4 = 0; s4 < 4; ++s4) A[r][s4] = cvt8(*(const f32x4*)(hr + 16 * s4), *(const f32x4*)(hr + 16 * s4 + 4));
        }
        bf16_t* gbase = (bf16_t*)(p.ws_() + (tr ? WS_GFS : WS_GFP)) + (size_t)o * 1024 * GL;
        const int ebase = dir ? L + 128 * b : L - 128 * b - 128;
#pragma unroll 1
        for (int ct = 0; ct < 8; ++ct) {
            const int c = (ct0 + ct) * 32 + col;
            const float* wr = w4t + (size_t)(o * 2048 + dir * 1024 + c) * 64 + 8 * hh;
            bf16x8 Bf[4];
#pragma unroll
            for (int s4 = 0; s4 < 4; ++s4) Bf[s4] = cvt8(*(const f32x4*)(wr + 16 * s4), *(const f32x4*)(wr + 16 * s4 + 4));
            const float d0 = -3.0701134573253946f, d1 = -15.350567286626973f;
            const float kc = -fabsf(d0 + (float)c * ((d1 - d0) / 1023.0f)) * 1.4426950408889634f;
            const float sk = skip[o * 1024 + c];
#pragma unroll
            for (int r = 0; r < 4; ++r) {
                f32x16 acc;
#pragma unroll
                for (int i = 0; i < 16; ++i) acc[i] = 0.f;
#pragma unroll
                for (int s4 = 0; s4 < 4; ++s4) acc = __builtin_amdgcn_mfma_f32_32x32x16_bf16(A[r][s4], Bf[s4], acc, 0, 0, 0);
#pragma unroll
                for (int q = 0; q < 4; ++q) {
                    const int nl0 = 32 * r + 8 * q + 4 * hh;
                    float v[4];
#pragma unroll
                    for (int e = 0; e < 4; ++e) { const int n = nbase + nl0 + e; const float t = (float)n * invL1;
                        v[e] = acc[4 * q + e] * __builtin_amdgcn_exp2f(t * kc); }
                    if (r == 0 && q == 0) v[0] += (nbase + nl0 == 0 && dir == 0) ? sk : 0.f;
                    u32x2 w;
                    if (dir) { w.x = cvt_pk_bf16(v[0], v[1]); w.y = cvt_pk_bf16(v[2], v[3]); *(LAS u32x2*)(S + col * 132 + nl0) = w; }
                    else     { w.x = cvt_pk_bf16(v[3], v[2]); w.y = cvt_pk_bf16(v[1], v[0]); *(LAS u32x2*)(S + col * 132 + 124 - nl0) = w; }
                }
            }
#pragma unroll
            for (int u = 0; u < 8; ++u) {
                const int id = u * 64 + lane, colr = id >> 4, k = id & 15;
                const u32x2 lo = *(const LAS u32x2*)(S + colr * 132 + 8 * k), hi = *(const LAS u32x2*)(S + colr * 132 + 8 * k + 4);
                const int e0 = ebase + 8 * k;
                if ((unsigned)e0 <= (unsigned)(GL - 8)) *(u32x4*)(gbase + (size_t)((ct0 + ct) * 32 + colr) * GL + e0) = (u32x4){lo.x, lo.y, hi.x, hi.y};
            }
        }
    }
}

__device__ __forceinline__ void pool_acc(float (&s)[8], const u32x4 v, float sg) {
    s[0] += sg * bflo(v.x); s[1] += sg * bfhi(v.x); s[2] += sg * bflo(v.y); s[3] += sg * bfhi(v.y); s[4] += sg * bflo(v.z); s[5] += sg * bfhi(v.z); s[6] += sg * bflo(v.w); s[7] += sg * bfhi(v.w);
}
__device__ __forceinline__ void pool_window(const DP& p, LAS unsigned char* lds) {
    const bf16_t* P = (const bf16_t*)(p.ws_() + WS_P); bf16_t* mix = (bf16_t*)(p.ws_() + WS_XA);
    LAS bf16_t* T = (LAS bf16_t*)lds;
    const int tid = p.tid;
    const int nitem = (4 * 65 + 2 * 129) * 4;
    for (int item = p.bid; item < nitem; item += p.nb) {
        const int g = item & 3, ch = item >> 2;
        int sq, r, L;
        if (ch < 4 * 65) { sq = ch / 65; r = ch - sq * 65; L = 4112; } else { const int c2 = ch - 4 * 65; sq = 4 + c2 / 129; r = c2 - (sq - 4) * 129; L = 8208; }
        const int hw = 1 << g, p0 = 64 * r, nrow = 64 + 2 * hw;
        for (int idx = tid; idx < nrow * 32; idx += NTHREADS) {
            const int j = idx >> 5, c8 = idx & 31, q = p0 - hw + j;
            u32x4 v = (u32x4){0u, 0u, 0u, 0u};
            if (q >= 0 && q < L) v = *(const u32x4*)(P + (size_t)seq_row(sq, q) * 1024 + g * 256 + 8 * c8);
            *(LAS u32x4*)(T + j * 264 + 8 * c8) = v;
        }
        __syncthreads();
        {
            const int c8 = tid & 31, run = tid >> 5, pb = p0 + 4 * run;
            if (pb < L) {
                float s[8];
#pragma unroll
                for (int e = 0; e < 8; ++e) s[e] = 0.f;
                for (int t = 0; t < 2 * hw; ++t) pool_acc(s, *(const LAS u32x4*)(T + (4 * run + t) * 264 + 8 * c8), 1.0f);
#pragma unroll
                for (int i = 0; i < 4; ++i) {
                    const int pp = pb + i;
                    const int lo = pp - hw < 0 ? 0 : pp - hw, hi = pp + hw > L ? L : pp + hw;
                    const float inv = 1.0f / (float)(hi - lo);
                    const u32x4 v = *(const LAS u32x4*)(T + (4 * run + i + hw) * 264 + 8 * c8);
                    u32x4 w;
                    w.x = cvt_pk_bf16(s[0] * inv - bflo(v.x), s[1] * inv - bfhi(v.x)); w.y = cvt_pk_bf16(s[2] * inv - bflo(v.y), s[3] * inv - bfhi(v.y));
                    w.z = cvt_pk_bf16(s[4] * inv - bflo(v.z), s[5] * inv - bfhi(v.z)); w.w = cvt_pk_bf16(s[6] * inv - bflo(v.w), s[7] * inv - bfhi(v.w));
                    if (pp < L) *(u32x4*)(mix + (size_t)seq_row(sq, pp) * DM + g * 256 + 8 * c8) = w;
                    if (i < 3) { pool_acc(s, *(const LAS u32x4*)(T + (4 * run + i + 2 * hw) * 264 + 8 * c8), 1.0f); pool_acc(s, *(const LAS u32x4*)(T + (4 * run + i) * 264 + 8 * c8), -1.0f); }
                }
            }
        }
        __syncthreads();
    }
}

constexpr int HYH_U = 0, HYH_FB = 35840, HYH_ZB = HYH_FB + 33280, HYH_RED = HYH_ZB + 512, HYH_SIZE = HYH_RED + 1024;
static_assert(2 * HYH_SIZE <= LDS_BYTES, "hyena LDS");
constexpr int FPAD = 176;
template <int TR> struct HG;
template <> struct HG<1> { static constexpr int L = 8208, B = 2, NSB = 16, BSE = 8720, NIN = 513, SQ0 = 4; };
template <> struct HG<0> { static constexpr int L = 4112, B = 4, NSB = 8,  BSE = 4416, NIN = 257, SQ0 = 0; };
__device__ __forceinline__ int uphys(int q) { return q + 8 * (q >> 7); }

struct ARaw { u32x2 w01, w23, w45; };
__device__ __forceinline__ ARaw hy_raw_a(const LAS unsigned char* p8) { ARaw r; r.w01 = *(const LAS u32x2*)p8; r.w23 = *(const LAS u32x2*)(p8 + 8); r.w45 = *(const LAS u32x2*)(p8 + 16); return r; }
__device__ __forceinline__ bf16x8 hy_fin_a(const ARaw& r, bool dsel, unsigned bsh) {
    const unsigned s0 = dsel ? r.w01.y : r.w01.x, s1 = dsel ? r.w23.x : r.w01.y, s2 = dsel ? r.w23.y : r.w23.x, s3 = dsel ? r.w45.x : r.w23.y, s4 = dsel ? r.w45.y : r.w45.x;
    u32x4 o; o.x = __builtin_amdgcn_alignbit(s1, s0, bsh); o.y = __builtin_amdgcn_alignbit(s2, s1, bsh); o.z = __builtin_amdgcn_alignbit(s3, s2, bsh); o.w = __builtin_amdgcn_alignbit(s4, s3, bsh);
    return __builtin_bit_cast(bf16x8, o);
}
template <int TR>
__device__ __forceinline__ void hy_conv(LAS unsigned char* hl, int wq, int lane, f32x16 (&acc)[4]) {
    typedef HG<TR> G;
    const LAS unsigned char* Ub = hl + HYH_U; const LAS unsigned char* FBb = hl + HYH_FB;
    asm volatile("" : "+v"(lane));
    const int n = lane & 31, h = lane >> 5;
    const int sbi = n % G::NSB, beta = n / G::NSB, sb0 = wq * G::NSB;
    const int abase = FPAD + (G::L - 1) - n + 8 * h;
    const int ab2 = 2 * abase, ab8 = ab2 & ~7; const bool dsel = (ab2 & 4) != 0; const unsigned bsh = (ab2 & 2) ? 16u : 0u;
    constexpr int KS = (G::L - 16) / 16 + 8 * (G::NSB - 1) + 1, NIT = (KS + 1) / 2, NOUT = (NIT + 3) / 4;
    const int dlo = 128 * sb0 - (G::L - 16);
    constexpr int MMAX = (G::L - 16) / 128;
#pragma unroll
    for (int r = 0; r < 4; ++r)
#pragma unroll
        for (int i = 0; i < 16; ++i) acc[r][i] = 0.f;
    bf16x8 qe[4], qo[4];
#pragma unroll
    for (int r = 0; r < 4; ++r) { qe[r] = hy_fin_a(hy_raw_a(FBb + (ab8 - 2 * (dlo + 32 * r))), dsel, bsh); qo[r] = hy_fin_a(hy_raw_a(FBb + (ab8 - 2 * (dlo + 16 + 32 * r))), dsel, bsh); }
    const int ub2 = 2 * (beta * G::BSE + 8 * h);
    int M = sbi + MMAX;
    const LAS unsigned char* zb = hl + HYH_ZB + 256;
#define HY_PB(MM, first) ({ const bool v_ = (first) ? ((unsigned)(MM) <= (unsigned)MMAX) : ((unsigned)((MM) - 1) < (unsigned)MMAX); v_ ? (Ub + ub2 + 272 * (MM)) : zb; })
    const LAS unsigned char* pb0 = HY_PB(M, true); const LAS unsigned char* pb1 = HY_PB(M, false);
    bf16x8 be = *(const LAS bf16x8*)pb0, bo = *(const LAS bf16x8*)(pb1 - 2 * (16 + 8));
    unsigned pa = (unsigned)(size_t)(FBb + (ab8 - 2 * (dlo + 128))) - 320u;
#define HY_DSR64(dst, addr, off)  asm volatile("ds_read_b64 %0, %1 offset:%2"  : "=v"(dst) : "v"(addr), "n"(off))
#define HY_DSR128(dst, addr, off) asm volatile("ds_read_b128 %0, %1 offset:%2" : "=v"(dst) : "v"(addr), "n"(off))
#pragma unroll 1
    for (int I = 0; I < NOUT; ++I) {
        const LAS unsigned char* pn0 = HY_PB(M - 1, true); const LAS unsigned char* pn1 = HY_PB(M - 1, false);
        const unsigned b1a = (unsigned)(size_t)pb1 - 256u, n0a = (unsigned)(size_t)pn0, n1a = (unsigned)(size_t)pn1 - 256u;
#pragma unroll
        for (int j = 0; j < 4; ++j) {
            ARaw ra, rb; bf16x8 nbe, nbo;
            HY_DSR64(ra.w01, pa, 320 - 64 * j);      HY_DSR64(ra.w23, pa, 320 - 64 * j + 8);      HY_DSR64(ra.w45, pa, 320 - 64 * j + 16);
            HY_DSR64(rb.w01, pa, 320 - 64 * j - 32); HY_DSR64(rb.w23, pa, 320 - 64 * j - 32 + 8); HY_DSR64(rb.w45, pa, 320 - 64 * j - 32 + 16);
            if (j < 3) { HY_DSR128(nbe, b1a, 256 - 2 * (32 * (j + 1) + 8)); HY_DSR128(nbo, b1a, 256 - 2 * (32 * (j + 1) + 16 + 8)); }
            else       { HY_DSR128(nbe, n0a, 0);                            HY_DSR128(nbo, n1a, 256 - 2 * (16 + 8)); }
#pragma unroll
            for (int r = 0; r < 4; ++r) acc[r] = __builtin_amdgcn_mfma_f32_32x32x16_bf16(qe[(j + r) & 3], be, acc[r], 0, 0, 0);
#pragma unroll
            for (int r = 0; r < 4; ++r) acc[r] = __builtin_amdgcn_mfma_f32_32x32x16_bf16(qo[(j + r) & 3], bo, acc[r], 0, 0, 0);
            asm volatile("s_waitcnt lgkmcnt(0)" : "+v"(ra.w01), "+v"(ra.w23), "+v"(ra.w45), "+v"(rb.w01), "+v"(rb.w23), "+v"(rb.w45), "+v"(nbe), "+v"(nbo), "+v"(acc[0]), "+v"(acc[1]), "+v"(acc[2]), "+v"(acc[3]));
            qe[j] = hy_fin_a(ra, dsel, bsh); qo[j] = hy_fin_a(rb, dsel, bsh);
            be = nbe; bo = nbo;
        }
        pa -= 256u; pb0 = pn0; pb1 = pn1; --M;
    }
#undef HY_DSR64
#undef HY_DSR128
#undef HY_PB
    {
        f32x16 at;
#pragma unroll
        for (int i = 0; i < 16; ++i) at[i] = 0.f;
        constexpr int MS = (G::NIN + 3) / 4;
        const int m0 = wq * MS, m1 = (m0 + MS < G::NIN) ? m0 + MS : G::NIN;
        const bool colv = n < G::B;
        const int ut2 = 2 * ((colv ? n : 0) * G::BSE + 8 * h);
#pragma unroll 4
        for (int m = m0; m < m1; ++m) {
            const int d = (G::L - 16) - 16 * m;
            const bf16x8 a = hy_fin_a(hy_raw_a(FBb + (ab8 - 2 * d)), dsel, bsh);
            const bf16x8 b = *(const LAS bf16x8*)(colv ? Ub + ut2 + 2 * (16 * m + 8 * ((16 * m) >> 7)) : zb);
            at = __builtin_amdgcn_mfma_f32_32x32x16_bf16(a, b, at, 0, 0, 0);
        }
        LAS float* RED = (LAS float*)(hl + HYH_RED);
        if (colv) {
#pragma unroll
            for (int i = 0; i < 8; ++i) { const int arow = (i & 3) + 8 * (i >> 2) + 4 * h; RED[(wq * 16 + arow) * 4 + n] = at[i]; }
        }
    }
}
template <int TR>
__device__ __forceinline__ void hy_load_stream(const DP& p, LAS unsigned char* hl, int lt, int l, int k, int c, bool toU) {
    typedef HG<TR> G;
    asm volatile("" : "+v"(lt));
    const int ch = k * 1024 + c;
    const float* cw = p.in_(7) + (size_t)l * 3 * 3072; const float* cb = p.in_(8) + (size_t)l * 3072;
    const float w0 = cw[ch], w1 = cw[3072 + ch], w2 = cw[2 * 3072 + ch], bb = cb[ch];
    const bf16_t* src = (const bf16_t*)(p.ws_() + WS_UT) + (size_t)ch * TP;
    LAS bf16_t* U = (LAS bf16_t*)(hl + HYH_U); LAS bf16_t* X = (LAS bf16_t*)(hl + HYH_FB);
    constexpr int nch = G::L / 8, NCH = G::B * nch, NI = (NCH + 255) / 256;
    constexpr int GB = 5;
#pragma unroll
    for (int g0 = 0; g0 < NI; g0 += GB) {
        u32x4 v[GB]; unsigned short xl[GB], xr[GB];
#pragma unroll
        for (int i = 0; i < GB; ++i) {
            int idx = lt + 256 * (g0 + i); idx = idx < NCH ? idx : NCH - 1;
            const int b = idx / nch, q = idx - b * nch, p0 = 8 * q, sq = G::SQ0 + b;
            const int moff = TREAL + 16 * sq, roff = seq_rbase(sq);
            const int off = p0 < 16 ? moff + p0 : roff + p0 - 16;
            v[i] = *(const u32x4*)(src + off);
            xl[i] = src[p0 == 0 ? off : (p0 == 16 ? moff + 15 : off - 1)];
            xr[i] = src[p0 + 8 >= G::L ? off : (p0 + 8 == 16 ? roff : off + 8)];
        }
#pragma unroll
        for (int i = 0; i < GB; ++i) {
            const int idx = lt + 256 * (g0 + i);
            if (g0 + i < NI && idx < NCH) {
                const int b = idx / nch, q = idx - b * nch, p0 = 8 * q;
                float x[10];
                x[0] = (p0 == 0) ? 0.f : bf2f(xl[i]);
                x[9] = (p0 + 8 >= G::L) ? 0.f : bf2f(xr[i]);
                x[1] = bflo(v[i].x); x[2] = bfhi(v[i].x); x[3] = bflo(v[i].y); x[4] = bfhi(v[i].y); x[5] = bflo(v[i].z); x[6] = bfhi(v[i].z); x[7] = bflo(v[i].w); x[8] = bfhi(v[i].w);
                float y[8];
#pragma unroll
                for (int j = 0; j < 8; ++j) y[j] = w0 * x[j] + w1 * x[j + 1] + w2 * x[j + 2] + bb;
                u32x4 w; w.x = cvt_pk_bf16(y[0], y[1]); w.y = cvt_pk_bf16(y[2], y[3]); w.z = cvt_pk_bf16(y[4], y[5]); w.w = cvt_pk_bf16(y[6], y[7]);
                LAS bf16_t* dst = toU ? U + b * G::BSE + uphys(p0) : X + b * G::L + p0;
                *(LAS u32x4*)dst = w;
            }
        }
    }
}
template <int TR>
__device__ __forceinline__ void hy_load_filter(const DP& p, LAS unsigned char* hl, int lt, int o, int c) {
    typedef HG<TR> G;
    constexpr int GL = 2 * G::L, NCH = GL / 8, NI = (NCH + 255) / 256;
    asm volatile("" : "+v"(lt));
    const bf16_t* gf = (const bf16_t*)(p.ws_() + (TR ? WS_GFS : WS_GFP)) + ((size_t)o * 1024 + c) * GL;
    LAS bf16_t* FB = (LAS bf16_t*)(hl + HYH_FB);
    u32x4 v[NI];
#pragma unroll
    for (int i = 0; i < NI; ++i) { int idx = lt + 256 * i; idx = idx < NCH ? idx : NCH - 1; v[i] = *(const u32x4*)(gf + 8 * idx); }
    if (lt < FPAD / 8) *(LAS u32x4*)(FB + 8 * lt) = (u32x4){0u, 0u, 0u, 0u};
#pragma unroll
    for (int i = 0; i < NI; ++i) { const int idx = lt + 256 * i; if (idx < NCH) *(LAS u32x4*)(FB + FPAD + 8 * idx) = v[i]; }
}
template <int TR>
__device__ __forceinline__ void hy_items(const DP& p, LAS unsigned char* lds, int l, int vcu) {
    typedef HG<TR> G;
    const int tid = p.tid, lane = tid & 63, wave = __builtin_amdgcn_readfirstlane(tid >> 6), hf = wave >> 2, wq = wave & 3, lt = tid & 255;
    LAS unsigned char* hl = lds + hf * HYH_SIZE;
    LAS bf16_t* U = (LAS bf16_t*)(hl + HYH_U); const LAS bf16_t* X = (const LAS bf16_t*)(hl + HYH_FB); const LAS float* RED = (const LAS float*)(hl + HYH_RED);
    bf16_t* UT = (bf16_t*)(p.ws_() + WS_UT);
    for (int pit = vcu; pit < 512; pit += p.nb) {
        const int c = 2 * pit + hf;
        if (lt < 32) *(LAS u32x4*)(hl + HYH_ZB + 16 * lt) = (u32x4){0u, 0u, 0u, 0u};
        hy_load_stream<TR>(p, hl, lt, l, 0, c, true);
        hy_load_filter<TR>(p, hl, lt, 0, c);
        __syncthreads();
        f32x16 acc[4];
#pragma unroll 1
        for (int rep = 0; rep < HYREP; ++rep) { hy_conv<TR>(hl, wq, lane, acc); asm volatile("" ::: "memory"); }
        __syncthreads();
        hy_load_stream<TR>(p, hl, lt, l, 1, c, false);
        __syncthreads();
        { int ln = lane; asm volatile("" : "+v"(ln)); const int n = ln & 31, hh = ln >> 5, sbi = n % G::NSB, beta = n / G::NSB, sb = wq * G::NSB + sbi;
#pragma unroll
        for (int r = 0; r < 4; ++r)
#pragma unroll
            for (int qd = 0; qd < 4; ++qd) {
                const int t0 = 128 * sb + 32 * r + 8 * qd + 4 * hh;
                const u32x2 xv = *(const LAS u32x2*)(X + beta * G::L + t0);
                u32x2 w; w.x = cvt_pk_bf16(bflo(xv.x) * acc[r][4 * qd], bfhi(xv.x) * acc[r][4 * qd + 1]); w.y = cvt_pk_bf16(bflo(xv.y) * acc[r][4 * qd + 2], bfhi(xv.y) * acc[r][4 * qd + 3]);
                *(LAS u32x2*)(U + beta * G::BSE + uphys(t0)) = w;
            }
        }
        if (lt < 16 * G::B) { const int a = lt & 15, b = lt >> 4; float y = 0.f;
#pragma unroll
            for (int w = 0; w < 4; ++w) y += RED[(w * 16 + a) * 4 + b];
            const int t = (G::L - 16) + a;
            U[b * G::BSE + uphys(t)] = f2bf(bf2f(X[b * G::L + t]) * y); }
        __syncthreads();
        hy_load_filter<TR>(p, hl, lt, 1, c);
        __syncthreads();
        hy_conv<TR>(hl, wq, lane, acc);
        __syncthreads();
        hy_load_stream<TR>(p, hl, lt, l, 2, c, false);
        __syncthreads();
        bf16_t* orow = UT + (size_t)c * TP;
        { int ln = lane; asm volatile("" : "+v"(ln)); const int n = ln & 31, hh = ln >> 5, sbi = n % G::NSB, beta = n / G::NSB, sb = wq * G::NSB + sbi;
#pragma unroll
        for (int r = 0; r < 4; ++r)
#pragma unroll
            for (int qd = 0; qd < 4; ++qd) {
                const int t0 = 128 * sb + 32 * r + 8 * qd + 4 * hh;
                const u32x2 xv = *(const LAS u32x2*)(X + beta * G::L + t0);
                u32x2 w; w.x = cvt_pk_bf16(bflo(xv.x) * acc[r][4 * qd], bfhi(xv.x) * acc[r][4 * qd + 1]); w.y = cvt_pk_bf16(bflo(xv.y) * acc[r][4 * qd + 2], bfhi(xv.y) * acc[r][4 * qd + 3]);
                *(u32x2*)(orow + seq_row(G::SQ0 + beta, t0)) = w;
            }
        }
        if (lt < 16 * G::B) { const int a = lt & 15, b = lt >> 4; float y = 0.f;
#pragma unroll
            for (int w = 0; w < 4; ++w) y += RED[(w * 16 + a) * 4 + b];
            const int t = (G::L - 16) + a;
            orow[seq_row(G::SQ0 + b, t)] = f2bf(bf2f(X[b * G::L + t]) * y); }
        __syncthreads();
    }
}
__device__ __forceinline__ void hyena_phase(const DP& p, LAS unsigned char* lds, int l) {
    const int Gd = p.nb, bx = p.bid;
    const int vcu = (Gd % 8 == 0) ? (bx % 8) * (Gd / 8) + bx / 8 : bx;
    hy_items<1>(p, lds, l, vcu);
    hy_items<0>(p, lds, l, vcu);
}
__device__ __forceinline__ void hyena_transpose(const DP& p, LAS unsigned char* lds) {
    const bf16_t* UT = (const bf16_t*)(p.ws_() + WS_UT); bf16_t* mix = (bf16_t*)(p.ws_() + WS_XA);
    LAS bf16_t* tile = (LAS bf16_t*)lds;
    const int tid = p.tid, ntile = 16 * (TP / 64);
    for (int t0 = p.bid * 4; t0 < ntile; t0 += p.nb * 4) {
        u32x4 v[4];
#pragma unroll
        for (int u = 0; u < 4; ++u) { const int t = (t0 + u < ntile) ? t0 + u : ntile - 1; const int c0 = (t & 15) * 64, tk0 = (t >> 4) * 64, cc = tid >> 3, t8 = tid & 7;
            v[u] = *(const u32x4*)(UT + (size_t)(c0 + cc) * TP + tk0 + 8 * t8); }
#pragma unroll
        for (int u = 0; u < 4; ++u) { const int cc = tid >> 3, t8 = tid & 7; *(LAS u32x4*)(tile + u * 4608 + cc * 72 + 8 * t8) = v[u]; }
        __syncthreads();
#pragma unroll
        for (int u = 0; u < 4; ++u) if (t0 + u < ntile) { const int t = t0 + u, c0 = (t & 15) * 64, tk0 = (t >> 4) * 64;
            const int tt = tid >> 3, c8 = tid & 7; unsigned w[4];
#pragma unroll
            for (int j = 0; j < 4; ++j) w[j] = (unsigned)tile[u * 4608 + (8 * c8 + 2 * j) * 72 + tt] | ((unsigned)tile[u * 4608 + (8 * c8 + 2 * j + 1) * 72 + tt] << 16);
            *(u32x4*)(mix + (size_t)(tk0 + tt) * DM + 1024 + c0 + 8 * c8) = (u32x4){w[0], w[1], w[2], w[3]}; }
        __syncthreads();
    }
}

#define XB_TMO      128
#define XB_XCNT(j)  (256  + 64 * (j))
#define XB_XSUB(j)  (1280 + 64 * (j))
#define XB_XGEN(j)  (2304 + 64 * (j))
#define XB_TOP      3328
#define XB_TOPGEN   3392
#define XCD_BAR_WORDS 3456
#define XB_SPIN_CAP (1u << 18)
__device__ __forceinline__ unsigned xb_ld(unsigned* p)              { return __hip_atomic_load(p, __ATOMIC_RELAXED, __HIP_MEMORY_SCOPE_AGENT); }
__device__ __forceinline__ unsigned xb_add(unsigned* p, unsigned v) { return __hip_atomic_fetch_add(p, v, __ATOMIC_RELAXED, __HIP_MEMORY_SCOPE_AGENT); }
__device__ __forceinline__ unsigned xb_xcc_id() { return (unsigned)__builtin_amdgcn_s_getreg((3 << 11) | 20) & 0xFu; }
#define XB_SPIN(cond, bar) do { unsigned _sp = 0; while (cond) { __builtin_amdgcn_s_sleep(1); \
    if ((++_sp & 255u) == 0u) { if (xb_ld(&(bar)[XB_TMO])) break; if (_sp > XB_SPIN_CAP) { atomicAdd(&(bar)[XB_TMO], 1u); break; } } } } while (0)
__device__ __forceinline__ void xcd_barrier_complete(unsigned* bar, unsigned x, unsigned G, unsigned& nloc, unsigned& nx) {
    unsigned sum, cnt, mine, sp = 0u;
    for (;;) {
        sum = 0u; cnt = 0u; mine = 0u;
#pragma unroll
        for (unsigned j = 0; j < 16; ++j) { const unsigned c = xb_ld(&bar[XB_XCNT(j)]); sum += c; cnt += (c > 0u) ? 1u : 0u; mine = (j == x) ? c : mine; }
        if (sum == G) break;
        __builtin_amdgcn_s_sleep(1);
        if ((++sp & 255u) == 0u) { if (xb_ld(&bar[XB_TMO])) break; if (sp > XB_SPIN_CAP) { atomicAdd(&bar[XB_TMO], 1u); break; } }
    }
    nloc = mine > 0u ? mine : 1u; nx = cnt > 0u ? cnt : 1u;
}
__device__ __forceinline__ void xcd_barrier(unsigned* bar, unsigned x, volatile LAS unsigned* st, unsigned G, int tid) {
    asm volatile("s_waitcnt vmcnt(0)" ::: "memory");
    __syncthreads();
    if (tid == 0) {
        __builtin_amdgcn_s_waitcnt(0);
        unsigned nloc = st[0], nx = st[1];
        if (nloc == 0u) { xcd_barrier_complete(bar, x, G, nloc, nx); st[0] = nloc; st[1] = nx; }
        const unsigned old = xb_add(&bar[XB_XSUB(x)], 1u);
        const unsigned gen = old / nloc;
        if (old + 1u == (gen + 1u) * nloc) {
            __builtin_amdgcn_fence(__ATOMIC_RELEASE, "agent");
            asm volatile("s_waitcnt vmcnt(0)" ::: "memory");
            const unsigned og = xb_add(&bar[XB_TOP], 1u);
            const unsigned tg = og / nx;
            if (og + 1u == (tg + 1u) * nx) xb_add(&bar[XB_TOPGEN], 1u);
            else XB_SPIN(xb_ld(&bar[XB_TOPGEN]) == tg, bar);
            __builtin_amdgcn_fence(__ATOMIC_ACQUIRE, "agent");
            xb_add(&bar[XB_XGEN(x)], 1u);
            asm volatile("s_waitcnt vmcnt(0)" ::: "memory");
        } else {
            XB_SPIN(xb_ld(&bar[XB_XGEN(x)]) == gen, bar);
            __builtin_amdgcn_fence(__ATOMIC_ACQUIRE, "agent");
            asm volatile("s_waitcnt vmcnt(0)" ::: "memory");
        }
    }
    __syncthreads();
}

constexpr int NPHASES = 17;
__device__ __forceinline__ void run_phase(const DP& p, LAS unsigned char* lds, int ph) {
    const int l = (ph == 0) ? 0 : (ph - 1) / 8, jj = (ph - 1) % 8, k = (ph == 0) ? 0 : (jj < 2 ? jj + 1 : (jj == 2 ? 8 : jj));
    const int G = p.nb, cbx = p.bid;
    bf16_t* XA = (bf16_t*)(p.ws_() + WS_XA);
    switch (k) {
#if (PHMASK >> 0) & 1
    case 0: {
#if SUB & 1
        norm_rows(p, 0, p.in_(3));
#endif
#if SUB & 2
        prep_early(p, lds, 0); prep_late(p, lds, 0);
#endif
#if SUB & 4
        __syncthreads(); filter_h3(p, lds, 0); filter_h3(p, lds, 1);
#endif
    } break;
#endif
#if (PHMASK >> 1) & 1
    case 1: {
        pg8::Prob p0{XA, (const bf16_t*)(p.ws_() + WS_WIN), TP / 256, 4};
        pg8::Prob p1{(const bf16_t*)(p.ws_() + WS_WIN) + (size_t)1024 * DM, XA, 12, TP / 256};
        pg8::Sched2 S; S.init(p0, p1, DM, G, cbx);
        pg8::EpiStore E{{(bf16_t*)(p.ws_() + WS_P), (bf16_t*)(p.ws_() + WS_UT)}, {1024, TP}};
#ifndef NOG1
        pg8::gemm_phase<pg8::EpiStore, pg8::Sched2>(p, lds, S, E);
#endif
#ifndef NOFG
        { DP p2 = p; asm volatile("" : "+v"(p2.tid));
          __syncthreads(); filter_gen(p2, lds, l); }
#endif
    } break;
#endif
#if (PHMASK >> 2) & 1
    case 2: {
#ifndef NOHY
        hyena_phase(p, lds, l);
#endif
#ifndef NOPOOL
        __syncthreads(); pool_window(p, lds);
#endif
    } break;
#endif
#if (PHMASK >> 8) & 1
    case 8: hyena_transpose(p, lds); break;
#endif
#if (PHMASK >> 3) & 1
    case 3: {
        pg8::Prob p0{XA, (const bf16_t*)(p.ws_() + WS_WOUT), TREAL / 256, DM / 256};
        pg8::Prob p1{XA, XA, 0, 0};
        pg8::Sched2 S; S.init(p0, p1, DM, G, cbx);
        pg8::EpiResid E{p.out_(), (float*)(p.ws_() + WS_TAIL), l == 0 ? p.in_(0) : nullptr, p.in_(1)};
        pg8::gemm_phase<pg8::EpiResid, pg8::Sched2>(p, lds, S, E);
        if (l == 0) {
            pg8::SchedSplit S2{XA, (const bf16_t*)(p.ws_() + WS_WOUT), DM / 256, 8, 256, DM, G, cbx};
            pg8::EpiResidAtomic E2{(float*)(p.ws_() + WS_TAIL)};
            DP p2 = p; asm volatile("" : "+v"(p2.tid));
            pg8::gemm_phase<pg8::EpiResidAtomic, pg8::SchedSplit>(p2, lds, S2, E2);
        }
    } break;
#endif
#if (PHMASK >> 4) & 1
    case 4: norm_rows(p, l == 0 ? 1 : 4, p.in_(19) + (size_t)l * DM); break;
#endif
#if (PHMASK >> 5) & 1
    case 5: {
        pg8::Prob p0{XA, (const bf16_t*)(p.ws_() + WS_WGU), l == 0 ? TP / 256 : TREAL / 256, 2 * DFF / 256};
        pg8::Prob p1{XA, XA, 0, 0};
        pg8::Sched2 S; S.init(p0, p1, DM, G, cbx);
        pg8::EpiSwiGLU E{(bf16_t*)(p.ws_() + WS_HID)};
        pg8::gemm_phase<pg8::EpiSwiGLU, pg8::Sched2>(p, lds, S, E);
        if (l == 0 && p.nb == 256 && p.bid >= 44) {
            DP p2 = p; p2.bid = p.bid - 44; p2.nb = p.nb - 44; asm volatile("" : "+v"(p2.tid));
            __syncthreads(); prep_early(p2, lds, 1);
        }
    } break;
#endif
#if (PHMASK >> 6) & 1
    case 6: {
        pg8::Prob p0{(const bf16_t*)(p.ws_() + WS_HID), (const bf16_t*)(p.ws_() + WS_WDN), TREAL / 256, DM / 256};
        pg8::Prob p1{XA, XA, 0, 0};
        pg8::Sched2 S; S.init(p0, p1, DFF, G, cbx);
        pg8::EpiResid E{p.out_(), (float*)(p.ws_() + WS_TAIL), nullptr, nullptr};
        pg8::gemm_phase<pg8::EpiResid, pg8::Sched2>(p, lds, S, E);
        if (l == 0) {
            pg8::SchedSplit S2{(const bf16_t*)(p.ws_() + WS_HID), (const bf16_t*)(p.ws_() + WS_WDN), DM / 256, 11, 512, DFF, G, cbx};
            pg8::EpiResidAtomic E2{(float*)(p.ws_() + WS_TAIL)};
            DP p2 = p; asm volatile("" : "+v"(p2.tid));
            pg8::gemm_phase<pg8::EpiResidAtomic, pg8::SchedSplit>(p2, lds, S2, E2);
        }
    } break;
#endif
#if (PHMASK >> 7) & 1
    case 7: {
        if (l == 0) { norm_rows(p, 1, p.in_(3) + DM); if (p.nb != 256) prep_early(p, lds, 1); prep_late(p, lds, 1); }
        else norm_rows(p, 2, p.in_(23));
    } break;
#endif
    }
}

__global__ void __launch_bounds__(NTHREADS, 2) mega_fwd(Params pk, int ph_lo, int ph_hi) {
    DP p;
    extern __shared__ __attribute__((aligned(16))) unsigned char lds_raw[];
    LAS unsigned char* lds = (LAS unsigned char*)lds_raw;
    cg::grid_group grid = cg::this_grid();
    volatile LAS unsigned* xst = (volatile LAS unsigned*)(lds + (LDS_BYTES - 16));
    if (threadIdx.x == 0) { xst[0] = 0u; xst[1] = 0u; }
    __syncthreads();
    unsigned* xbar = (unsigned*)(pk.ws + WS_BAR);
    const unsigned xcc = xb_xcc_id();
    if (threadIdx.x == 0) (void)xb_add(&xbar[XB_XCNT(xcc)], 1u);
    const int wave_s = __builtin_amdgcn_readfirstlane(threadIdx.x >> 6);
    for (int ph = ph_lo; ph < ph_hi; ++ph) {
        { kseg_t ks = (kseg_t)__builtin_amdgcn_kernarg_segment_ptr(); unsigned z0 = 0u; asm volatile("" : "+s"(z0));
          int t = wave_s * 64 + (int)__builtin_amdgcn_mbcnt_hi(~0u, __builtin_amdgcn_mbcnt_lo(~0u, z0)), b = blockIdx.x, n = gridDim.x;
          asm volatile("" : "+s"(ks), "+v"(t), "+s"(b), "+s"(n));
          p.ks = ks; p.tid = t; p.bid = b; p.nb = n; }
        run_phase(p, lds, ph);
#if REPMASK
        { const int j2 = (ph - 1) % 8, kk = (ph == 0) ? 0 : (j2 < 2 ? j2 + 1 : (j2 == 2 ? 8 : j2));
          if (((REPMASK >> kk) & 1) && ph != 16) { grid.sync(); run_phase(p, lds, ph); } }
#endif
        if (ph + 1 < ph_hi) {
            if (ph == ph_lo) grid.sync();
            else xcd_barrier(xbar, xcc, xst, gridDim.x, p.tid);
        }
    }
}

extern "C" void kernel_launch(void* const* d_in, const int* in_sizes, int n_in, void* d_out, int out_size, void* d_ws, size_t ws_size, hipStream_t stream) {
    static int grid = 0;
    if (grid == 0) {
        if (n_in != 24 || ws_size < WS_END) { fprintf(stderr, "kernel_launch: need 24 inputs and %zu bytes of workspace (got %d, %zu)\n", (size_t)WS_END, n_in, ws_size); grid = -1; return; }
        int dev = 0, cus = 0, per_cu = 0;
        hipGetDevice(&dev);
        hipDeviceGetAttribute(&cus, hipDeviceAttributeMultiprocessorCount, dev);
        if (hipFuncSetAttribute((const void*)mega_fwd, hipFuncAttributeMaxDynamicSharedMemorySize, LDS_BYTES) != hipSuccess) { fprintf(stderr, "hipFuncSetAttribute failed\n"); grid = -1; return; }
        hipOccupancyMaxActiveBlocksPerMultiprocessor(&per_cu, (const void*)mega_fwd, NTHREADS, LDS_BYTES);
        if (per_cu < 1) per_cu = 1;
        (void)hipGetLastError();
        grid = cus;
    }
    if (grid < 0) return;
    Params p{};
    for (int i = 0; i < 24; ++i) p.in[i] = (const float*)d_in[i];
    p.out = (float*)d_out; p.ws = (unsigned char*)d_ws;
#if MEGA
    (void)hipMemsetAsync((char*)d_ws + WS_BAR, 0, 16384, stream);
    int lo = 0, hi = NPHASES;
    void* args[] = {&p, &lo, &hi};
    hipError_t e = hipLaunchCooperativeKernel((const void*)mega_fwd, dim3(grid), dim3(NTHREADS), args, LDS_BYTES, stream);
    if (e != hipSuccess) fprintf(stderr, "cooperative launch failed: %s (grid %d)\n", hipGetErrorString(e), grid);
#else
    for (int ph = 0; ph < NPHASES; ++ph) hipLaunchKernelGGL(mega_fwd, dim3(grid), dim3(NTHREADS), LDS_BYTES, stream, p, ph, ph + 1);
#endif
}
```

```cpp
#include <hip/hip_runtime.h>
#include <hip/hip_cooperative_groups.h>
#include <cstdio>
namespace cg = cooperative_groups;

#ifndef PHMASK
#define PHMASK 511
#endif
#ifndef SUB
#define SUB 7
#endif
#ifndef REPMASK
#define REPMASK 0
#endif
#ifndef HYREP
#define HYREP 1
#endif
#ifndef MEGA
#define MEGA 1
#endif

#define LAS __attribute__((address_space(3)))
typedef unsigned short bf16_t;
typedef short bf16x8 __attribute__((ext_vector_type(8)));
typedef float f32x4 __attribute__((ext_vector_type(4)));
typedef float f32x16 __attribute__((ext_vector_type(16)));
typedef unsigned u32x4 __attribute__((ext_vector_type(4)));
typedef unsigned u32x2 __attribute__((ext_vector_type(2)));

constexpr int DM = 2048, TREAL = 32768, TTOK = 32864, TP = 33024, DFF = 5632;
constexpr int NTHREADS = 512;
constexpr int LDS_BYTES = 147456;
constexpr float EPSN = 1e-6f;

constexpr size_t WS_TAIL = 0;
constexpr size_t WS_XA   = WS_TAIL + (size_t)256 * DM * 4;
constexpr size_t WS_WIN  = WS_XA + (size_t)TP * DM * 2;
constexpr size_t WS_WOUT = WS_WIN + (size_t)4096 * DM * 2;
constexpr size_t WS_WGU  = WS_WOUT + (size_t)DM * DM * 2;
constexpr size_t WS_WDN  = WS_WGU + (size_t)2 * DFF * DM * 2;
constexpr size_t WS_H3   = WS_WDN + (size_t)DM * DFF * 2;
constexpr size_t WS_W4T  = WS_H3 + (size_t)2 * (8208 + 4112) * 64 * 4;
constexpr size_t WS_BIG  = WS_W4T + (size_t)4096 * 64 * 4;
constexpr size_t WS_P    = WS_BIG;
constexpr size_t WS_UT   = WS_P + (size_t)TP * 1024 * 2;
constexpr size_t WS_GFS  = WS_UT + (size_t)3072 * TP * 2;
constexpr size_t WS_GFP  = WS_GFS + (size_t)2048 * 16416 * 2;
constexpr size_t WS_HID  = WS_BIG;
constexpr size_t WS_BAR  = WS_BIG + (size_t)TP * DFF * 2;
constexpr size_t WS_END  = WS_BAR + 16384;
static_assert(WS_GFP + (size_t)2048 * 8224 * 2 <= WS_BAR, "big region");

struct Params {
    const float* in[24];
    float* out;
    unsigned char* ws;
};
typedef const __attribute__((address_space(4))) unsigned long long* kseg_t;
struct DP {
    kseg_t ks; int tid, bid, nb;
    __device__ __forceinline__ const float* in_(int k) const { return (const float*)ks[k]; }
    __device__ __forceinline__ float* out_() const { return (float*)ks[24]; }
    __device__ __forceinline__ unsigned char* ws_() const { return (unsigned char*)ks[25]; }
};

__device__ __forceinline__ unsigned cvt_pk_bf16(float lo, float hi) { unsigned r; asm volatile("v_cvt_pk_bf16_f32 %0, %1, %2" : "=v"(r) : "v"(lo), "v"(hi)); return r; }
__device__ __forceinline__ bf16_t f2bf(float f) { return (bf16_t)(cvt_pk_bf16(f, 0.f) & 0xffffu); }
__device__ __forceinline__ float bf2f(unsigned v) { return __uint_as_float(v << 16); }
__device__ __forceinline__ float bflo(unsigned w) { return __uint_as_float(w << 16); }
__device__ __forceinline__ float bfhi(unsigned w) { return __uint_as_float(w & 0xffff0000u); }
__device__ __forceinline__ float wave_sum(float v) {
#pragma unroll
    for (int o = 32; o >= 1; o >>= 1) v += __shfl_xor(v, o);
    return v;
}
__device__ __forceinline__ int seq_rbase(int sq) { return sq < 4 ? sq * 4096 : 16384 + (sq - 4) * 8192; }
__device__ __forceinline__ int seq_row(int sq, int p) { return p < 16 ? TREAL + 16 * sq + p : seq_rbase(sq) + p - 16; }

namespace pg8 {
constexpr int BM = 256, BK = 64, HALF = 128, HTB = HALF * BK * 2, STAGE_BYTES = 8 * HTB, NXCD = 8, WGM = 8;
__device__ __forceinline__ int lds_byte(int r, int c) { const int st = (r >> 4) * 2 + (c >> 5), rr = r & 15, cc = c & 31, ob = rr * 64 + cc * 2; return st * 1024 + (ob ^ (((ob >> 9) & 1) << 5)); }
__device__ __forceinline__ void stage_rc(int b, int& R, int& C) { const int st = b / 1024, sb = b % 1024, swz = sb ^ (((sb >> 9) & 1) << 5); R = (st >> 1) * 16 + swz / 64; C = (st & 1) * 32 + (swz % 64) / 2; }
__device__ __forceinline__ int perm32(int rho) { const int n = rho >> 4, i = rho & 15; return 8 * (i >> 2) + 4 * n + (i & 3); }

struct Unit { const char* a; const char* b; int pm, pn, prob; };
struct Prob { const bf16_t* A; const bf16_t* Bt; int nM, nN; };
struct Sched2 {
    const bf16_t* A0; const bf16_t* B0; const bf16_t* A1; const bf16_t* B1; int nM0, nN0, nM1, nN1, nwg0, nwg1; int K, ld, G, c;
    __device__ __forceinline__ void init(const Prob& p0, const Prob& p1, int K_, int G_, int c_) { A0 = p0.A; B0 = p0.Bt; A1 = p1.A; B1 = p1.Bt; nM0 = p0.nM; nN0 = p0.nN; nM1 = p1.nM; nN1 = p1.nN;
        nwg0 = nM0 * nN0; nwg1 = nM1 * nN1; K = K_; ld = K_; G = G_; c = c_; }
    __device__ __forceinline__ bool next(int i, Unit& u) const {
        long L = (long)i * G + c; int q = 0;
        if (L >= nwg0) { L -= nwg0; q = 1; if (L >= nwg1) return false; }
        const int nM = q ? nM1 : nM0, nN = q ? nN1 : nN0, nw = q ? nwg1 : nwg0;
        int wgid = (int)L; { const int qq = nw / NXCD, r = nw % NXCD, xcd = wgid % NXCD, off = wgid / NXCD; wgid = (xcd < r ? xcd * (qq + 1) : r * (qq + 1) + (xcd - r) * qq) + off; }
        const int nig = WGM * nN, gid = wgid / nig, fm = gid * WGM, gsz = (nM - fm) < WGM ? (nM - fm) : WGM;
        u.pm = fm + ((wgid % nig) % gsz); u.pn = (wgid % nig) / gsz; u.prob = q;
        const size_t tstep = (size_t)BM * K * 2;
        u.a = (const char*)(q ? A1 : A0) + (size_t)u.pm * tstep; u.b = (const char*)(q ? B1 : B0) + (size_t)u.pn * tstep;
        return true;
    }
};

struct EpiStore {
    static constexpr bool PERM = true;
    bf16_t* O[2]; int ldc[2];
    __device__ __forceinline__ void operator()(const f32x4 (&acc)[2][2][4][2], const Unit& u, int wr, int wc, int fr, int fq) const {
        bf16_t* base = u.prob ? O[1] : O[0]; const int ld = u.prob ? ldc[1] : ldc[0];
        const int row0 = u.pm * BM + wr * 64 + fr, col0 = u.pn * BM + wc * 32 + 8 * fq;
#pragma unroll
        for (int ai = 0; ai < 2; ++ai)
#pragma unroll
            for (int m = 0; m < 4; ++m) { bf16_t* rowp = base + (size_t)(row0 + ai * HALF + m * 16) * ld + col0;
#pragma unroll
                for (int bj = 0; bj < 2; ++bj) { const f32x4 v0 = acc[ai][bj][m][0], v1 = acc[ai][bj][m][1];
                    u32x4 w; w.x = cvt_pk_bf16(v0[0], v0[1]); w.y = cvt_pk_bf16(v0[2], v0[3]); w.z = cvt_pk_bf16(v1[0], v1[1]); w.w = cvt_pk_bf16(v1[2], v1[3]);
                    *(u32x4*)(rowp + bj * HALF) = w; } }
    }
};
struct EpiResid {
    static constexpr bool PERM = false;
    float* hmain; float* htail; const float* x0; const float* x1;
    __device__ __forceinline__ void operator()(const f32x4 (&acc)[2][2][4][2], const Unit& u, int wr, int wc, int fr, int fq) const {
        float* base = (u.pm < TREAL / BM) ? hmain + (size_t)u.pm * BM * DM : htail;
        const float* rbase = (x0 && u.pm < TREAL / BM) ? ((u.pm < 64) ? x0 + (size_t)u.pm * BM * DM : x1 + (size_t)(u.pm - 64) * BM * DM) : base;
        const int row0 = wr * 64 + fr, col0 = u.pn * BM + wc * 32 + 4 * fq;
#pragma unroll
        for (int ai = 0; ai < 2; ++ai)
#pragma unroll
            for (int m = 0; m < 4; ++m) { const size_t ro = (size_t)(row0 + ai * HALF + m * 16) * DM + col0; float* rowp = base + ro; const float* rrow = rbase + ro;
#pragma unroll
                for (int bj = 0; bj < 2; ++bj)
#pragma unroll
                    for (int n = 0; n < 2; ++n) *(f32x4*)(rowp + bj * HALF + n * 16) = *(const f32x4*)(rrow + bj * HALF + n * 16) + acc[ai][bj][m][n];
                asm volatile("" ::: "memory"); }
    }
};
struct EpiSwiGLU {
    static constexpr bool PERM = true;
    bf16_t* O;
    __device__ __forceinline__ void operator()(const f32x4 (&acc)[2][2][4][2], const Unit& u, int wr, int wc, int fr, int fq) const {
        const int row0 = u.pm * BM + wr * 64 + fr, col0 = u.pn * HALF + wc * 32 + 8 * fq;
#pragma unroll
        for (int ai = 0; ai < 2; ++ai)
#pragma unroll
            for (int m = 0; m < 4; ++m) { bf16_t* rowp = O + (size_t)(row0 + ai * HALF + m * 16) * DFF + col0;
                float r[8];
#pragma unroll
                for (int n = 0; n < 2; ++n)
#pragma unroll
                    for (int e = 0; e < 4; ++e) { const float g = acc[ai][0][m][n][e], up = acc[ai][1][m][n][e];
                        r[n * 4 + e] = g * __builtin_amdgcn_rcpf(1.0f + __expf(-g)) * up; }
                u32x4 w; w.x = cvt_pk_bf16(r[0], r[1]); w.y = cvt_pk_bf16(r[2], r[3]); w.z = cvt_pk_bf16(r[4], r[5]); w.w = cvt_pk_bf16(r[6], r[7]);
                *(u32x4*)rowp = w; }
    }
};

struct SchedSplit {
    const bf16_t* A; const bf16_t* Bt; int nN, nK, K, ld, G, c;
    __device__ __forceinline__ bool next(int i, Unit& u) const {
        const long L = (long)i * G + c; if (L >= nN * nK) return false;
        const int pn = (int)L % nN, kc = (int)L / nN;
        u.pm = TREAL / BM; u.pn = pn; u.prob = 0;
        u.a = (const char*)(A + (size_t)u.pm * BM * ld + (size_t)kc * K); u.b = (const char*)(Bt + (size_t)pn * BM * ld + (size_t)kc * K);
        return true;
    }
};
struct EpiResidAtomic {
    static constexpr bool PERM = false;
    float* htail;
    __device__ __forceinline__ void operator()(const f32x4 (&acc)[2][2][4][2], const Unit& u, int wr, int wc, int fr, int fq) const {
        const int col0 = u.pn * BM + wc * 32 + 4 * fq;
#pragma unroll
        for (int m = 0; m < 4; ++m) { const int row = wr * 64 + m * 16 + fr;
            if (row < 96) { float* rowp = htail + (size_t)row * DM + col0;
#pragma unroll
                for (int bj = 0; bj < 2; ++bj)
#pragma unroll
                    for (int n = 0; n < 2; ++n)
#pragma unroll
                        for (int e = 0; e < 4; ++e) atomicAdd(rowp + bj * HALF + n * 16 + e, acc[0][bj][m][n][e]); } }
    }
};
template <class Epi, class Sched>
__device__ __forceinline__ void gemm_phase(const DP& p, LAS unsigned char* lds, const Sched& S, const Epi& E) {
    const int tid = p.tid, wid = __builtin_amdgcn_readfirstlane(tid >> 6), lane = tid & 63, wr = wid >> 2, wc = wid & 3, fr = lane & 15, fq = lane >> 4;
    const int K = S.ld, nt = S.K / BK;
    unsigned voffA[2], voffB[2];
#pragma unroll
    for (int i = 0; i < 2; ++i) { int R, C; stage_rc(tid * 16 + i * 8192, R, C); const int Rb = Epi::PERM ? ((R & ~31) + perm32(R & 31)) : R;
        voffA[i] = (unsigned)(R * K + C) * 2u; voffB[i] = (unsigned)(Rb * K + C) * 2u; }
    const size_t kstep = (size_t)(BK * 2);
    const size_t hstep = (size_t)HALF * K * 2;
    const unsigned ldsw = (unsigned)wid * 1024u;
    const int aoff = lds_byte(wr * 64 + fr, fq * 8), boff = lds_byte(wc * 32 + fr, fq * 8);
#define PG8_SA(b, h) (((b) * 2 + (h)) * HTB)
#define PG8_SB(b, h) ((4 + (b) * 2 + (h)) * HTB)
#define PG8_STAGE(bufoff, gbase, voff) do { _Pragma("unroll") for (int _i = 0; _i < 2; ++_i) \
        __builtin_amdgcn_global_load_lds((const unsigned*)((const char*)(gbase) + (voff)[_i]), (LAS unsigned*)(lds + (bufoff) + ldsw + _i * 8192), 16, 0, 0); } while (0)
#define PG8_LDA(dst, b, h) do { _Pragma("unroll") for (int m = 0; m < 4; ++m) _Pragma("unroll") for (int k = 0; k < 2; ++k) dst[m][k] = *(const LAS bf16x8*)(lds + PG8_SA(b, h) + aoff + m * 2048 + k * 1024); } while (0)
#define PG8_LDB(dst, b, h) do { _Pragma("unroll") for (int n = 0; n < 2; ++n) _Pragma("unroll") for (int k = 0; k < 2; ++k) dst[n][k] = *(const LAS bf16x8*)(lds + PG8_SB(b, h) + boff + n * 2048 + k * 1024); } while (0)
#define PG8_MMA(ai, bj, At, Bt) do { __builtin_amdgcn_s_setprio(1); _Pragma("unroll") for (int m = 0; m < 4; ++m) _Pragma("unroll") for (int n = 0; n < 2; ++n) _Pragma("unroll") for (int k = 0; k < 2; ++k) \
        acc[ai][bj][m][n] = __builtin_amdgcn_mfma_f32_16x16x32_bf16(Bt[n][k], At[m][k], acc[ai][bj][m][n], 0, 0, 0); __builtin_amdgcn_s_setprio(0); } while (0)
#define PG8_WAIT_V(n) asm volatile("s_waitcnt vmcnt(" #n ")" ::: "memory")
#define PG8_WAIT_L(n) asm volatile("s_waitcnt lgkmcnt(" #n ")" ::: "memory")
#define PG8_BAR __builtin_amdgcn_s_barrier()
#define PG8_SCHED __builtin_amdgcn_sched_barrier(0)
    Unit cur, nxt; int ui = 0;
    if (!S.next(0, cur)) return;
    f32x4 acc[2][2][4][2];
#pragma unroll
    for (int a = 0; a < 2; ++a)
#pragma unroll
        for (int b = 0; b < 2; ++b)
#pragma unroll
            for (int m = 0; m < 4; ++m)
#pragma unroll
                for (int n = 0; n < 2; ++n) acc[a][b][m][n] = (f32x4){0.f, 0.f, 0.f, 0.f};
    bf16x8 At[4][2], B0[2][2], B1[2][2];
    const char* cA = cur.a; const char* cB = cur.b;
    PG8_STAGE(PG8_SB(0, 0), cB, voffB); PG8_STAGE(PG8_SA(0, 0), cA, voffA); PG8_STAGE(PG8_SB(0, 1), cB + hstep, voffB); PG8_STAGE(PG8_SA(0, 1), cA + hstep, voffA);
    if (wr == 1) PG8_BAR;
    PG8_WAIT_V(4); PG8_BAR;
    PG8_STAGE(PG8_SB(1, 0), cB + kstep, voffB); PG8_STAGE(PG8_SA(1, 0), cA + kstep, voffA); PG8_STAGE(PG8_SB(1, 1), cB + hstep + kstep, voffB);
    PG8_WAIT_V(6); PG8_BAR;
    for (;;) {
        const bool has_next = S.next(ui + 1, nxt);
        const char* nA = has_next ? nxt.a : cA; const char* nB = has_next ? nxt.b : cB;
        for (int t = 0; t < nt; t += 2) {
            const bool last = (t == nt - 2);
            const char* a1 = cA + (size_t)(t + 1) * kstep;
            const char* a2 = last ? nA : cA + (size_t)(t + 2) * kstep; const char* b2 = last ? nB : cB + (size_t)(t + 2) * kstep;
            const char* a3 = a2 + kstep; const char* b3 = b2 + kstep;
            PG8_LDB(B0, 0, 0); PG8_SCHED; PG8_LDA(At, 0, 0); PG8_STAGE(PG8_SA(1, 1), a1 + hstep, voffA);
            PG8_WAIT_L(8); PG8_BAR; PG8_WAIT_L(0); PG8_MMA(0, 0, At, B0); PG8_BAR; PG8_SCHED;
            PG8_LDB(B1, 0, 1); PG8_STAGE(PG8_SB(0, 0), b2, voffB);
            PG8_BAR; PG8_WAIT_L(0); PG8_MMA(0, 1, At, B1); PG8_BAR;
            PG8_LDA(At, 0, 1); PG8_STAGE(PG8_SA(0, 0), a2, voffA);
            PG8_BAR; PG8_WAIT_L(0); PG8_MMA(1, 0, At, B0); PG8_BAR; PG8_SCHED;
            PG8_STAGE(PG8_SB(0, 1), b2 + hstep, voffB);
            PG8_WAIT_V(6); PG8_BAR; PG8_MMA(1, 1, At, B1); PG8_BAR;
            PG8_LDB(B0, 1, 0); PG8_SCHED; PG8_LDA(At, 1, 0); PG8_STAGE(PG8_SA(0, 1), a2 + hstep, voffA);
            PG8_WAIT_L(8); PG8_BAR; PG8_WAIT_L(0); PG8_MMA(0, 0, At, B0); PG8_BAR; PG8_SCHED;
            PG8_LDB(B1, 1, 1); PG8_STAGE(PG8_SB(1, 0), b3, voffB);
            PG8_BAR; PG8_WAIT_L(0); PG8_MMA(0, 1, At, B1); PG8_BAR;
            PG8_LDA(At, 1, 1); PG8_STAGE(PG8_SA(1, 0), a3, voffA);
            PG8_BAR; PG8_WAIT_L(0); PG8_MMA(1, 0, At, B0); PG8_BAR; PG8_SCHED;
            PG8_STAGE(PG8_SB(1, 1), b3 + hstep, voffB);
            PG8_WAIT_V(6); PG8_BAR; PG8_MMA(1, 1, At, B1); PG8_BAR;
        }
        E(acc, cur, wr, wc, fr, fq);
        if (!has_next) break;
#pragma unroll
        for (int a = 0; a < 2; ++a)
#pragma unroll
            for (int b = 0; b < 2; ++b)
#pragma unroll
                for (int m = 0; m < 4; ++m)
#pragma unroll
                    for (int n = 0; n < 2; ++n) acc[a][b][m][n] = (f32x4){0.f, 0.f, 0.f, 0.f};
        cur = nxt; cA = nA; cB = nB; ++ui;
    }
    PG8_WAIT_V(0);
    if (wr == 0) PG8_BAR;
    PG8_BAR;
#undef PG8_SA
#undef PG8_SB
#undef PG8_STAGE
#undef PG8_LDA
#undef PG8_LDB
#undef PG8_MMA
#undef PG8_WAIT_V
#undef PG8_WAIT_L
#undef PG8_BAR
#undef PG8_SCHED
}
}

__device__ __forceinline__ void norm_rows(const DP& p, int mode, const float* gain) {
    const int lane = p.tid & 63, gw = p.bid * 8 + (p.tid >> 6), nw = p.nb * 8;
    float* tail = (float*)(p.ws_() + WS_TAIL); bf16_t* hn = (bf16_t*)(p.ws_() + WS_XA);
    const int nrows = (mode == 2 || mode == 4) ? TREAL : TP;
    f32x4 g[8];
#pragma unroll
    for (int j = 0; j < 8; ++j) g[j] = *(const f32x4*)(gain + 4 * (lane + 64 * j));
#define NR_SRC(rr) ((mode == 0) ? (((rr) < 16384) ? p.in_(0) + (size_t)(rr) * DM : ((rr) < TREAL) ? p.in_(1) + (size_t)((rr) - 16384) * DM : p.in_(2) + (size_t)(((rr) - TREAL) & 15) * DM) \
                                : (((rr) < TREAL) ? p.out_() + (size_t)(rr) * DM : tail + (size_t)((rr) - TREAL) * DM))
    f32x4 v[8], vn[8];
    if (gw < nrows && gw < TTOK) { const float* src = NR_SRC(gw);
#pragma unroll
        for (int j = 0; j < 8; ++j) v[j] = __builtin_nontemporal_load((const f32x4*)(src + 4 * (lane + 64 * j))); }
    for (int r = gw; r < nrows; r += nw) {
        const int rn = r + nw;
        if (rn < nrows && rn < TTOK) { const float* srcn = NR_SRC(rn);
#pragma unroll
            for (int j = 0; j < 8; ++j) vn[j] = __builtin_nontemporal_load((const f32x4*)(srcn + 4 * (lane + 64 * j))); }
        if (r >= TTOK) {
#pragma unroll
            for (int j = 0; j < 8; ++j) { *(u32x2*)(hn + (size_t)r * DM + 4 * (lane + 64 * j)) = (u32x2){0u, 0u};
                if (mode == 0) *(f32x4*)(tail + (size_t)(r - TREAL) * DM + 4 * (lane + 64 * j)) = (f32x4){0.f, 0.f, 0.f, 0.f}; }
        } else {
            float* hrow = (r < TREAL) ? p.out_() + (size_t)r * DM : tail + (size_t)(r - TREAL) * DM;
            float ss = 0.f;
#pragma unroll
            for (int j = 0; j < 8; ++j) ss += v[j][0] * v[j][0] + v[j][1] * v[j][1] + v[j][2] * v[j][2] + v[j][3] * v[j][3];
            ss = wave_sum(ss);
            const float rstd = 1.0f / sqrtf(ss * (1.0f / DM) + EPSN);
#pragma unroll
            for (int j = 0; j < 8; ++j) {
                const f32x4 o = v[j] * rstd * g[j];
                if (mode == 0 && r >= TREAL) *(f32x4*)(hrow + 4 * (lane + 64 * j)) = v[j];
                if (mode == 2) *(f32x4*)(hrow + 4 * (lane + 64 * j)) = o;
                else { u32x2 w; w.x = cvt_pk_bf16(o[0], o[1]); w.y = cvt_pk_bf16(o[2], o[3]); *(u32x2*)(hn + (size_t)r * DM + 4 * (lane + 64 * j)) = w; }
            }
        }
#pragma unroll
        for (int j = 0; j < 8; ++j) v[j] = vn[j];
    }
#undef NR_SRC
}

__device__ __forceinline__ void transpose_cvt(const DP& p, LAS unsigned char* lds, const float* src, int K, int N, bf16_t* dst, int ldd, int koff, int mode) {
    LAS float* tile = (LAS float*)lds;
    const int tid = p.tid, nkt = K / 64, nnt = N / 64, ntile = nkt * nnt;
    for (int t0 = p.bid * 4; t0 < ntile; t0 += p.nb * 4) {
        f32x4 v[4][2];
#pragma unroll
        for (int u = 0; u < 4; ++u) { const int t = (t0 + u < ntile) ? t0 + u : ntile - 1; const int k0 = (t / nnt) * 64, n0 = (t % nnt) * 64;
#pragma unroll
            for (int it = 0; it < 2; ++it) { const int e = tid + it * 512, kk = e >> 4, n4 = e & 15; v[u][it] = __builtin_nontemporal_load((const f32x4*)(src + (size_t)(k0 + kk) * N + n0 + 4 * n4)); } }
#pragma unroll
        for (int u = 0; u < 4; ++u)
#pragma unroll
            for (int it = 0; it < 2; ++it) { const int e = tid + it * 512, kk = e >> 4, n4 = e & 15; LAS float* tp = tile + u * 4160 + kk * 65 + 4 * n4;
                tp[0] = v[u][it][0]; tp[1] = v[u][it][1]; tp[2] = v[u][it][2]; tp[3] = v[u][it][3]; }
        __syncthreads();
#pragma unroll
        for (int u = 0; u < 4; ++u) if (t0 + u < ntile) { const int t = t0 + u, k0 = (t / nnt) * 64, n0 = (t % nnt) * 64;
            const int nn = tid >> 3, k8 = tid & 7; float f[8];
#pragma unroll
            for (int j = 0; j < 8; ++j) f[j] = tile[u * 4160 + (8 * k8 + j) * 65 + nn];
            const int n = n0 + nn; const int drow = (mode == 0) ? n : ((n >> 7) * 256 + (n & 127) + (mode == 2 ? 128 : 0));
            u32x4 w; w.x = cvt_pk_bf16(f[0], f[1]); w.y = cvt_pk_bf16(f[2], f[3]); w.z = cvt_pk_bf16(f[4], f[5]); w.w = cvt_pk_bf16(f[6], f[7]);
            *(u32x4*)(dst + (size_t)drow * ldd + koff + k0 + 8 * k8) = w; }
        __syncthreads();
    }
}
__device__ __forceinline__ void fold_pool(const DP& p, const float* pw, const float* sc, const float* wo, bf16_t* dst) {
    const int tid = p.tid;
    for (int it = p.bid; it < 512; it += p.nb) {
        const int g = it >> 7, c8 = (it >> 2) & 31, n = (it & 3) * 512 + tid;
        float acc[8];
#pragma unroll
        for (int e = 0; e < 8; ++e) acc[e] = 0.f;
        const float* pwr = pw + (size_t)(g * 256 + c8 * 8) * 256;
#pragma unroll 1
        for (int d0 = 0; d0 < 256; d0 += 16) {
            float wv[16];
#pragma unroll
            for (int dd = 0; dd < 16; ++dd) wv[dd] = wo[(size_t)(g * 256 + d0 + dd) * DM + n];
#pragma unroll
            for (int dd = 0; dd < 16; ++dd) { const float w = wv[dd] * sc[g * 256 + d0 + dd];
#pragma unroll
                for (int e = 0; e < 8; ++e) acc[e] += pwr[e * 256 + d0 + dd] * w; }
        }
        u32x4 w; w.x = cvt_pk_bf16(acc[0], acc[1]); w.y = cvt_pk_bf16(acc[2], acc[3]); w.z = cvt_pk_bf16(acc[4], acc[5]); w.w = cvt_pk_bf16(acc[6], acc[7]);
        *(u32x4*)(dst + (size_t)n * DM + g * 256 + c8 * 8) = w;
    }
}
__device__ __forceinline__ void prep_early(const DP& p, LAS unsigned char* lds, int l) {
    transpose_cvt(p, lds, p.in_(4) + (size_t)l * DM * 4096, DM, 4096, (bf16_t*)(p.ws_() + WS_WIN), DM, 0, 0);
    transpose_cvt(p, lds, p.in_(18) + (size_t)l * DM * DM + (size_t)1024 * DM, 1024, DM, (bf16_t*)(p.ws_() + WS_WOUT), DM, 1024, 0);
    fold_pool(p, p.in_(5) + (size_t)l * 4 * 256 * 256, p.in_(6) + (size_t)l * 1024, p.in_(18) + (size_t)l * DM * DM, (bf16_t*)(p.ws_() + WS_WOUT));
}
__device__ __forceinline__ void prep_late(const DP& p, LAS unsigned char* lds, int l) {
    transpose_cvt(p, lds, p.in_(20) + (size_t)l * DM * DFF, DM, DFF, (bf16_t*)(p.ws_() + WS_WGU), DM, 0, 1);
    transpose_cvt(p, lds, p.in_(21) + (size_t)l * DM * DFF, DM, DFF, (bf16_t*)(p.ws_() + WS_WGU), DM, 0, 2);
    transpose_cvt(p, lds, p.in_(22) + (size_t)l * DFF * DM, DFF, DM, (bf16_t*)(p.ws_() + WS_WDN), DFF, 0, 0);
    { const float* w4 = p.in_(16) + (size_t)l * 64 * 4096; float* w4t = (float*)(p.ws_() + WS_W4T);
      for (int i = p.bid * NTHREADS + p.tid; i < 4096 * 64; i += p.nb * NTHREADS) w4t[i] = w4[(size_t)(i & 63) * 4096 + (i >> 6)]; }
}

__device__ __forceinline__ void mlp_layer(LAS float* hl, int lane, int nin, const float* w, const float* b, const float* fr) {
    float acc[64];
#pragma unroll
    for (int j = 0; j < 64; ++j) acc[j] = b[j];
#pragma unroll 1
    for (int i = 0; i < nin; ++i) {
        const float hv = hl[i * 64 + lane];
#pragma unroll
        for (int j = 0; j < 64; ++j) acc[j] += hv * w[i * 64 + j];
    }
#pragma unroll
    for (int j = 0; j < 64; ++j) hl[j * 64 + lane] = __sinf(fr[j] * acc[j]);
}
__device__ __forceinline__ void filter_h3(const DP& p, LAS unsigned char* lds, int l) {
    const int lane = p.tid & 63, wv = __builtin_amdgcn_readfirstlane(p.tid >> 6), gw = __builtin_amdgcn_readfirstlane(p.bid * 8 + (p.tid >> 6)), nw = p.nb * 8;
    const float* w1 = p.in_(9) + (size_t)l * 33 * 64; const float* b1 = p.in_(10) + l * 64;
    const float* w2 = p.in_(11) + (size_t)l * 64 * 64; const float* b2 = p.in_(12) + l * 64;
    const float* w3 = p.in_(13) + (size_t)l * 64 * 64; const float* b3 = p.in_(14) + l * 64;
    const float* fr = p.in_(15) + l * 64;
    float* h3 = (float*)(p.ws_() + WS_H3) + (size_t)l * (8208 + 4112) * 64;
    LAS float* hl = (LAS float*)lds + wv * 4096;
    int item0 = gw - l * (nw / 2); if (item0 < 0) item0 += nw;
    for (int item = item0; item < 129 + 65; item += nw) {
        const int tr = item < 129 ? 1 : 0, tile = tr ? item : item - 129, L = tr ? 8208 : 4112;
        const int n = tile * 64 + lane; const bool valid = n < L;
        const float nf = (float)n, t = nf / (float)(L - 1);
        hl[lane] = t;
#pragma unroll
        for (int b = 0; b < 16; ++b) { const float band = 1e-4f + (float)b * ((15.0f - 1e-4f) / 15.0f);
            const float ang = (6.283185307179586f / (float)L) * nf * band; hl[(1 + b) * 64 + lane] = __cosf(ang); hl[(17 + b) * 64 + lane] = -__sinf(ang); }
        mlp_layer(hl, lane, 33, w1, b1, fr);
        mlp_layer(hl, lane, 64, w2, b2, fr);
        mlp_layer(hl, lane, 64, w3, b3, fr);
        if (valid) { float* o = h3 + (size_t)((tr ? 0 : 8208) + n) * 64;
#pragma unroll
            for (int j = 0; j < 16; ++j) *(f32x4*)(o + 4 * j) = (f32x4){hl[(4 * j) * 64 + lane], hl[(4 * j + 1) * 64 + lane], hl[(4 * j + 2) * 64 + lane], hl[(4 * j + 3) * 64 + lane]}; }
    }
}
__device__ __forceinline__ bf16x8 cvt8(const f32x4 a, const f32x4 b) { u32x4 o; o.x = cvt_pk_bf16(a[0], a[1]); o.y = cvt_pk_bf16(a[2], a[3]); o.z = cvt_pk_bf16(b[0], b[1]); o.w = cvt_pk_bf16(b[2], b[3]); return __builtin_bit_cast(bf16x8, o); }
__device__ __forceinline__ void filter_gen(const DP& p, LAS unsigned char* lds, int l) {
    const int skipb = (p.nb == 256) ? 16 : 0;
    if (p.bid < skipb) return;
    const int lane = p.tid & 63, wv = __builtin_amdgcn_readfirstlane(p.tid >> 6), gw = __builtin_amdgcn_readfirstlane((p.bid - skipb) * 8 + (p.tid >> 6)), nw = (p.nb - skipb) * 8;
    const float* w4t = (const float*)(p.ws_() + WS_W4T); const float* h3 = (const float*)(p.ws_() + WS_H3) + (size_t)l * (8208 + 4112) * 64;
    const float* skip = p.in_(17) + (size_t)l * 2 * 1024;
    LAS bf16_t* S = (LAS bf16_t*)(lds + wv * 8448);
    const int col = lane & 31, hh = lane >> 5;
    constexpr int NS = 2 * 65 * 8, NPI = 2 * 33 * 8;
    for (int item = gw; item < NS + NPI; item += nw) {
        const int tr = item < NS ? 1 : 0, it2 = tr ? item : item - NS;
        const int L = tr ? 8208 : 4112, GL = 2 * L;
        const int part = it2 & 7, bd = it2 >> 3, dir = bd & 1, b = bd >> 1, o = part >> 2, ct0 = (part & 3) * 8;
        const int nbase = 128 * b + dir;
        const float invL1 = 1.0f / (float)(L - 1);
        bf16x8 A[4][4];
#pragma unroll
        for (int r = 0; r < 4; ++r) {
            int n = nbase + 32 * r + col; n = n < L ? n : L - 1;
            const float* hr = h3 + (size_t)((tr ? 0 : 8208) + n) * 64 + 8 * hh;
#pragma unroll
            for (int s4 = 0; s4 < 4; ++s4) A[r][s4] = cvt8(*(const f32x4*)(hr + 16 * s4), *(const f32x4*)(hr + 16 * s4 + 4));
        }
        bf16_t* gbase = (bf16_t*)(p.ws_() + (tr ? WS_GFS : WS_GFP)) + (size_t)o * 1024 * GL;
        const int ebase = dir ? L + 128 * b : L - 128 * b - 128;
#pragma unroll 1
        for (int ct = 0; ct < 8; ++ct) {
            const int c = (ct0 + ct) * 32 + col;
            const float* wr = w4t + (size_t)(o * 2048 + dir * 1024 + c) * 64 + 8 * hh;
            bf16x8 Bf[4];
#pragma unroll
            for (int s4 = 0; s4 < 4; ++s4) Bf[s4] = cvt8(*(const f32x4*)(wr + 16 * s4), *(const f32x4*)(wr + 16 * s4 + 4));
            const float d0 = -3.0701134573253946f, d1 = -15.350567286626973f;
            const float kc = -fabsf(d0 + (float)c * ((d1 - d0) / 1023.0f)) * 1.4426950408889634f;
            const float sk = skip[o * 1024 + c];
#pragma unroll
            for (int r = 0; r < 4; ++r) {
                f32x16 acc;
#pragma unroll
                for (int i = 0; i < 16; ++i) acc[i] = 0.f;
#pragma unroll
                for (int s4 = 0; s4 < 4; ++s4) acc = __builtin_amdgcn_mfma_f32_32x32x16_bf16(A[r][s4], Bf[s4], acc, 0, 0, 0);
#pragma unroll
                for (int q = 0; q < 4; ++q) {
                    const int nl0 = 32 * r + 8 * q + 4 * hh;
                    float v[4];
#pragma unroll
                    for (int e = 0; e < 4; ++e) { const int n = nbase + nl0 + e; const float t = (float)n * invL1;
                        v[e] = acc[4 * q + e] * __builtin_amdgcn_exp2f(t * kc); }
                    if (r == 0 && q == 0) v[0] += (nbase + nl0 == 0 && dir == 0) ? sk : 0.f;
                    u32x2 w;
                    if (dir) { w.x = cvt_pk_bf16(v[0], v[1]); w.y = cvt_pk_bf16(v[2], v[3]); *(LAS u32x2*)(S + col * 132 + nl0) = w; }
                    else     { w.x = cvt_pk_bf16(v[3], v[2]); w.y = cvt_pk_bf16(v[1], v[0]); *(LAS u32x2*)(S + col * 132 + 124 - nl0) = w; }
                }
            }
#pragma unroll
            for (int u = 0; u < 8; ++u) {
                const int id = u * 64 + lane, colr = id >> 4, k = id & 15;
                const u32x2 lo = *(const LAS u32x2*)(S + colr * 132 + 8 * k), hi = *(const LAS u32x2*)(S + colr * 132 + 8 * k + 4);
                const int e0 = ebase + 8 * k;
                if ((unsigned)e0 <= (unsigned)(GL - 8)) *(u32x4*)(gbase + (size_t)((ct0 + ct) * 32 + colr) * GL + e0) = (u32x4){lo.x, lo.y, hi.x, hi.y};
            }
        }
    }
}

__device__ __forceinline__ void pool_acc(float (&s)[8], const u32x4 v, float sg) {
    s[0] += sg * bflo(v.x); s[1] += sg * bfhi(v.x); s[2] += sg * bflo(v.y); s[3] += sg * bfhi(v.y); s[4] += sg * bflo(v.z); s[5] += sg * bfhi(v.z); s[6] += sg * bflo(v.w); s[7] += sg * bfhi(v.w);
}
__device__ __forceinline__ void pool_window(const DP& p, LAS unsigned char* lds) {
    const bf16_t* P = (const bf16_t*)(p.ws_() + WS_P); bf16_t* mix = (bf16_t*)(p.ws_() + WS_XA);
    LAS bf16_t* T = (LAS bf16_t*)lds;
    const int tid = p.tid;
    const int nitem = (4 * 65 + 2 * 129) * 4;
    for (int item = p.bid; item < nitem; item += p.nb) {
        const int g = item & 3, ch = item >> 2;
        int sq, r, L;
        if (ch < 4 * 65) { sq = ch / 65; r = ch - sq * 65; L = 4112; } else { const int c2 = ch - 4 * 65; sq = 4 + c2 / 129; r = c2 - (sq - 4) * 129; L = 8208; }
        const int hw = 1 << g, p0 = 64 * r, nrow = 64 + 2 * hw;
        for (int idx = tid; idx < nrow * 32; idx += NTHREADS) {
            const int j = idx >> 5, c8 = idx & 31, q = p0 - hw + j;
            u32x4 v = (u32x4){0u, 0u, 0u, 0u};
            if (q >= 0 && q < L) v = *(const u32x4*)(P + (size_t)seq_row(sq, q) * 1024 + g * 256 + 8 * c8);
            *(LAS u32x4*)(T + j * 264 + 8 * c8) = v;
        }
        __syncthreads();
        {
            const int c8 = tid & 31, run = tid >> 5, pb = p0 + 4 * run;
            if (pb < L) {
                float s[8];
#pragma unroll
                for (int e = 0; e < 8; ++e) s[e] = 0.f;
                for (int t = 0; t < 2 * hw; ++t) pool_acc(s, *(const LAS u32x4*)(T + (4 * run + t) * 264 + 8 * c8), 1.0f);
#pragma unroll
                for (int i = 0; i < 4; ++i) {
                    const int pp = pb + i;
                    const int lo = pp - hw < 0 ? 0 : pp - hw, hi = pp + hw > L ? L : pp + hw;
                    const float inv = 1.0f / (float)(hi - lo);
                    const u32x4 v = *(const LAS u32x4*)(T + (4 * run + i + hw) * 264 + 8 * c8);
                    u32x4 w;
                    w.x = cvt_pk_bf16(s[0] * inv - bflo(v.x), s[1] * inv - bfhi(v.x)); w.y = cvt_pk_bf16(s[2] * inv - bflo(v.y), s[3] * inv - bfhi(v.y));
                    w.z = cvt_pk_bf16(s[4] * inv - bflo(v.z), s[5] * inv - bfhi(v.z)); w.w = cvt_pk_bf16(s[6] * inv - bflo(v.w), s[7] * inv - bfhi(v.w));
                    if (pp < L) *(u32x4*)(mix + (size_t)seq_row(sq, pp) * DM + g * 256 + 8 * c8) = w;
                    if (i < 3) { pool_acc(s, *(const LAS u32x4*)(T + (4 * run + i + 2 * hw) * 264 + 8 * c8), 1.0f); pool_acc(s, *(const LAS u32x4*)(T + (4 * run + i) * 264 + 8 * c8), -1.0f); }
                }
            }
        }
        __syncthreads();
    }
}

constexpr int HYH_U = 0, HYH_FB = 35840, HYH_ZB = HYH_FB + 33280, HYH_RED = HYH_ZB + 512, HYH_SIZE = HYH_RED + 1024;
static_assert(2 * HYH_SIZE <= LDS_BYTES, "hyena LDS");
constexpr int FPAD = 176;
template <int TR> struct HG;
template <> struct HG<1> { static constexpr int L = 8208, B = 2, NSB = 16, BSE = 8720, NIN = 513, SQ0 = 4; };
template <> struct HG<0> { static constexpr int L = 4112, B = 4, NSB = 8,  BSE = 4416, NIN = 257, SQ0 = 0; };
__device__ __forceinline__ int uphys(int q) { return q + 8 * (q >> 7); }

struct ARaw { u32x2 w01, w23, w45; };
__device__ __forceinline__ ARaw hy_raw_a(const LAS unsigned char* p8) { ARaw r; r.w01 = *(const LAS u32x2*)p8; r.w23 = *(const LAS u32x2*)(p8 + 8); r.w45 = *(const LAS u32x2*)(p8 + 16); return r; }
__device__ __forceinline__ bf16x8 hy_fin_a(const ARaw& r, bool dsel, unsigned bsh) {
    const unsigned s0 = dsel ? r.w01.y : r.w01.x, s1 = dsel ? r.w23.x : r.w01.y, s2 = dsel ? r.w23.y : r.w23.x, s3 = dsel ? r.w45.x : r.w23.y, s4 = dsel ? r.w45.y : r.w45.x;
    u32x4 o; o.x = __builtin_amdgcn_alignbit(s1, s0, bsh); o.y = __builtin_amdgcn_alignbit(s2, s1, bsh); o.z = __builtin_amdgcn_alignbit(s3, s2, bsh); o.w = __builtin_amdgcn_alignbit(s4, s3, bsh);
    return __builtin_bit_cast(bf16x8, o);
}
template <int TR>
__device__ __forceinline__ void hy_conv(LAS unsigned char* hl, int wq, int lane, f32x16 (&acc)[4]) {
    typedef HG<TR> G;
    const LAS unsigned char* Ub = hl + HYH_U; const LAS unsigned char* FBb = hl + HYH_FB;
    asm volatile("" : "+v"(lane));
    const int n = lane & 31, h = lane >> 5;
    const int sbi = n % G::NSB, beta = n / G::NSB, sb0 = wq * G::NSB;
    const int abase = FPAD + (G::L - 1) - n + 8 * h;
    const int ab2 = 2 * abase, ab8 = ab2 & ~7; const bool dsel = (ab2 & 4) != 0; const unsigned bsh = (ab2 & 2) ? 16u : 0u;
    constexpr int KS = (G::L - 16) / 16 + 8 * (G::NSB - 1) + 1, NIT = (KS + 1) / 2, NOUT = (NIT + 3) / 4;
    const int dlo = 128 * sb0 - (G::L - 16);
    constexpr int MMAX = (G::L - 16) / 128;
#pragma unroll
    for (int r = 0; r < 4; ++r)
#pragma unroll
        for (int i = 0; i < 16; ++i) acc[r][i] = 0.f;
    bf16x8 qe[4], qo[4];
#pragma unroll
    for (int r = 0; r < 4; ++r) { qe[r] = hy_fin_a(hy_raw_a(FBb + (ab8 - 2 * (dlo + 32 * r))), dsel, bsh); qo[r] = hy_fin_a(hy_raw_a(FBb + (ab8 - 2 * (dlo + 16 + 32 * r))), dsel, bsh); }
    const int ub2 = 2 * (beta * G::BSE + 8 * h);
    int M = sbi + MMAX;
    const LAS unsigned char* zb = hl + HYH_ZB + 256;
#define HY_PB(MM, first) ({ const bool v_ = (first) ? ((unsigned)(MM) <= (unsigned)MMAX) : ((unsigned)((MM) - 1) < (unsigned)MMAX); v_ ? (Ub + ub2 + 272 * (MM)) : zb; })
    const LAS unsigned char* pb0 = HY_PB(M, true); const LAS unsigned char* pb1 = HY_PB(M, false);
    bf16x8 be = *(const LAS bf16x8*)pb0, bo = *(const LAS bf16x8*)(pb1 - 2 * (16 + 8));
    unsigned pa = (unsigned)(size_t)(FBb + (ab8 - 2 * (dlo + 128))) - 320u;
#define HY_DSR64(dst, addr, off)  asm volatile("ds_read_b64 %0, %1 offset:%2"  : "=v"(dst) : "v"(addr), "n"(off))
#define HY_DSR128(dst, addr, off) asm volatile("ds_read_b128 %0, %1 offset:%2" : "=v"(dst) : "v"(addr), "n"(off))
#pragma unroll 1
    for (int I = 0; I < NOUT; ++I) {
        const LAS unsigned char* pn0 = HY_PB(M - 1, true); const LAS unsigned char* pn1 = HY_PB(M - 1, false);
        const unsigned b1a = (unsigned)(size_t)pb1 - 256u, n0a = (unsigned)(size_t)pn0, n1a = (unsigned)(size_t)pn1 - 256u;
#pragma unroll
        for (int j = 0; j < 4; ++j) {
            ARaw ra, rb; bf16x8 nbe, nbo;
            HY_DSR64(ra.w01, pa, 320 - 64 * j);      HY_DSR64(ra.w23, pa, 320 - 64 * j + 8);      HY_DSR64(ra.w45, pa, 320 - 64 * j + 16);
            HY_DSR64(rb.w01, pa, 320 - 64 * j - 32); HY_DSR64(rb.w23, pa, 320 - 64 * j - 32 + 8); HY_DSR64(rb.w45, pa, 320 - 64 * j - 32 + 16);
            if (j < 3) { HY_DSR128(nbe, b1a, 256 - 2 * (32 * (j + 1) + 8)); HY_DSR128(nbo, b1a, 256 - 2 * (32 * (j + 1) + 16 + 8)); }
            else       { HY_DSR128(nbe, n0a, 0);                            HY_DSR128(nbo, n1a, 256 - 2 * (16 + 8)); }
#pragma unroll
            for (int r = 0; r < 4; ++r) acc[r] = __builtin_amdgcn_mfma_f32_32x32x16_bf16(qe[(j + r) & 3], be, acc[r], 0, 0, 0);
#pragma unroll
            for (int r = 0; r < 4; ++r) acc[r] = __builtin_amdgcn_mfma_f32_32x32x16_bf16(qo[(j + r) & 3], bo, acc[r], 0, 0, 0);
            asm volatile("s_waitcnt lgkmcnt(0)" : "+v"(ra.w01), "+v"(ra.w23), "+v"(ra.w45), "+v"(rb.w01), "+v"(rb.w23), "+v"(rb.w45), "+v"(nbe), "+v"(nbo), "+v"(acc[0]), "+v"(acc[1]), "+v"(acc[2]), "+v"(acc[3]));
            qe[j] = hy_fin_a(ra, dsel, bsh); qo[j] = hy_fin_a(rb, dsel, bsh);
            be = nbe; bo = nbo;
        }
        pa -= 256u; pb0 = pn0; pb1 = pn1; --M;
    }
#undef HY_DSR64
#undef HY_DSR128
#undef HY_PB
    {
        f32x16 at;
#pragma unroll
        for (int i = 0; i < 16; ++i) at[i] = 0.f;
        constexpr int MS = (G::NIN + 3) / 4;
        const int m0 = wq * MS, m1 = (m0 + MS < G::NIN) ? m0 + MS : G::NIN;
        const bool colv = n < G::B;
        const int ut2 = 2 * ((colv ? n : 0) * G::BSE + 8 * h);
#pragma unroll 4
        for (int m = m0; m < m1; ++m) {
            const int d = (G::L - 16) - 16 * m;
            const bf16x8 a = hy_fin_a(hy_raw_a(FBb + (ab8 - 2 * d)), dsel, bsh);
            const bf16x8 b = *(const LAS bf16x8*)(colv ? Ub + ut2 + 2 * (16 * m + 8 * ((16 * m) >> 7)) : zb);
            at = __builtin_amdgcn_mfma_f32_32x32x16_bf16(a, b, at, 0, 0, 0);
        }
        LAS float* RED = (LAS float*)(hl + HYH_RED);
        if (colv) {
#pragma unroll
            for (int i = 0; i < 8; ++i) { const int arow = (i & 3) + 8 * (i >> 2) + 4 * h; RED[(wq * 16 + arow) * 4 + n] = at[i]; }
        }
    }
}
template <int TR>
__device__ __forceinline__ void hy_load_stream(const DP& p, LAS unsigned char* hl, int lt, int l, int k, int c, bool toU) {
    typedef HG<TR> G;
    asm volatile("" : "+v"(lt));
    const int ch = k * 1024 + c;
    const float* cw = p.in_(7) + (size_t)l * 3 * 3072; const float* cb = p.in_(8) + (size_t)l * 3072;
    const float w0 = cw[ch], w1 = cw[3072 + ch], w2 = cw[2 * 3072 + ch], bb = cb[ch];
    const bf16_t* src = (const bf16_t*)(p.ws_() + WS_UT) + (size_t)ch * TP;
    LAS bf16_t* U = (LAS bf16_t*)(hl + HYH_U); LAS bf16_t* X = (LAS bf16_t*)(hl + HYH_FB);
    constexpr int nch = G::L / 8, NCH = G::B * nch, NI = (NCH + 255) / 256;
    constexpr int GB = 5;
#pragma unroll
    for (int g0 = 0; g0 < NI; g0 += GB) {
        u32x4 v[GB]; unsigned short xl[GB], xr[GB];
#pragma unroll
        for (int i = 0; i < GB; ++i) {
            int idx = lt + 256 * (g0 + i); idx = idx < NCH ? idx : NCH - 1;
            const int b = idx / nch, q = idx - b * nch, p0 = 8 * q, sq = G::SQ0 + b;
            const int moff = TREAL + 16 * sq, roff = seq_rbase(sq);
            const int off = p0 < 16 ? moff + p0 : roff + p0 - 16;
            v[i] = *(const u32x4*)(src + off);
            xl[i] = src[p0 == 0 ? off : (p0 == 16 ? moff + 15 : off - 1)];
            xr[i] = src[p0 + 8 >= G::L ? off : (p0 + 8 == 16 ? roff : off + 8)];
        }
#pragma unroll
        for (int i = 0; i < GB; ++i) {
            const int idx = lt + 256 * (g0 + i);
            if (g0 + i < NI && idx < NCH) {
                const int b = idx / nch, q = idx - b * nch, p0 = 8 * q;
                float x[10];
                x[0] = (p0 == 0) ? 0.f : bf2f(xl[i]);
                x[9] = (p0 + 8 >= G::L) ? 0.f : bf2f(xr[i]);
                x[1] = bflo(v[i].x); x[2] = bfhi(v[i].x); x[3] = bflo(v[i].y); x[4] = bfhi(v[i].y); x[5] = bflo(v[i].z); x[6] = bfhi(v[i].z); x[7] = bflo(v[i].w); x[8] = bfhi(v[i].w);
                float y[8];
#pragma unroll
                for (int j = 0; j < 8; ++j) y[j] = w0 * x[j] + w1 * x[j + 1] + w2 * x[j + 2] + bb;
                u32x4 w; w.x = cvt_pk_bf16(y[0], y[1]); w.y = cvt_pk_bf16(y[2], y[3]); w.z = cvt_pk_bf16(y[4], y[5]); w.w = cvt_pk_bf16(y[6], y[7]);
                LAS bf16_t* dst = toU ? U + b * G::BSE + uphys(p0) : X + b * G::L + p0;
                *(LAS u32x4*)dst = w;
            }
        }
    }
}
template <int TR>
__device__ __forceinline__ void hy_load_filter(const DP& p, LAS unsigned char* hl, int lt, int o, int c) {
    typedef HG<TR> G;
    constexpr int GL = 2 * G::L, NCH = GL / 8, NI = (NCH + 255) / 256;
    asm volatile("" : "+v"(lt));
    const bf16_t* gf = (const bf16_t*)(p.ws_() + (TR ? WS_GFS : WS_GFP)) + ((size_t)o * 1024 + c) * GL;
    LAS bf16_t* FB = (LAS bf16_t*)(hl + HYH_FB);
    u32x4 v[NI];
#pragma unroll
    for (int i = 0; i < NI; ++i) { int idx = lt + 256 * i; idx = idx < NCH ? idx : NCH - 1; v[i] = *(const u32x4*)(gf + 8 * idx); }
    if (lt < FPAD / 8) *(LAS u32x4*)(FB + 8 * lt) = (u32x4){0u, 0u, 0u, 0u};
#pragma unroll
    for (int i = 0; i < NI; ++i) { const int idx = lt + 256 * i; if (idx < NCH) *(LAS u32x4*)(FB + FPAD + 8 * idx) = v[i]; }
}
template <int TR>
__device__ __forceinline__ void hy_items(const DP& p, LAS unsigned char* lds, int l, int vcu) {
    typedef HG<TR> G;
    const int tid = p.tid, lane = tid & 63, wave = __builtin_amdgcn_readfirstlane(tid >> 6), hf = wave >> 2, wq = wave & 3, lt = tid & 255;
    LAS unsigned char* hl = lds + hf * HYH_SIZE;
    LAS bf16_t* U = (LAS bf16_t*)(hl + HYH_U); const LAS bf16_t* X = (const LAS bf16_t*)(hl + HYH_FB); const LAS float* RED = (const LAS float*)(hl + HYH_RED);
    bf16_t* UT = (bf16_t*)(p.ws_() + WS_UT);
    for (int pit = vcu; pit < 512; pit += p.nb) {
        const int c = 2 * pit + hf;
        if (lt < 32) *(LAS u32x4*)(hl + HYH_ZB + 16 * lt) = (u32x4){0u, 0u, 0u, 0u};
        hy_load_stream<TR>(p, hl, lt, l, 0, c, true);
        hy_load_filter<TR>(p, hl, lt, 0, c);
        __syncthreads();
        f32x16 acc[4];
#pragma unroll 1
        for (int rep = 0; rep < HYREP; ++rep) { hy_conv<TR>(hl, wq, lane, acc); asm volatile("" ::: "memory"); }
        __syncthreads();
        hy_load_stream<TR>(p, hl, lt, l, 1, c, false);
        __syncthreads();
        { int ln = lane; asm volatile("" : "+v"(ln)); const int n = ln & 31, hh = ln >> 5, sbi = n % G::NSB, beta = n / G::NSB, sb = wq * G::NSB + sbi;
#pragma unroll
        for (int r = 0; r < 4; ++r)
#pragma unroll
            for (int qd = 0; qd < 4; ++qd) {
                const int t0 = 128 * sb + 32 * r + 8 * qd + 4 * hh;
                const u32x2 xv = *(const LAS u32x2*)(X + beta * G::L + t0);
                u32x2 w; w.x = cvt_pk_bf16(bflo(xv.x) * acc[r][4 * qd], bfhi(xv.x) * acc[r][4 * qd + 1]); w.y = cvt_pk_bf16(bflo(xv.y) * acc[r][4 * qd + 2], bfhi(xv.y) * acc[r][4 * qd + 3]);
                *(LAS u32x2*)(U + beta * G::BSE + uphys(t0)) = w;
            }
        }
        if (lt < 16 * G::B) { const int a = lt & 15, b = lt >> 4; float y = 0.f;
#pragma unroll
            for (int w = 0; w < 4; ++w) y += RED[(w * 16 + a) * 4 + b];
            const int t = (G::L - 16) + a;
            U[b * G::BSE + uphys(t)] = f2bf(bf2f(X[b * G::L + t]) * y); }
        __syncthreads();
        hy_load_filter<TR>(p, hl, lt, 1, c);
        __syncthreads();
        hy_conv<TR>(hl, wq, lane, acc);
        __syncthreads();
        hy_load_stream<TR>(p, hl, lt, l, 2, c, false);
        __syncthreads();
        bf16_t* orow = UT + (size_t)c * TP;
        { int ln = lane; asm volatile("" : "+v"(ln)); const int n = ln & 31, hh = ln >> 5, sbi = n % G::NSB, beta = n / G::NSB, sb = wq * G::NSB + sbi;
#pragma unroll
        for (int r = 0; r < 4; ++r)
#pragma unroll
            for (int qd = 0; qd < 4; ++qd) {
                const int t0 = 128 * sb + 32 * r + 8 * qd + 4 * hh;
                const u32x2 xv = *(const LAS u32x2*)(X + beta * G::L + t0);
                u32x2 w; w.x = cvt_pk_bf16(bflo(xv.x) * acc[r][4 * qd], bfhi(xv.x) * acc[r][4 * qd + 1]); w.y = cvt_pk_bf16(bflo(xv.y) * acc[r][4 * qd + 2], bfhi(xv.y) * acc[r][4 * qd + 3]);
                *(u32x2*)(orow + seq_row(G::SQ0 + beta, t0)) = w;
            }
        }
        if (lt < 16 * G::B) { const int a = lt & 15, b = lt >> 4; float y = 0.f;
#pragma unroll
            for (int w = 0; w < 4; ++w) y += RED[(w * 16 + a) * 4 + b];
            const int t = (G::L - 16) + a;
            orow[seq_row(G::SQ0 + b, t)] = f2bf(bf2f(X[b * G::L + t]) * y); }
        __syncthreads();
    }
}
__device__ __forceinline__ void hyena_phase(const DP& p, LAS unsigned char* lds, int l) {
    const int Gd = p.nb, bx = p.bid;
    const int vcu = (Gd % 8 == 0) ? (bx % 8) * (Gd / 8) + bx / 8 : bx;
    hy_items<1>(p, lds, l, vcu);
    hy_items<0>(p, lds, l, vcu);
}
__device__ __forceinline__ void hyena_transpose(const DP& p, LAS unsigned char* lds) {
    const bf16_t* UT = (const bf16_t*)(p.ws_() + WS_UT); bf16_t* mix = (bf16_t*)(p.ws_() + WS_XA);
    LAS bf16_t* tile = (LAS bf16_t*)lds;
    const int tid = p.tid, ntile = 16 * (TP / 64);
    for (int t0 = p.bid * 4; t0 < ntile; t0 += p.nb * 4) {
        u32x4 v[4];
#pragma unroll
        for (int u = 0; u < 4; ++u) { const int t = (t0 + u < ntile) ? t0 + u : ntile - 1; const int c0 = (t & 15) * 64, tk0 = (t >> 4) * 64, cc = tid >> 3, t8 = tid & 7;
            v[u] = *(const u32x4*)(UT + (size_t)(c0 + cc) * TP + tk0 + 8 * t8); }
#pragma unroll
        for (int u = 0; u < 4; ++u) { const int cc = tid >> 3, t8 = tid & 7; *(LAS u32x4*)(tile + u * 4608 + cc * 72 + 8 * t8) = v[u]; }
        __syncthreads();
#pragma unroll
        for (int u = 0; u < 4; ++u) if (t0 + u < ntile) { const int t = t0 + u, c0 = (t & 15) * 64, tk0 = (t >> 4) * 64;
            const int tt = tid >> 3, c8 = tid & 7; unsigned w[4];
#pragma unroll
            for (int j = 0; j < 4; ++j) w[j] = (unsigned)tile[u * 4608 + (8 * c8 + 2 * j) * 72 + tt] | ((unsigned)tile[u * 4608 + (8 * c8 + 2 * j + 1) * 72 + tt] << 16);
            *(u32x4*)(mix + (size_t)(tk0 + tt) * DM + 1024 + c0 + 8 * c8) = (u32x4){w[0], w[1], w[2], w[3]}; }
        __syncthreads();
    }
}

#define XB_TMO      128
#define XB_XCNT(j)  (256  + 64 * (j))
#define XB_XSUB(j)  (1280 + 64 * (j))
#define XB_XGEN(j)  (2304 + 64 * (j))
#define XB_TOP      3328
#define XB_TOPGEN   3392
#define XCD_BAR_WORDS 3456
#define XB_SPIN_CAP (1u << 18)
__device__ __forceinline__ unsigned xb_ld(unsigned* p)              { return __hip_atomic_load(p, __ATOMIC_RELAXED, __HIP_MEMORY_SCOPE_AGENT); }
__device__ __forceinline__ unsigned xb_add(unsigned* p, unsigned v) { return __hip_atomic_fetch_add(p, v, __ATOMIC_RELAXED, __HIP_MEMORY_SCOPE_AGENT); }
__device__ __forceinline__ unsigned xb_xcc_id() { return (unsigned)__builtin_amdgcn_s_getreg((3 << 11) | 20) & 0xFu; }
#define XB_SPIN(cond, bar) do { unsigned _sp = 0; while (cond) { __builtin_amdgcn_s_sleep(1); \
    if ((++_sp & 255u) == 0u) { if (xb_ld(&(bar)[XB_TMO])) break; if (_sp > XB_SPIN_CAP) { atomicAdd(&(bar)[XB_TMO], 1u); break; } } } } while (0)
__device__ __forceinline__ void xcd_barrier_complete(unsigned* bar, unsigned x, unsigned G, unsigned& nloc, unsigned& nx) {
    unsigned sum, cnt, mine, sp = 0u;
    for (;;) {
        sum = 0u; cnt = 0u; mine = 0u;
#pragma unroll
        for (unsigned j = 0; j < 16; ++j) { const unsigned c = xb_ld(&bar[XB_XCNT(j)]); sum += c; cnt += (c > 0u) ? 1u : 0u; mine = (j == x) ? c : mine; }
        if (sum == G) break;
        __builtin_amdgcn_s_sleep(1);
        if ((++sp & 255u) == 0u) { if (xb_ld(&bar[XB_TMO])) break; if (sp > XB_SPIN_CAP) { atomicAdd(&bar[XB_TMO], 1u); break; } }
    }
    nloc = mine > 0u ? mine : 1u; nx = cnt > 0u ? cnt : 1u;
}
__device__ __forceinline__ void xcd_barrier(unsigned* bar, unsigned x, volatile LAS unsigned* st, unsigned G, int tid) {
    asm volatile("s_waitcnt vmcnt(0)" ::: "memory");
    __syncthreads();
    if (tid == 0) {
        __builtin_amdgcn_s_waitcnt(0);
        unsigned nloc = st[0], nx = st[1];
        if (nloc == 0u) { xcd_barrier_complete(bar, x, G, nloc, nx); st[0] = nloc; st[1] = nx; }
        const unsigned old = xb_add(&bar[XB_XSUB(x)], 1u);
        const unsigned gen = old / nloc;
        if (old + 1u == (gen + 1u) * nloc) {
            __builtin_amdgcn_fence(__ATOMIC_RELEASE, "agent");
            asm volatile("s_waitcnt vmcnt(0)" ::: "memory");
            const unsigned og = xb_add(&bar[XB_TOP], 1u);
            const unsigned tg = og / nx;
            if (og + 1u == (tg + 1u) * nx) xb_add(&bar[XB_TOPGEN], 1u);
            else XB_SPIN(xb_ld(&bar[XB_TOPGEN]) == tg, bar);
            __builtin_amdgcn_fence(__ATOMIC_ACQUIRE, "agent");
            xb_add(&bar[XB_XGEN(x)], 1u);
            asm volatile("s_waitcnt vmcnt(0)" ::: "memory");
        } else {
            XB_SPIN(xb_ld(&bar[XB_XGEN(x)]) == gen, bar);
            __builtin_amdgcn_fence(__ATOMIC_ACQUIRE, "agent");
            asm volatile("s_waitcnt vmcnt(0)" ::: "memory");
        }
    }
    __syncthreads();
}

constexpr int NPHASES = 17;
__device__ __forceinline__ void run_phase(const DP& p, LAS unsigned char* lds, int ph) {
    const int l = (ph == 0) ? 0 : (ph - 1) / 8, jj = (ph - 1) % 8, k = (ph == 0) ? 0 : (jj < 2 ? jj + 1 : (jj == 2 ? 8 : jj));
    const int G = p.nb, cbx = p.bid;
    bf16_t* XA = (bf16_t*)(p.ws_() + WS_XA);
    switch (k) {
#if (PHMASK >> 0) & 1
    case 0: {
#if SUB & 1
        norm_rows(p, 0, p.in_(3));
#endif
#if SUB & 2
        prep_early(p, lds, 0); prep_late(p, lds, 0);
#endif
#if SUB & 4
        __syncthreads(); filter_h3(p, lds, 0); filter_h3(p, lds, 1);
#endif
    } break;
#endif
#if (PHMASK >> 1) & 1
    case 1: {
        pg8::Prob p0{XA, (const bf16_t*)(p.ws_() + WS_WIN), TP / 256, 4};
        pg8::Prob p1{(const bf16_t*)(p.ws_() + WS_WIN) + (size_t)1024 * DM, XA, 12, TP / 256};
        pg8::Sched2 S; S.init(p0, p1, DM, G, cbx);
        pg8::EpiStore E{{(bf16_t*)(p.ws_() + WS_P), (bf16_t*)(p.ws_() + WS_UT)}, {1024, TP}};
#ifndef NOG1
        pg8::gemm_phase<pg8::EpiStore, pg8::Sched2>(p, lds, S, E);
#endif
#ifndef NOFG
        { DP p2 = p; asm volatile("" : "+v"(p2.tid));
          __syncthreads(); filter_gen(p2, lds, l); }
#endif
    } break;
#endif
#if (PHMASK >> 2) & 1
    case 2: {
#ifndef NOHY
        hyena_phase(p, lds, l);
#endif
#ifndef NOPOOL
        __syncthreads(); pool_window(p, lds);
#endif
    } break;
#endif
#if (PHMASK >> 8) & 1
    case 8: hyena_transpose(p, lds); break;
#endif
#if (PHMASK >> 3) & 1
    case 3: {
        pg8::Prob p0{XA, (const bf16_t*)(p.ws_() + WS_WOUT), TREAL / 256, DM / 256};
        pg8::Prob p1{XA, XA, 0, 0};
        pg8::Sched2 S; S.init(p0, p1, DM, G, cbx);
        pg8::EpiResid E{p.out_(), (float*)(p.ws_() + WS_TAIL), l == 0 ? p.in_(0) : nullptr, p.in_(1)};
        pg8::gemm_phase<pg8::EpiResid, pg8::Sched2>(p, lds, S, E);
        if (l == 0) {
            pg8::SchedSplit S2{XA, (const bf16_t*)(p.ws_() + WS_WOUT), DM / 256, 8, 256, DM, G, cbx};
            pg8::EpiResidAtomic E2{(float*)(p.ws_() + WS_TAIL)};
            DP p2 = p; asm volatile("" : "+v"(p2.tid));
            pg8::gemm_phase<pg8::EpiResidAtomic, pg8::SchedSplit>(p2, lds, S2, E2);
        }
    } break;
#endif
#if (PHMASK >> 4) & 1
    case 4: norm_rows(p, l == 0 ? 1 : 4, p.in_(19) + (size_t)l * DM); break;
#endif
#if (PHMASK >> 5) & 1
    case 5: {
        pg8::Prob p0{XA, (const bf16_t*)(p.ws_() + WS_WGU), l == 0 ? TP / 256 : TREAL / 256, 2 * DFF / 256};
        pg8::Prob p1{XA, XA, 0, 0};
        pg8::Sched2 S; S.init(p0, p1, DM, G, cbx);
        pg8::EpiSwiGLU E{(bf16_t*)(p.ws_() + WS_HID)};
        pg8::gemm_phase<pg8::EpiSwiGLU, pg8::Sched2>(p, lds, S, E);
        if (l == 0 && p.nb == 256 && p.bid >= 44) {
            DP p2 = p; p2.bid = p.bid - 44; p2.nb = p.nb - 44; asm volatile("" : "+v"(p2.tid));
            __syncthreads(); prep_early(p2, lds, 1);
        }
    } break;
#endif
#if (PHMASK >> 6) & 1
    case 6: {
        pg8::Prob p0{(const bf16_t*)(p.ws_() + WS_HID), (const bf16_t*)(p.ws_() + WS_WDN), TREAL / 256, DM / 256};
        pg8::Prob p1{XA, XA, 0, 0};
        pg8::Sched2 S; S.init(p0, p1, DFF, G, cbx);
        pg8::EpiResid E{p.out_(), (float*)(p.ws_() + WS_TAIL), nullptr, nullptr};
        pg8::gemm_phase<pg8::EpiResid, pg8::Sched2>(p, lds, S, E);
        if (l == 0) {
            pg8::SchedSplit S2{(const bf16_t*)(p.ws_() + WS_HID), (const bf16_t*)(p.ws_() + WS_WDN), DM / 256, 11, 512, DFF, G, cbx};
            pg8::EpiResidAtomic E2{(float*)(p.ws_() + WS_TAIL)};
            DP p2 = p; asm volatile("" : "+v"(p2.tid));
            pg8::gemm_phase<pg8::EpiResidAtomic, pg8::SchedSplit>(p2, lds, S2, E2);
        }
    } break;
#endif
#if (PHMASK >> 7) & 1
    case 7: {
        if (l == 0) { norm_rows(p, 1, p.in_(3) + DM); if (p.nb != 256) prep_early(p, lds, 1); prep_late(p, lds, 1); }
        else norm_rows(p, 2, p.in_(23));
    } break;
#endif
    }
}

__global__ void __launch_bounds__(NTHREADS, 2) mega_fwd(Params pk, int ph_lo, int ph_hi) {
    DP p;
    extern __shared__ __attribute__((aligned(16))) unsigned char lds_raw[];
    LAS unsigned char* lds = (LAS unsigned char*)lds_raw;
    cg::grid_group grid = cg::this_grid();
    volatile LAS unsigned* xst = (volatile LAS unsigned*)(lds + (LDS_BYTES - 16));
    if (threadIdx.x == 0) { xst[0] = 0u; xst[1] = 0u; }
    __syncthreads();
    unsigned* xbar = (unsigned*)(pk.ws + WS_BAR);
    const unsigned xcc = xb_xcc_id();
    if (threadIdx.x == 0) (void)xb_add(&xbar[XB_XCNT(xcc)], 1u);
    const int wave_s = __builtin_amdgcn_readfirstlane(threadIdx.x >> 6);
    for (int ph = ph_lo; ph < ph_hi; ++ph) {
        { kseg_t ks = (kseg_t)__builtin_amdgcn_kernarg_segment_ptr(); unsigned z0 = 0u; asm volatile("" : "+s"(z0));
          int t = wave_s * 64 + (int)__builtin_amdgcn_mbcnt_hi(~0u, __builtin_amdgcn_mbcnt_lo(~0u, z0)), b = blockIdx.x, n = gridDim.x;
          asm volatile("" : "+s"(ks), "+v"(t), "+s"(b), "+s"(n));
          p.ks = ks; p.tid = t; p.bid = b; p.nb = n; }
        run_phase(p, lds, ph);
#if REPMASK
        { const int j2 = (ph - 1) % 8, kk = (ph == 0) ? 0 : (j2 < 2 ? j2 + 1 : (j2 == 2 ? 8 : j2));
          if (((REPMASK >> kk) & 1) && ph != 16) { grid.sync(); run_phase(p, lds, ph); } }
#endif
        if (ph + 1 < ph_hi) {
            if (ph == ph_lo) grid.sync();
            else xcd_barrier(xbar, xcc, xst, gridDim.x, p.tid);
        }
    }
}

extern "C" void kernel_launch(void* const* d_in, const int* in_sizes, int n_in, void* d_out, int out_size, void* d_ws, size_t ws_size, hipStream_t stream) {
    static int grid = 0;
    if (grid == 0) {
        if (n_in != 24 || ws_size < WS_END) { fprintf(stderr, "kernel_launch: need 24 inputs and %zu bytes of workspace (got %d, %zu)\n", (size_t)WS_END, n_in, ws_size); grid = -1; return; }
        int dev = 0, cus = 0, per_cu = 0;
        hipGetDevice(&dev);
        hipDeviceGetAttribute(&cus, hipDeviceAttributeMultiprocessorCount, dev);
        if (hipFuncSetAttribute((const void*)mega_fwd, hipFuncAttributeMaxDynamicSharedMemorySize, LDS_BYTES) != hipSuccess) { fprintf(stderr, "hipFuncSetAttribute failed\n"); grid = -1; return; }
        hipOccupancyMaxActiveBlocksPerMultiprocessor(&per_cu, (const void*)mega_fwd, NTHREADS, LDS_BYTES);
        if (per_cu < 1) per_cu = 1;
        (void)hipGetLastError();
        grid = cus;
    }
    if (grid < 0) return;
    Params p{};
    for (int i = 0; i < 24; ++i) p.in[i] = (const float*)d_in[i];
    p.out = (float*)d_out; p.ws = (unsigned char*)d_ws;
#if MEGA
    (void)hipMemsetAsync((char*)d_ws + WS_BAR, 0, 16384, stream);
    int lo = 0, hi = NPHASES;
    void* args[] = {&p, &lo, &hi};
    hipError_t e = hipLaunchCooperativeKernel((const void*)mega_fwd, dim3(grid), dim3(NTHREADS), args, LDS_BYTES, stream);
    if (e != hipSuccess) fprintf(stderr, "cooperative launch failed: %s (grid %d)\n", hipGetErrorString(e), grid);
#else
    for (int ph = 0; ph < NPHASES; ++ph) hipLaunchKernelGGL(mega_fwd, dim3(grid), dim3(NTHREADS), LDS_BYTES, stream, p, ph, ph + 1);
#endif
}
```
